# Optimizing an MI355X kernel written in HIP

```python
import math
import jax, jax.numpy as jnp
from jax import lax
import numpy as np

D_MODEL = 2048
BATCH = 8
SEQ = 2048
DEPTH = 2

GRID_W = 64
CTX_LEN = 256
EXPAND = 2
D_INNER = EXPAND * D_MODEL
N_DIR = 2
N_MIXERS = 2
S5_GROUP = 16
S5_GROUPS = D_INNER // S5_GROUP
S5_STATE = 64
S5_CHUNK = 128
S5_DT_MIN = 1e-3
S5_DT_MAX = 1e-1
RWKV_HEAD = 64
RWKV_HEADS = D_INNER // RWKV_HEAD
LORA_DECAY = 96
LORA_AAA = 96
N_LERP = 6
RMS_EPS = 1e-6
GN_EPS = 64e-5
NORM_EPS = 1e-12

kernel_name = "hybrid_s5_rwkv7_prefix_dit"

F32 = jnp.float32


def rmsnorm(x, g):
    xf = x.astype(F32)
    y = xf * lax.rsqrt(jnp.mean(xf * xf, axis=-1, keepdims=True) + RMS_EPS)
    return (y * g.astype(F32)).astype(x.dtype)


def modulation(cond, ada_w, ada_b):
    m = (jax.nn.silu(cond) @ ada_w + ada_b).reshape(cond.shape[0], 1, 3 * D_MODEL)
    return jnp.split(m, 3, axis=-1)


def s5_discretize(a_re, a_im, log_step, b_re, b_im):
    a_re, a_im = a_re.astype(F32), a_im.astype(F32)
    b_re, b_im = b_re.astype(F32), b_im.astype(F32)
    dt = jnp.exp(log_step.astype(F32))[:, None]
    mag = jnp.exp(dt * a_re)
    ab_re = mag * jnp.cos(dt * a_im)
    ab_im = mag * jnp.sin(dt * a_im)
    den = a_re * a_re + a_im * a_im
    nr, ni = ab_re - 1.0, ab_im
    f_re = ((nr * a_re + ni * a_im) / den)[..., None]
    f_im = ((ni * a_re - nr * a_im) / den)[..., None]
    bb_re = f_re * b_re - f_im * b_im
    bb_im = f_re * b_im + f_im * b_re
    return ab_re, ab_im, bb_re, bb_im


def _complex_affine_combine(e1, e2):
    a1r, a1i, b1r, b1i = e1
    a2r, a2i, b2r, b2i = e2
    return (a2r * a1r - a2i * a1i, a2r * a1i + a2i * a1r,
            a2r * b1r - a2i * b1i + b2r, a2r * b1i + a2i * b1r + b2i)


def s5_chunked_scan(u, h0_re, h0_im, disc, c_re, c_im):
    ab_re, ab_im, bb_re, bb_im = disc
    c_re, c_im = c_re.astype(F32), c_im.astype(F32)
    b, l = u.shape[0], u.shape[1]
    n_chunks = l // S5_CHUNK
    uc = u.reshape(b, n_chunks, S5_CHUNK, S5_GROUPS, S5_GROUP).transpose(1, 2, 0, 3, 4)
    a_re = jnp.broadcast_to(ab_re, (S5_CHUNK, b, S5_GROUPS, S5_STATE))
    a_im = jnp.broadcast_to(ab_im, (S5_CHUNK, b, S5_GROUPS, S5_STATE))

    def chunk_step(carry, u_blk):
        h_re, h_im = carry
        bu_re = jnp.einsum('tbgi,gni->tbgn', u_blk, bb_re)
        bu_im = jnp.einsum('tbgi,gni->tbgn', u_blk, bb_im)
        ac_re, ac_im, hl_re, hl_im = lax.associative_scan(
            _complex_affine_combine, (a_re, a_im, bu_re, bu_im), axis=0)
        hs_re = hl_re + ac_re * h_re - ac_im * h_im
        hs_im = hl_im + ac_re * h_im + ac_im * h_re
        y = (jnp.einsum('tbgn,gin->tbgi', hs_re, c_re)
             - jnp.einsum('tbgn,gin->tbgi', hs_im, c_im))
        return (hs_re[-1], hs_im[-1]), y

    (h_re, h_im), ys = lax.scan(chunk_step, (h0_re, h0_im), uc)
    y = ys.transpose(2, 0, 1, 3, 4).reshape(b, l, S5_GROUPS, S5_GROUP)
    return y, h_re, h_im


def s5_direction(u, h0_re, h0_im, disc, c_re, c_im, reverse):
    b, l, _ = u.shape
    uu = u.astype(F32).reshape(b, l, S5_GROUPS, S5_GROUP)
    if reverse:
        uu = jnp.flip(uu, axis=1)
    y, h_re, h_im = s5_chunked_scan(uu, h0_re, h0_im, disc, c_re, c_im)
    if reverse:
        y = jnp.flip(y, axis=1)
    return y.reshape(b, l, D_INNER), h_re, h_im


def s5_output(y_ssm, u, z, d_skip, glu_w, glu_b, out_w):
    y = jax.nn.gelu(y_ssm + d_skip.astype(F32) * u.astype(F32)).astype(u.dtype)
    y = y * jax.nn.sigmoid(y @ glu_w + glu_b)
    return (y * jax.nn.silu(z)) @ out_w


def s5_mixer(h_lat, h_ctx, need_ctx_out, in_w, a_re, a_im, log_step, b_re, b_im,
             c_re, c_im, d_skip, glu_w, glu_b, out_w):
    u_lat, z_lat = jnp.split(h_lat @ in_w, 2, axis=-1)
    if need_ctx_out:
        u_ctx, z_ctx = jnp.split(h_ctx @ in_w, 2, axis=-1)
    else:
        u_ctx = h_ctx @ in_w[:, :D_INNER]
    h0 = jnp.zeros((h_ctx.shape[0], S5_GROUPS, S5_STATE), F32)
    ys_lat, ys_ctx = [], []
    for d in range(N_DIR):
        disc = s5_discretize(a_re[d], a_im[d], log_step[d], b_re[d], b_im[d])
        rev = d == 1
        y_c, hc_re, hc_im = s5_direction(u_ctx, h0, h0, disc, c_re[d], c_im[d], rev)
        y_l, _, _ = s5_direction(u_lat, hc_re, hc_im, disc, c_re[d], c_im[d], rev)
        ys_lat.append(y_l)
        ys_ctx.append(y_c)
    o_lat = s5_output(ys_lat[0] + ys_lat[1], u_lat, z_lat, d_skip, glu_w, glu_b, out_w)
    o_ctx = None
    if need_ctx_out:
        o_ctx = s5_output(ys_ctx[0] + ys_ctx[1], u_ctx, z_ctx, d_skip, glu_w, glu_b, out_w)
    return o_lat, o_ctx


def q_shift(h):
    b, l, d = h.shape
    rows = l // GRID_W
    g = h.reshape(b, rows, GRID_W, d)
    q = d // 4
    left = jnp.pad(g[:, :, :-1, :q], ((0, 0), (0, 0), (1, 0), (0, 0)))
    right = jnp.pad(g[:, :, 1:, q:2 * q], ((0, 0), (0, 0), (0, 1), (0, 0)))
    up = jnp.pad(g[:, :-1, :, 2 * q:3 * q], ((0, 0), (1, 0), (0, 0), (0, 0)))
    down = jnp.pad(g[:, 1:, :, 3 * q:], ((0, 0), (0, 1), (0, 0), (0, 0)))
    return jnp.concatenate([left, right, up, down], axis=-1).reshape(b, l, d)


def seq_shift(h):
    half = h.shape[-1] // 2
    prev = jnp.pad(h[:, :-1, :half], ((0, 0), (1, 0), (0, 0)))
    nxt = jnp.pad(h[:, 1:, half:], ((0, 0), (0, 1), (0, 0)))
    return jnp.concatenate([prev, nxt], axis=-1)


def rwkv_stream(h, shifted, with_gate, mu, in_w, w0, w1, w2, a0, a1, a2, k_k, k_a):
    b, l, _ = h.shape
    delta = shifted - h
    n_proj = 4 if with_gate else 3
    proj = [(h + delta * mu[i]) @ in_w[i] for i in range(n_proj)]
    z = proj[3] if with_gate else None
    xw = h + delta * mu[4]
    xa = h + delta * mu[5]

    def heads(t):
        return t.astype(F32).reshape(b, l, RWKV_HEADS, RWKV_HEAD)

    r, k, v = heads(proj[0]), heads(proj[1]), heads(proj[2])
    kk = k * k_k.astype(F32).reshape(RWKV_HEADS, RWKV_HEAD)
    kk = kk / jnp.maximum(jnp.sqrt(jnp.sum(kk * kk, axis=-1, keepdims=True)), NORM_EPS)
    k_a_h = k_a.astype(F32).reshape(RWKV_HEADS, RWKV_HEAD)
    dirs = []
    for d in range(N_DIR):
        w_log = -jax.nn.softplus(-heads(w0[d] + jnp.tanh(xw @ w1[d]) @ w2[d])) - 0.5
        decay = jnp.exp(-jnp.exp(w_log))
        a_rate = jax.nn.sigmoid(heads(a0[d] + (xa @ a1[d]) @ a2[d]))
        k_d = k * (1.0 + (a_rate - 1.0) * k_a_h)
        dirs.append((decay, k_d, -kk, kk * a_rate))
    return r, v, z, dirs


def rwkv_scan(r, decay, k, v, a, bvec, s0):
    def step(s, inp):
        r_t, w_t, k_t, v_t, a_t, b_t = inp
        sa = jnp.einsum('bhvk,bhk->bhv', s, a_t)
        s = (s * w_t[:, :, None, :] + sa[..., None] * b_t[:, :, None, :]
             + v_t[..., None] * k_t[:, :, None, :])
        return s, jnp.einsum('bhvk,bhk->bhv', s, r_t)

    xs = tuple(jnp.moveaxis(t, 1, 0) for t in (r, decay, k, v, a, bvec))
    s, ys = lax.scan(step, s0, xs)
    return jnp.moveaxis(ys, 0, 1), s


def rwkv_direction(r, v, dir_terms, s0, reverse):
    decay, k_d, a_vec, b_vec = dir_terms
    seqs = (r, decay, k_d, v, a_vec, b_vec)
    if reverse:
        seqs = tuple(jnp.flip(t, axis=1) for t in seqs)
    y, s = rwkv_scan(*seqs, s0)
    if reverse:
        y = jnp.flip(y, axis=1)
    return y, s


def rwkv_output(y_sum, r, k_sum, v, z, r_k, ln_w, ln_b, out_w):
    b, l = y_sum.shape[0], y_sum.shape[1]
    mu_ = jnp.mean(y_sum, axis=-1, keepdims=True)
    var = jnp.mean(jnp.square(y_sum - mu_), axis=-1, keepdims=True)
    yn = ((y_sum - mu_) * lax.rsqrt(var + GN_EPS)).reshape(b, l, D_INNER)
    yn = yn * ln_w.astype(F32) + ln_b.astype(F32)
    bonus = jnp.sum(r * k_sum * r_k.astype(F32), axis=-1, keepdims=True) * v
    y = (yn + bonus.reshape(b, l, D_INNER)).astype(z.dtype)
    return (y * jax.nn.silu(z)) @ out_w


def rwkv_mixer(h_lat, h_ctx, need_ctx_out, mu, in_w, w0, w1, w2, a0, a1, a2,
               k_k, k_a, r_k, ln_w, ln_b, out_w):
    lora = (mu, in_w, w0, w1, w2, a0, a1, a2, k_k, k_a)
    r_l, v_l, z_l, dirs_l = rwkv_stream(h_lat, q_shift(h_lat), True, *lora)
    r_c, v_c, z_c, dirs_c = rwkv_stream(h_ctx, seq_shift(h_ctx), need_ctx_out, *lora)
    s0 = jnp.zeros((h_ctx.shape[0], RWKV_HEADS, RWKV_HEAD, RWKV_HEAD), F32)
    ys_lat, ys_ctx = [], []
    for d in range(N_DIR):
        rev = d == 1
        y_c, s_c = rwkv_direction(r_c, v_c, dirs_c[d], s0, rev)
        y_l, _ = rwkv_direction(r_l, v_l, dirs_l[d], s_c, rev)
        ys_lat.append(y_l)
        ys_ctx.append(y_c)
    o_lat = rwkv_output(ys_lat[0] + ys_lat[1], r_l, dirs_l[0][1] + dirs_l[1][1], v_l, z_l,
                        r_k, ln_w, ln_b, out_w)
    o_ctx = None
    if need_ctx_out:
        o_ctx = rwkv_output(ys_ctx[0] + ys_ctx[1], r_c, dirs_c[0][1] + dirs_c[1][1], v_c,
                            z_c, r_k, ln_w, ln_b, out_w)
    return o_lat, o_ctx


def setup_inputs(seed: int = 0) -> dict:
    key = jax.random.key(seed)
    ks = iter(jax.random.split(key, 64))

    def nrm(shape, std):
        return jax.random.normal(next(ks), shape, F32) * std

    def gain(shape):
        return 1.0 + nrm(shape, 0.02)

    D, E, G, N, GC = D_MODEL, D_INNER, S5_GROUPS, S5_STATE, S5_GROUP
    p = {}
    p["x"] = nrm((BATCH, SEQ, D), 1.0)
    p["c"] = nrm((BATCH, D), 1.0)
    p["ctx"] = nrm((BATCH, CTX_LEN, D), 1.0)
    p["c_ctx"] = nrm((D,), 1.0)
    p["l0_norm_g"] = gain((D,))
    p["l0_ada_w"] = nrm((D, 3 * D), 0.5 * D ** -0.5)
    p["l0_ada_b"] = nrm((3 * D,), 0.01)
    p["l0_in_w"] = nrm((D, 2 * E), D ** -0.5)
    n_idx = jnp.arange(N, dtype=F32)
    p["l0_a_re"] = -0.5 + nrm((N_DIR, G, N), 0.01)
    p["l0_a_im"] = math.pi * n_idx + nrm((N_DIR, G, N), 0.01)
    p["l0_log_step"] = jax.random.uniform(next(ks), (N_DIR, G), F32,
                                          math.log(S5_DT_MIN), math.log(S5_DT_MAX))
    p["l0_b_re"] = nrm((N_DIR, G, N, GC), (2.0 * GC) ** -0.5)
    p["l0_b_im"] = nrm((N_DIR, G, N, GC), (2.0 * GC) ** -0.5)
    p["l0_c_re"] = nrm((N_DIR, G, GC, N), (2.0 * N) ** -0.5)
    p["l0_c_im"] = nrm((N_DIR, G, GC, N), (2.0 * N) ** -0.5)
    p["l0_d"] = nrm((E,), 1.0)
    p["l0_glu_w"] = nrm((E, E), E ** -0.5)
    p["l0_glu_b"] = nrm((E,), 0.01)
    p["l0_out_w"] = nrm((E, D), E ** -0.5)
    p["l1_norm_g"] = gain((D,))
    p["l1_ada_w"] = nrm((D, 3 * D), 0.5 * D ** -0.5)
    p["l1_ada_b"] = nrm((3 * D,), 0.01)
    p["l1_mu"] = jax.random.uniform(next(ks), (N_LERP, D), F32)
    p["l1_in_w"] = nrm((4, D, E), D ** -0.5)
    p["l1_w0"] = jax.random.uniform(next(ks), (N_DIR, E), F32, -6.0, 0.0)
    p["l1_w1"] = nrm((N_DIR, D, LORA_DECAY), D ** -0.5)
    p["l1_w2"] = nrm((N_DIR, LORA_DECAY, E), 0.1 * LORA_DECAY ** -0.5)
    p["l1_a0"] = nrm((N_DIR, E), 0.1)
    p["l1_a1"] = nrm((N_DIR, D, LORA_AAA), D ** -0.5)
    p["l1_a2"] = nrm((N_DIR, LORA_AAA, E), 0.1 * LORA_AAA ** -0.5)
    p["l1_k_k"] = 0.85 + nrm((E,), 0.02)
    p["l1_k_a"] = gain((E,))
    p["l1_r_k"] = nrm((RWKV_HEADS, RWKV_HEAD), 0.1)
    p["l1_ln_w"] = gain((E,))
    p["l1_ln_b"] = nrm((E,), 0.01)
    p["l1_out_w"] = nrm((E, D), E ** -0.5)
    p["final_norm_g"] = gain((D,))
    return p


def reference(x, c, ctx, c_ctx,
              l0_norm_g, l0_ada_w, l0_ada_b, l0_in_w, l0_a_re, l0_a_im, l0_log_step,
              l0_b_re, l0_b_im, l0_c_re, l0_c_im, l0_d, l0_glu_w, l0_glu_b, l0_out_w,
              l1_norm_g, l1_ada_w, l1_ada_b, l1_mu, l1_in_w, l1_w0, l1_w1, l1_w2,
              l1_a0, l1_a1, l1_a2, l1_k_k, l1_k_a, l1_r_k, l1_ln_w, l1_ln_b, l1_out_w,
              final_norm_g):
    mixers = (s5_mixer, rwkv_mixer)
    layers = (
        ((l0_norm_g, l0_ada_w, l0_ada_b),
         (l0_in_w, l0_a_re, l0_a_im, l0_log_step, l0_b_re, l0_b_im, l0_c_re, l0_c_im,
          l0_d, l0_glu_w, l0_glu_b, l0_out_w)),
        ((l1_norm_g, l1_ada_w, l1_ada_b),
         (l1_mu, l1_in_w, l1_w0, l1_w1, l1_w2, l1_a0, l1_a1, l1_a2, l1_k_k, l1_k_a,
          l1_r_k, l1_ln_w, l1_ln_b, l1_out_w)),
    )
    x_lat, x_ctx = x, ctx
    for i in range(DEPTH):
        (norm_g, ada_w, ada_b), mixer_params = layers[i]
        mixer = mixers[i % N_MIXERS]
        need_ctx_out = i < DEPTH - 1
        sh_l, sc_l, g_l = modulation(c, ada_w, ada_b)
        sh_c, sc_c, g_c = modulation(c_ctx[None], ada_w, ada_b)
        h_lat = rmsnorm(x_lat, norm_g) * (1.0 + sc_l) + sh_l
        h_ctx = rmsnorm(x_ctx, norm_g) * (1.0 + sc_c) + sh_c
        o_lat, o_ctx = mixer(h_lat, h_ctx, need_ctx_out, *mixer_params)
        x_lat = x_lat + g_l * o_lat
        if need_ctx_out:
            x_ctx = x_ctx + g_c * o_ctx
    return rmsnorm(x_lat, final_norm_g)
```

```cpp
#include <hip/hip_runtime.h>
#include <hip/hip_cooperative_groups.h>
#include <cstdio>
#include <cstdint>
namespace cg = cooperative_groups;
namespace pg8 {
#define PG8_LAS __attribute__((address_space(3)))
typedef unsigned short bf16_t;
typedef short bf16x8 __attribute__((ext_vector_type(8)));
typedef float f32x4 __attribute__((ext_vector_type(4)));
typedef unsigned u32x4 __attribute__((ext_vector_type(4)));
constexpr int BM = 256, BK = 64, HALF = 128, HTB = HALF * BK * 2  , STAGE_BYTES = 8 * HTB, NXCD = 8, WGM = 8;

__host__ __device__ __forceinline__ int lds_byte(int r, int c) { const int st = (r >> 4) * 2 + (c >> 5), rr = r & 15, cc = c & 31, ob = rr * 64 + cc * 2; return st * 1024 + (ob ^ (((ob >> 9) & 1) << 5)); }
__host__ __device__ __forceinline__ void stage_rc(int b, int& R, int& C) { const int st = b / 1024, sb = b % 1024, swz = sb ^ (((sb >> 9) & 1) << 5); R = (st >> 1) * 16 + swz / 64; C = (st & 1) * 32 + (swz % 64) / 2; }
__host__ __device__ __forceinline__ int perm32(int rho) { const int n = rho >> 4, i = rho & 15; return 8 * (i >> 2) + 4 * n + (i & 3); }

struct Unit { int pm, pn; };
struct Gemm { const bf16_t* A; const bf16_t* Bt; int M, N, K; size_t a_stride; int a_div, a_n0; };
#define PG8_AIDX(g, pn) ((size_t)((pn) < (g).a_n0 ? (pn) / (g).a_div : (g).a_n0 / (g).a_div + ((pn) - (g).a_n0)) * (g).a_stride)

struct StaticOrder {
    int nM, nN, nwg, G, c;
    __host__ __device__ void init(int M, int N, int G_, int c_) { nM = M / BM; nN = N / BM; nwg = nM * nN; G = G_; c = c_; }
    __host__ __device__ bool next(int i, Unit& u) const {
        const long L = (long)i * G + c; if (L >= nwg) return false;
        int wgid = (int)L; { const int q = nwg / NXCD, r = nwg % NXCD, xcd = wgid % NXCD, off = wgid / NXCD; wgid = (xcd < r ? xcd * (q + 1) : r * (q + 1) + (xcd - r) * q) + off; }
        const int nig = WGM * nN, gid = wgid / nig, fm = gid * WGM, gsz = (nM - fm) < WGM ? (nM - fm) : WGM;
        u.pm = fm + ((wgid % nig) % gsz); u.pn = (wgid % nig) / gsz; return true;
    }
    __device__ __forceinline__ void a_ready(const Unit&) const {}
    __device__ __forceinline__ void done(const Unit&) const {}
};
__device__ __forceinline__ unsigned cvt_pk_bf16(float lo, float hi) { unsigned r; asm volatile("v_cvt_pk_bf16_f32 %0, %1, %2" : "=v"(r) : "v"(lo), "v"(hi)); return r; }
__device__ __forceinline__ float bflo(unsigned w) { return __builtin_bit_cast(float, w << 16); }
__device__ __forceinline__ float bfhi(unsigned w) { return __builtin_bit_cast(float, w & 0xffff0000u); }
__device__ __forceinline__ float sigm(float x) { return 1.0f / (1.0f + __expf(-x)); }
__device__ __forceinline__ float tanh_f(float x) { const float e = __expf(2.0f * x); return 1.0f - 2.0f / (1.0f + e); }

struct EpiSplitBf16 {
    static constexpr bool PERM = true, AFTER_DRAIN = false;
    bf16_t* O; int ldc; int split_cols; size_t split_stride;
    __device__ __forceinline__ void operator()(const f32x4 (&acc)[2][2][4][2], const Unit& u, int wr, int wc, int fr, int fq) const {
        const int row0 = u.pm * BM + wr * 64 + fr; int colt = u.pn * BM; bf16_t* base = O;
        { const int t = colt / split_cols; base += (size_t)t * split_stride; colt -= t * split_cols; }
        const int col0 = colt + wc * 32 + 8 * fq;
#pragma unroll
        for (int ai = 0; ai < 2; ++ai)
#pragma unroll
            for (int m = 0; m < 4; ++m) { bf16_t* rowp = base + (size_t)(row0 + ai * HALF + m * 16) * ldc + col0;
#pragma unroll
                for (int bj = 0; bj < 2; ++bj) { const f32x4 v0 = acc[ai][bj][m][0], v1 = acc[ai][bj][m][1];
                    u32x4 w; w.x = cvt_pk_bf16(v0[0], v0[1]); w.y = cvt_pk_bf16(v0[2], v0[3]); w.z = cvt_pk_bf16(v1[0], v1[1]); w.w = cvt_pk_bf16(v1[2], v1[3]);
                    *(u32x4*)(rowp + bj * HALF) = w; } }
    }
};

struct EpiGlu {
    static constexpr bool PERM = true, AFTER_DRAIN = false;
    const bf16_t* Y; bf16_t* Z; int ldc; const float* bias;
    __device__ __forceinline__ void operator()(const f32x4 (&acc)[2][2][4][2], const Unit& u, int wr, int wc, int fr, int fq) const {
        const int row0 = u.pm * BM + wr * 64 + fr; const int col0 = u.pn * BM + wc * 32 + 8 * fq;
#pragma unroll
        for (int bj = 0; bj < 2; ++bj) {
            const f32x4 b0 = *(const f32x4*)(bias + col0 + bj * HALF), b1 = *(const f32x4*)(bias + col0 + bj * HALF + 4);
#pragma unroll
            for (int ai = 0; ai < 2; ++ai)
#pragma unroll
                for (int m = 0; m < 4; ++m) {
                    const size_t off = (size_t)(row0 + ai * HALF + m * 16) * ldc + col0 + bj * HALF;
                    const u32x4 yy = *(const u32x4*)(Y + off); const u32x4 zz = *(const u32x4*)(Z + off);
                    const f32x4 t0 = acc[ai][bj][m][0] + b0, t1 = acc[ai][bj][m][1] + b1;
                    float o[8];
#define GLU1(k, yv, zv, tv) { const float y_ = (yv), z_ = (zv); o[k] = y_ * sigm(tv) * (z_ * sigm(z_)); }
                    GLU1(0, bflo(yy.x), bflo(zz.x), t0[0]) GLU1(1, bfhi(yy.x), bfhi(zz.x), t0[1])
                    GLU1(2, bflo(yy.y), bflo(zz.y), t0[2]) GLU1(3, bfhi(yy.y), bfhi(zz.y), t0[3])
                    GLU1(4, bflo(yy.z), bflo(zz.z), t1[0]) GLU1(5, bfhi(yy.z), bfhi(zz.z), t1[1])
                    GLU1(6, bflo(yy.w), bflo(zz.w), t1[2]) GLU1(7, bfhi(yy.w), bfhi(zz.w), t1[3])
#undef GLU1
                    u32x4 w; w.x = cvt_pk_bf16(o[0], o[1]); w.y = cvt_pk_bf16(o[2], o[3]); w.z = cvt_pk_bf16(o[4], o[5]); w.w = cvt_pk_bf16(o[6], o[7]);
                    *(u32x4*)(Z + off) = w; }
        }
    }
};

struct EpiResid {
    static constexpr bool PERM = false, AFTER_DRAIN = false;
    const float* XIN; float* OUT; const float* CTXIN; float* XC; const float* MOD; int ctx_rows; int lat_row0;
    __device__ __forceinline__ void operator()(const f32x4 (&acc)[2][2][4][2], const Unit& u, int wr, int wc, int fr, int fq) const {
        const int row0 = u.pm * BM + wr * 64 + fr, col0 = u.pn * BM + wc * 32 + 4 * fq;
        const bool isctx = (u.pm * BM) < ctx_rows;
#pragma unroll
        for (int ai = 0; ai < 2; ++ai)
#pragma unroll
            for (int m = 0; m < 4; ++m) {
                const int row = row0 + ai * HALF + m * 16;
                const int rr = isctx ? row : (row - ctx_rows + lat_row0); const int gj = isctx ? 8 : (rr >> 11);
                const float* src = (isctx ? CTXIN : XIN) + (size_t)rr * 2048; float* dst = (isctx ? XC : OUT) + (size_t)rr * 2048; const float* gate = MOD + gj * 6144 + 4096;
#pragma unroll
                for (int bj = 0; bj < 2; ++bj)
#pragma unroll
                    for (int n = 0; n < 2; ++n) { const int c = col0 + bj * HALF + n * 16;
                        const f32x4 g4 = *(const f32x4*)(gate + c); const f32x4 x4 = *(const f32x4*)(src + c);
                        *(f32x4*)(dst + c) = x4 + g4 * acc[ai][bj][m][n]; }
            }
    }
};

struct EpiZLora {
    static constexpr bool PERM = true, AFTER_DRAIN = false;
    bf16_t* Zb; bf16_t* LW; bf16_t* LA;
    __device__ __forceinline__ void operator()(const f32x4 (&acc)[2][2][4][2], const Unit& u, int wr, int wc, int fr, int fq) const {
        const int row0 = u.pm * BM + wr * 64 + fr;
        if (u.pn < 16) {
            if (u.pm < 4) return;
            const int col0 = u.pn * BM + wc * 32 + 8 * fq;
#pragma unroll
            for (int ai = 0; ai < 2; ++ai)
#pragma unroll
                for (int m = 0; m < 4; ++m) { bf16_t* rowp = Zb + (size_t)(row0 + ai * HALF + m * 16) * 4096 + col0;
#pragma unroll
                    for (int bj = 0; bj < 2; ++bj) { const f32x4 v0 = acc[ai][bj][m][0], v1 = acc[ai][bj][m][1];
                        u32x4 w; w.x = cvt_pk_bf16(v0[0], v0[1]); w.y = cvt_pk_bf16(v0[2], v0[3]); w.z = cvt_pk_bf16(v1[0], v1[1]); w.w = cvt_pk_bf16(v1[2], v1[3]);
                        *(u32x4*)(rowp + bj * HALF) = w; } }
        } else {
            const bool isw = (u.pn == 16); bf16_t* base = isw ? LW : LA;
#pragma unroll
            for (int bj = 0; bj < 2; ++bj) {
                const int col = bj * HALF + wc * 32 + 8 * fq;
                if (col < 192) {
#pragma unroll
                    for (int ai = 0; ai < 2; ++ai)
#pragma unroll
                        for (int m = 0; m < 4; ++m) { f32x4 v0 = acc[ai][bj][m][0], v1 = acc[ai][bj][m][1];
                            if (isw) { v0[0] = tanh_f(v0[0]); v0[1] = tanh_f(v0[1]); v0[2] = tanh_f(v0[2]); v0[3] = tanh_f(v0[3]); v1[0] = tanh_f(v1[0]); v1[1] = tanh_f(v1[1]); v1[2] = tanh_f(v1[2]); v1[3] = tanh_f(v1[3]); }
                            u32x4 w; w.x = cvt_pk_bf16(v0[0], v0[1]); w.y = cvt_pk_bf16(v0[2], v0[3]); w.z = cvt_pk_bf16(v1[0], v1[1]); w.w = cvt_pk_bf16(v1[2], v1[3]);
                            *(u32x4*)(base + (size_t)(row0 + ai * HALF + m * 16) * 192 + col) = w; }
                }
            }
        }
    }
};
template <class Epi, class Sched, bool ALIGN_EPI = false, bool SP2 = false>
__device__ __forceinline__ void gemm_phase(PG8_LAS unsigned char* lds, const Gemm g, const Sched& S, const Epi& E) {
    const int tid = threadIdx.x, wid = __builtin_amdgcn_readfirstlane(tid >> 6), lane = tid & 63, wr = wid >> 2, wc = wid & 3, fr = lane & 15, fq = lane >> 4;
    const int K = g.K, nt = K / BK;
    unsigned voffA[2], voffB[2];
#pragma unroll
    for (int i = 0; i < 2; ++i) { int R, C; stage_rc(tid * 16 + i * 8192, R, C); const int Rb = Epi::PERM ? ((R & ~31) + perm32(R & 31)) : R;
        voffA[i] = (unsigned)(R * K + C) * 2u; voffB[i] = (unsigned)(Rb * K + C) * 2u; }
    const size_t kstep = (size_t)(BK * 2);
    const size_t hstep = (size_t)HALF * K * 2;
    const size_t tstep = 2 * hstep;
    const unsigned ldsw = (unsigned)wid * 1024u;
    const int aoff = lds_byte(wr * 64 + fr, fq * 8), boff = lds_byte(wc * 32 + fr, fq * 8);
#define PG8_SA(b, h) (((b) * 2 + (h)) * HTB)
#define PG8_SB(b, h) ((4 + (b) * 2 + (h)) * HTB)
#define PG8_STAGE(bufoff, gbase, voff) do { _Pragma("unroll") for (int _i = 0; _i < 2; ++_i) \
        __builtin_amdgcn_global_load_lds((const unsigned*)((const char*)(gbase) + (voff)[_i]), (PG8_LAS unsigned*)(lds + (bufoff) + ldsw + _i * 8192), 16, 0, 0); } while (0)
#define PG8_LDA(dst, b, h) do { _Pragma("unroll") for (int m = 0; m < 4; ++m) _Pragma("unroll") for (int k = 0; k < 2; ++k) dst[m][k] = *(const PG8_LAS bf16x8*)(lds + PG8_SA(b, h) + aoff + m * 2048 + k * 1024); } while (0)
#define PG8_LDB(dst, b, h) do { _Pragma("unroll") for (int n = 0; n < 2; ++n) _Pragma("unroll") for (int k = 0; k < 2; ++k) dst[n][k] = *(const PG8_LAS bf16x8*)(lds + PG8_SB(b, h) + boff + n * 2048 + k * 1024); } while (0)
#define PG8_MMA(ai, bj, At, Bt) do { __builtin_amdgcn_s_setprio(1); _Pragma("unroll") for (int m = 0; m < 4; ++m) _Pragma("unroll") for (int n = 0; n < 2; ++n) _Pragma("unroll") for (int k = 0; k < 2; ++k) \
        acc[ai][bj][m][n] = __builtin_amdgcn_mfma_f32_16x16x32_bf16(Bt[n][k], At[m][k], acc[ai][bj][m][n], 0, 0, 0); __builtin_amdgcn_s_setprio(0); } while (0)
#define PG8_WAIT_V(n) asm volatile("s_waitcnt vmcnt(" #n ")" ::: "memory")
#define PG8_WAIT_L(n) asm volatile("s_waitcnt lgkmcnt(" #n ")" ::: "memory")
#define PG8_BAR __builtin_amdgcn_s_barrier()
#define PG8_SCHED __builtin_amdgcn_sched_barrier(0)
    Unit cur, nxt; int ui = 0;
    if (!S.next(0, cur)) return;
    f32x4 acc[2][2][4][2];
#pragma unroll
    for (int a = 0; a < 2; ++a)
#pragma unroll
        for (int b = 0; b < 2; ++b)
#pragma unroll
            for (int m = 0; m < 4; ++m)
#pragma unroll
                for (int n = 0; n < 2; ++n) acc[a][b][m][n] = (f32x4){0.f, 0.f, 0.f, 0.f};
    bf16x8 At[4][2], B0[2][2], B1[2][2];
    const char* cA = (const char*)g.A + PG8_AIDX(g, cur.pn) + (size_t)cur.pm * tstep; const char* cB = (const char*)g.Bt + (size_t)cur.pn * tstep;
    S.a_ready(cur);
    if constexpr (SP2) {
        PG8_STAGE(PG8_SB(0, 0), cB, voffB); PG8_STAGE(PG8_SB(0, 1), cB + hstep, voffB); PG8_STAGE(PG8_SA(0, 0), cA, voffA); PG8_STAGE(PG8_SA(0, 1), cA + hstep, voffA);
        if (wr == 1) PG8_BAR;
        PG8_WAIT_V(2); PG8_BAR;
        PG8_STAGE(PG8_SB(1, 0), cB + kstep, voffB); PG8_STAGE(PG8_SA(1, 0), cA + kstep, voffA); PG8_STAGE(PG8_SB(1, 1), cB + hstep + kstep, voffB);
        PG8_WAIT_V(6); PG8_BAR;
    } else {
        PG8_STAGE(PG8_SB(0, 0), cB, voffB); PG8_STAGE(PG8_SA(0, 0), cA, voffA); PG8_STAGE(PG8_SB(0, 1), cB + hstep, voffB); PG8_STAGE(PG8_SA(0, 1), cA + hstep, voffA);
        if (wr == 1) PG8_BAR;
        PG8_WAIT_V(4); PG8_BAR;
        PG8_STAGE(PG8_SB(1, 0), cB + kstep, voffB); PG8_STAGE(PG8_SA(1, 0), cA + kstep, voffA); PG8_STAGE(PG8_SB(1, 1), cB + hstep + kstep, voffB);
        PG8_WAIT_V(6); PG8_BAR;
    }
    for (;;) {
        const bool has_next = S.next(ui + 1, nxt);
        const char* nA = has_next ? (const char*)g.A + PG8_AIDX(g, nxt.pn) + (size_t)nxt.pm * tstep : cA; const char* nB = has_next ? (const char*)g.Bt + (size_t)nxt.pn * tstep : cB;
        for (int t = 0; t < nt; t += 2) {
            const bool last = (t == nt - 2);
            const char* a1 = cA + (size_t)(t + 1) * kstep;
            const char* a2 = last ? nA : cA + (size_t)(t + 2) * kstep; const char* b2 = last ? nB : cB + (size_t)(t + 2) * kstep;
            const char* a3 = a2 + kstep; const char* b3 = b2 + kstep;
            if (last && has_next) S.a_ready(nxt);
            if constexpr (SP2) {
            PG8_LDB(B0, 0, 0); PG8_LDB(B1, 0, 1); PG8_SCHED; PG8_LDA(At, 0, 0); PG8_STAGE(PG8_SA(1, 1), a1 + hstep, voffA);
            PG8_WAIT_V(8); PG8_WAIT_L(0); PG8_BAR; PG8_MMA(0, 0, At, B0); PG8_MMA(0, 1, At, B1); PG8_BAR; PG8_SCHED;
            PG8_LDA(At, 0, 1); PG8_STAGE(PG8_SB(0, 0), b2, voffB); PG8_STAGE(PG8_SB(0, 1), b2 + hstep, voffB); PG8_STAGE(PG8_SA(0, 0), a2, voffA);
            PG8_WAIT_V(8); PG8_WAIT_L(0); PG8_BAR; PG8_MMA(1, 0, At, B0); PG8_MMA(1, 1, At, B1); PG8_BAR; PG8_SCHED;
            PG8_LDB(B0, 1, 0); PG8_LDB(B1, 1, 1); PG8_SCHED; PG8_LDA(At, 1, 0); PG8_STAGE(PG8_SA(0, 1), a2 + hstep, voffA);
            PG8_WAIT_V(8); PG8_WAIT_L(0); PG8_BAR; PG8_MMA(0, 0, At, B0); PG8_MMA(0, 1, At, B1); PG8_BAR; PG8_SCHED;
            PG8_LDA(At, 1, 1); PG8_STAGE(PG8_SB(1, 0), b3, voffB); PG8_STAGE(PG8_SB(1, 1), b3 + hstep, voffB); PG8_STAGE(PG8_SA(1, 0), a3, voffA);
            PG8_WAIT_V(8); PG8_WAIT_L(0); PG8_BAR; PG8_MMA(1, 0, At, B0); PG8_MMA(1, 1, At, B1); PG8_BAR; PG8_SCHED;
            } else {
            PG8_LDB(B0, 0, 0); PG8_SCHED; PG8_LDA(At, 0, 0); PG8_STAGE(PG8_SA(1, 1), a1 + hstep, voffA);
            PG8_WAIT_L(8); PG8_BAR; PG8_WAIT_L(0); PG8_MMA(0, 0, At, B0); PG8_BAR; PG8_SCHED;
            PG8_LDB(B1, 0, 1); PG8_STAGE(PG8_SB(0, 0), b2, voffB);
            PG8_BAR; PG8_WAIT_L(0); PG8_MMA(0, 1, At, B1); PG8_BAR;
            PG8_LDA(At, 0, 1); PG8_STAGE(PG8_SA(0, 0), a2, voffA);
            PG8_BAR; PG8_WAIT_L(0); PG8_MMA(1, 0, At, B0); PG8_BAR; PG8_SCHED;
            PG8_STAGE(PG8_SB(0, 1), b2 + hstep, voffB);
            PG8_WAIT_V(6); PG8_BAR; PG8_MMA(1, 1, At, B1); PG8_BAR;
            PG8_LDB(B0, 1, 0); PG8_SCHED; PG8_LDA(At, 1, 0); PG8_STAGE(PG8_SA(0, 1), a2 + hstep, voffA);
            PG8_WAIT_L(8); PG8_BAR; PG8_WAIT_L(0); PG8_MMA(0, 0, At, B0); PG8_BAR; PG8_SCHED;
            PG8_LDB(B1, 1, 1); PG8_STAGE(PG8_SB(1, 0), b3, voffB);
            PG8_BAR; PG8_WAIT_L(0); PG8_MMA(0, 1, At, B1); PG8_BAR;
            PG8_LDA(At, 1, 1); PG8_STAGE(PG8_SA(1, 0), a3, voffA);
            PG8_BAR; PG8_WAIT_L(0); PG8_MMA(1, 0, At, B0); PG8_BAR; PG8_SCHED;
            PG8_STAGE(PG8_SB(1, 1), b3 + hstep, voffB);
            PG8_WAIT_V(6); PG8_BAR; PG8_MMA(1, 1, At, B1); PG8_BAR;
            }
        }
        if constexpr (ALIGN_EPI) { if (wr == 0) PG8_BAR; }
        if constexpr (!Epi::AFTER_DRAIN) { E(acc, cur, wr, wc, fr, fq); S.done(cur); }
        if (!has_next) break;
#pragma unroll
        for (int a = 0; a < 2; ++a)
#pragma unroll
            for (int b = 0; b < 2; ++b)
#pragma unroll
                for (int m = 0; m < 4; ++m)
#pragma unroll
                    for (int n = 0; n < 2; ++n) acc[a][b][m][n] = (f32x4){0.f, 0.f, 0.f, 0.f};
        cur = nxt; cA = nA; cB = nB; ++ui;
        if constexpr (ALIGN_EPI) { if (wr == 1) PG8_BAR; }
    }
    PG8_WAIT_V(0);
    if constexpr (!ALIGN_EPI) { if (wr == 0) PG8_BAR; }
    PG8_BAR;
    if constexpr (Epi::AFTER_DRAIN) { E.fused(acc, cur, wr, wc, fr, fq, lds, wid, lane); S.done(cur); }
#undef PG8_SA
#undef PG8_SB
#undef PG8_STAGE
#undef PG8_LDA
#undef PG8_LDB
#undef PG8_MMA
#undef PG8_WAIT_V
#undef PG8_WAIT_L
#undef PG8_BAR
#undef PG8_SCHED
}
}

#define LAS __attribute__((address_space(3)))
typedef unsigned short bf16;
typedef short bf16x8 __attribute__((ext_vector_type(8)));
typedef float f32x4 __attribute__((ext_vector_type(4)));
typedef float f32x16 __attribute__((ext_vector_type(16)));
typedef unsigned u32x4 __attribute__((ext_vector_type(4)));
typedef unsigned u32x2 __attribute__((ext_vector_type(2)));

constexpr int NT = 512;
constexpr int LDS_BYTES = 147456;
constexpr size_t MiB = 1u << 20;
constexpr size_t WS_MOD = 0;
constexpr size_t MOD_BYTES = 2 * 9 * 6144 * 4;
constexpr size_t WS_QP = 1 * MiB;
constexpr size_t WS_W2T = 3 * MiB;
constexpr size_t WS_A2T = WS_W2T + 2 * 4096 * 96 * 2;
constexpr size_t WS_XC = 6 * MiB;
constexpr size_t WS_WB = 22 * MiB;
constexpr size_t WB_L0_IN = WS_WB, WB_L0_GLU = WS_WB + 32 * MiB, WB_L0_OUT = WS_WB + 64 * MiB;
constexpr size_t WB_L1_IN = WS_WB, WB_L1_OUT = WS_WB + 66 * MiB;
constexpr size_t WS_BIG = 106 * MiB;
constexpr size_t WS_U = WS_BIG, WS_Z = WS_BIG + 144 * MiB, WS_Y = WS_BIG + 288 * MiB;
constexpr size_t WS_H1 = WS_BIG, WS_A = WS_BIG + 36 * MiB, WS_RKV = WS_BIG + 144 * MiB, WS_ZB = WS_BIG + 360 * MiB;
constexpr size_t WS_END = WS_BIG + 432 * MiB;
constexpr size_t A_STRIDE = (size_t)9216 * 2048 * 2;
constexpr size_t WS_YP = WS_A;
constexpr size_t ZB_LW = 0, ZB_LA = (size_t)9216 * 192 * 2;

struct Params { const float* in[37]; float* out; unsigned char* ws; };
typedef const __attribute__((address_space(4))) Params* PPtr;
#define GETP PPtr P = (PPtr)__builtin_amdgcn_kernarg_segment_ptr(); asm volatile("" : "+s"(P));

__device__ __forceinline__ unsigned f2bf(float f) { unsigned u = __builtin_bit_cast(unsigned, f); return (u + 0x7fffu + ((u >> 16) & 1u)) >> 16; }
__device__ __forceinline__ unsigned pk2(float lo, float hi) { return f2bf(lo) | (f2bf(hi) << 16); }
__device__ __forceinline__ float bf2f(unsigned h) { return __builtin_bit_cast(float, h << 16); }
__device__ __forceinline__ float blo(unsigned w) { return __builtin_bit_cast(float, w << 16); }
__device__ __forceinline__ float bhi(unsigned w) { return __builtin_bit_cast(float, w & 0xffff0000u); }
__device__ __forceinline__ float wave_sum(float v) {
#pragma unroll
    for (int o = 1; o < 64; o <<= 1) v += __shfl_xor(v, o);
    return v;
}
#define DPPF(v, ctrl) __builtin_bit_cast(float, __builtin_amdgcn_update_dpp(0, __builtin_bit_cast(int, (v)), (ctrl), 0xF, 0xF, true))
__device__ __forceinline__ float red8(float v) { v += DPPF(v, 0xB1); v += DPPF(v, 0x4E); v += DPPF(v, 0x141); return v; }
__device__ __forceinline__ float red16(float v) { v = red8(v); v += DPPF(v, 0x128); return v; }
__device__ __forceinline__ float sigmoidf_(float x) { return 1.0f / (1.0f + __expf(-x)); }

__device__ __forceinline__ void transpose_item(const float* W, int K, int N, bf16* WT, int row_off, LAS float* scr, int item, int lane) {
    const int nblk = N / 32, kb = item / nblk, nb = item % nblk, k0 = 64 * kb, n0 = 32 * nb;
#pragma unroll 8
    for (int i = 0; i < 32; ++i) { const int kk = 2 * i + (lane >> 5); scr[kk * 33 + (lane & 31)] = W[(size_t)(k0 + kk) * N + n0 + (lane & 31)]; }
    asm volatile("s_waitcnt lgkmcnt(0)" ::: "memory");
    const int c = lane & 7;
#pragma unroll
    for (int j = 0; j < 4; ++j) { const int n = (lane >> 3) + 8 * j; const LAS float* s = scr + (8 * c) * 33 + n;
        u32x4 o; o.x = pk2(s[0 * 33], s[1 * 33]); o.y = pk2(s[2 * 33], s[3 * 33]); o.z = pk2(s[4 * 33], s[5 * 33]); o.w = pk2(s[6 * 33], s[7 * 33]);
        *(u32x4*)(WT + (size_t)(row_off + n0 + n) * K + k0 + 8 * c) = o; }
    asm volatile("s_waitcnt lgkmcnt(0)" ::: "memory");
}

__device__ __forceinline__ void mod_task(PPtr P, float* MOD, LAS float* sil, int tk, int tid) {
    const int layer = tk / 192, rem = tk % 192, ks = rem / 12, nb = rem % 12;
    const float* ada_w = P->in[layer ? 20 : 5]; const float* ada_b = P->in[layer ? 21 : 6];
    const float* c = P->in[1]; const float* cc = P->in[3];
    const int k0 = ks * 128, n = nb * 512 + tid;
    __syncthreads();
    for (int idx = tid; idx < 128 * 9; idx += NT) { const int k = idx / 9, j = idx % 9; const float v = (j < 8) ? c[j * 2048 + k0 + k] : cc[k0 + k]; sil[idx] = v * sigmoidf_(v); }
    __syncthreads();
    float acc[9];
#pragma unroll
    for (int j = 0; j < 9; ++j) acc[j] = 0.f;
#pragma unroll 4
    for (int k = 0; k < 128; ++k) { const float w = ada_w[(size_t)(k0 + k) * 6144 + n];
#pragma unroll
        for (int j = 0; j < 9; ++j) acc[j] += sil[k * 9 + j] * w; }
    const float bb = (ks == 0) ? ada_b[n] : 0.f;
#pragma unroll
    for (int j = 0; j < 9; ++j) atomicAdd(MOD + (size_t)(layer * 9 + j) * 6144 + n, acc[j] + bb);
}

__device__ __forceinline__ void normmod_row(const float* xrow, const float* g, const float* mod  , bf16* orow, int lane) {
    f32x4 v[8]; float s = 0.f;
#pragma unroll
    for (int j = 0; j < 8; ++j) { v[j] = ((const f32x4*)xrow)[lane + 64 * j]; s += (v[j].x * v[j].x + v[j].y * v[j].y) + (v[j].z * v[j].z + v[j].w * v[j].w); }
    const float rstd = 1.0f / sqrtf(wave_sum(s) * (1.0f / 2048.0f) + 1e-6f);
#pragma unroll
    for (int j = 0; j < 8; ++j) { const int c4 = lane + 64 * j; const f32x4 gg = ((const f32x4*)g)[c4], sh = ((const f32x4*)mod)[c4], sc = ((const f32x4*)(mod + 2048))[c4];
        const f32x4 y = v[j] * rstd * gg * (sc + 1.0f) + sh;
        u32x2 o; o.x = pk2(y.x, y.y); o.y = pk2(y.z, y.w); ((u32x2*)orow)[c4] = o; }
}

constexpr int S5_ROWB = 528;
constexpr int S5_WLDS = 32 * S5_ROWB;
__device__ __forceinline__ float gelu_tanh(float x) { const float u = 0.7978845608028654f * (x + 0.044715f * x * x * x); const float e = __expf(2.0f * u); return 0.5f * x * (2.0f - 2.0f / (1.0f + e)); }

__device__ __forceinline__ void s5_phase(PPtr P, LAS unsigned char* lds, int wave, int lane) {
    const float* a_re = P->in[8]; const float* a_im = P->in[9]; const float* lstep = P->in[10];
    const float* b_re = P->in[11]; const float* b_im = P->in[12]; const float* c_re = P->in[13]; const float* c_im = P->in[14]; const float* dskip = P->in[15];
    const bf16* U = (const bf16*)(P->ws + WS_U); bf16* Y = (bf16*)(P->ws + WS_Y);
    LAS unsigned char* wl = lds + wave * S5_WLDS;
    const int d = wave >> 2;
    for (int round = blockIdx.x; round < 512; round += gridDim.x) {
        const int unit = round * 4 + (wave & 3), b = unit >> 8, g = unit & 255, dg = d * 256 + g;
        const float dt = expf(lstep[dg]);
        float abr, abi;
        { const float are = a_re[dg * 64 + lane], aim = a_im[dg * 64 + lane]; const float mag = expf(dt * are); abr = mag * cosf(dt * aim); abi = mag * sinf(dt * aim); }
        bf16x8 Bf[4];
#pragma unroll
        for (int nn = 0; nn < 2; ++nn) {
            const int n = (lane & 31) + 32 * nn; const float are = a_re[dg * 64 + n], aim = a_im[dg * 64 + n];
            const float mag = expf(dt * are), cr = mag * cosf(dt * aim), ci = mag * sinf(dt * aim), den = are * are + aim * aim, nr = cr - 1.0f, ni = ci;
            const float fre = (nr * are + ni * aim) / den, fim = (ni * are - nr * aim) / den;
            const float* br = b_re + ((size_t)dg * 64 + n) * 16 + 8 * (lane >> 5); const float* bi = b_im + ((size_t)dg * 64 + n) * 16 + 8 * (lane >> 5);
#pragma unroll
            for (int j = 0; j < 8; ++j) { const float xr = br[j], xi = bi[j]; Bf[nn][j] = (short)f2bf(fre * xr - fim * xi); Bf[2 + nn][j] = (short)f2bf(fre * xi + fim * xr); }
        }
        bf16x8 Cf[4];
#pragma unroll
        for (int ks = 0; ks < 4; ++ks) { const int k = 32 * ks + 8 * (lane >> 4); const int o = lane & 15;
            const float* src = (ks < 2) ? (c_re + ((size_t)dg * 16 + o) * 64 + k) : (c_im + ((size_t)dg * 16 + o) * 64 + (k - 64)); const float sg = (ks < 2) ? 1.0f : -1.0f;
#pragma unroll
            for (int j = 0; j < 8; ++j) Cf[ks][j] = (short)f2bf(sg * src[j]); }
        const float dsk = dskip[g * 16 + (lane & 15)];
        float hr = 0.f, hi = 0.f;
        for (int cs = 0; cs < 72; ++cs) {
            const bool isctx = cs < 8; const int ci = isctx ? cs : cs - 8, nch = isctx ? 8 : 64;
            const int tc = d ? (nch - 1 - ci) : ci; const bool first = ci < (nch >> 1);
            const size_t rowbase = isctx ? (size_t)b * 256 : (size_t)2048 + (size_t)b * 2048;
            { const int i = lane & 31; const int t = 32 * tc + (d ? 31 - i : i);
              const bf16x8 Af = *(const bf16x8*)(U + (rowbase + t) * 4096 + g * 16 + 8 * (lane >> 5));
#pragma unroll
              for (int tl = 0; tl < 4; ++tl) { f32x16 z16; for (int q = 0; q < 16; ++q) z16[q] = 0.f;
                  const f32x16 r = __builtin_amdgcn_mfma_f32_32x32x16_bf16(Af, Bf[tl], z16, 0, 0, 0);
#pragma unroll
                  for (int reg = 0; reg < 16; ++reg) { const int ii = (reg & 3) + 8 * (reg >> 2) + 4 * (lane >> 5);
                      *(LAS float*)(wl + ii * S5_ROWB + (32 * tl + (lane & 31)) * 4) = r[reg]; } } }
#pragma unroll 4
            for (int i = 0; i < 32; ++i) { const float re = *(LAS float*)(wl + i * S5_ROWB + lane * 4), im = *(LAS float*)(wl + i * S5_ROWB + (64 + lane) * 4);
                const float nhr = abr * hr - abi * hi + re, nhi = abr * hi + abi * hr + im; hr = nhr; hi = nhi;
                *(LAS unsigned short*)(wl + i * S5_ROWB + lane * 2) = (unsigned short)f2bf(hr); *(LAS unsigned short*)(wl + i * S5_ROWB + (64 + lane) * 2) = (unsigned short)f2bf(hi); }
#pragma unroll
            for (int mt = 0; mt < 2; ++mt) { f32x4 yv = {0.f, 0.f, 0.f, 0.f};
#pragma unroll
                for (int ks = 0; ks < 4; ++ks) { const bf16x8 Af = *(const LAS bf16x8*)(wl + (16 * mt + (lane & 15)) * S5_ROWB + (32 * ks + 8 * (lane >> 4)) * 2);
                    yv = __builtin_amdgcn_mfma_f32_16x16x32_bf16(Af, Cf[ks], yv, 0, 0, 0); }
#pragma unroll
                for (int reg = 0; reg < 4; ++reg) { const int i = 16 * mt + 4 * (lane >> 4) + reg; const int t = 32 * tc + (d ? 31 - i : i);
                    const size_t pos = (rowbase + t) * 4096 + g * 16 + (lane & 15);
                    if (first) Y[pos] = (bf16)f2bf(yv[reg]);
                    else { const float tot = yv[reg] + bf2f(Y[pos]) + dsk * bf2f(U[pos]); Y[pos] = (bf16)f2bf(gelu_tanh(tot)); } } }
            __threadfence();
            __syncthreads();
        }
    }
}

constexpr int RW_ARR = 16 * 64 * 4, RW_DIR = 7 * RW_ARR + 64;
__device__ __forceinline__ void rwkv_phase(PPtr P, LAS unsigned char* lds, int hb, int tid) {
    const float* w0 = P->in[24]; const float* a0 = P->in[27]; const float* k_k = P->in[30]; const float* k_a = P->in[31]; const float* r_k = P->in[32];
    const float* ln_w = P->in[33]; const float* ln_b = P->in[34];
    const bf16* RB = (const bf16*)(P->ws + WS_RKV); const bf16* KB = RB + (size_t)9216 * 4096; const bf16* VB = KB + (size_t)9216 * 4096;
    bf16* ZB = (bf16*)(P->ws + WS_ZB); const bf16* LW = (const bf16*)(P->ws + WS_ZB + ZB_LW); const bf16* LA = (const bf16*)(P->ws + WS_ZB + ZB_LA);
    const bf16* W2T = (const bf16*)(P->ws + WS_W2T); const bf16* A2T = (const bf16*)(P->ws + WS_A2T);
    bf16* YP = (bf16*)(P->ws + WS_YP); float* QP = (float*)(P->ws + WS_QP);
    const int d = tid >> 8, lt = tid & 255, lane = tid & 63, wv = (tid >> 6) & 3;
    LAS unsigned char* dl = lds + d * RW_DIR;
    LAS float* aW = (LAS float*)(dl); LAS float* aA = (LAS float*)(dl + RW_ARR); LAS float* aB = (LAS float*)(dl + 2 * RW_ARR); LAS float* aKD = (LAS float*)(dl + 3 * RW_ARR);
    LAS float* aR = (LAS float*)(dl + 4 * RW_ARR); LAS float* aV = (LAS float*)(dl + 5 * RW_ARR); LAS float* aY = (LAS float*)(dl + 6 * RW_ARR); LAS float* aQ = (LAS float*)(dl + 7 * RW_ARR);
    for (int pr = blockIdx.x; pr < 256; pr += gridDim.x) {
        const int bl = pr >> 6, h = pr & 63;
        bf16x8 Bw[3], Ba[3];
        { const size_t rowo = ((size_t)d * 4096 + h * 64 + 16 * wv + (lane & 15)) * 96 + 8 * (lane >> 4);
#pragma unroll
          for (int ks = 0; ks < 3; ++ks) { Bw[ks] = *(const bf16x8*)(W2T + rowo + 32 * ks); Ba[ks] = *(const bf16x8*)(A2T + rowo + 32 * ks); } }
        const int hn1 = h * 64 + 16 * wv + (lane & 15);
        const float w0v = w0[d * 4096 + hn1], a0v = a0[d * 4096 + hn1];
        const int pi = lt >> 4, nq = lt & 15, hn4 = h * 64 + 4 * nq;
        const f32x4 kk4 = *(const f32x4*)(k_k + hn4), ka4 = *(const f32x4*)(k_a + hn4), rk4 = *(const f32x4*)(r_k + hn4), lw4 = *(const f32x4*)(ln_w + hn4), lb4 = *(const f32x4*)(ln_b + hn4);
        const int rg = lt >> 3, kg = lt & 7;
        float S0[8], S1[8];
#pragma unroll
        for (int k = 0; k < 8; ++k) { S0[k] = 0.f; S1[k] = 0.f; }
        for (int cs = 0; cs < 144; ++cs) {
            const bool isctx = cs < 16; const int ci = isctx ? cs : cs - 16, nch = isctx ? 16 : 128;
            const int tc = d ? (nch - 1 - ci) : ci; const bool first = ci < 64;
            const size_t rowbase = isctx ? (size_t)bl * 256 : (size_t)1024 + (size_t)bl * 2048;
            { const int i = lane & 15; const int t = 16 * tc + (d ? 15 - i : i); const size_t row = rowbase + t;
              const bf16* lwr = LW + row * 192 + d * 96 + 8 * (lane >> 4); const bf16* lar = LA + row * 192 + d * 96 + 8 * (lane >> 4);
              f32x4 cw = {0.f, 0.f, 0.f, 0.f}, ca = {0.f, 0.f, 0.f, 0.f};
#pragma unroll
              for (int ks = 0; ks < 3; ++ks) { const bf16x8 Aw = *(const bf16x8*)(lwr + 32 * ks), Aa = *(const bf16x8*)(lar + 32 * ks);
                  cw = __builtin_amdgcn_mfma_f32_16x16x32_bf16(Aw, Bw[ks], cw, 0, 0, 0); ca = __builtin_amdgcn_mfma_f32_16x16x32_bf16(Aa, Ba[ks], ca, 0, 0, 0); }
#pragma unroll
              for (int reg = 0; reg < 4; ++reg) { const int ii = 4 * (lane >> 4) + reg; const int n = 16 * wv + (lane & 15);
                  const float x = -(w0v + cw[reg]);
                  const float sp = fmaxf(x, 0.f) + log1pf(__expf(-fabsf(x)));
                  const float wlog = -sp - 0.5f; const float dec = __expf(-__expf(wlog));
                  aW[ii * 64 + n] = dec; aB[ii * 64 + n] = sigmoidf_(a0v + ca[reg]); } }
            __syncthreads();
            { const int t = 16 * tc + (d ? 15 - pi : pi); const size_t off = (rowbase + t) * 4096 + hn4;
              const u32x2 kr = *(const u32x2*)(KB + off), rr = *(const u32x2*)(RB + off), vr = *(const u32x2*)(VB + off);
              const f32x4 k4 = {blo(kr.x), bhi(kr.x), blo(kr.y), bhi(kr.y)}, r4 = {blo(rr.x), bhi(rr.x), blo(rr.y), bhi(rr.y)}, v4 = {blo(vr.x), bhi(vr.x), blo(vr.y), bhi(vr.y)};
              f32x4 kk = k4 * kk4; float ss = (kk.x * kk.x + kk.y * kk.y) + (kk.z * kk.z + kk.w * kk.w); ss = red16(ss);
              const float inv = 1.0f / fmaxf(sqrtf(ss), 1e-12f); kk = kk * inv;
              const f32x4 ar = *(LAS f32x4*)(aB + pi * 64 + 4 * nq);
              const f32x4 kd = k4 * ((ar - 1.0f) * ka4 + 1.0f);
              *(LAS f32x4*)(aA + pi * 64 + 4 * nq) = -kk; *(LAS f32x4*)(aB + pi * 64 + 4 * nq) = kk * ar; *(LAS f32x4*)(aKD + pi * 64 + 4 * nq) = kd;
              *(LAS f32x4*)(aR + pi * 64 + 4 * nq) = r4; *(LAS f32x4*)(aV + pi * 64 + 4 * nq) = v4;
              const f32x4 qq = r4 * kd * rk4; float q = (qq.x + qq.y) + (qq.z + qq.w); q = red16(q); if (nq == 0) aQ[pi] = q; }
            __syncthreads();
#pragma unroll 2
            for (int i = 0; i < 16; ++i) {
                const f32x4 w_0 = *(LAS f32x4*)(aW + i * 64 + 8 * kg), w_1 = *(LAS f32x4*)(aW + i * 64 + 8 * kg + 4);
                const f32x4 a_0 = *(LAS f32x4*)(aA + i * 64 + 8 * kg), a_1 = *(LAS f32x4*)(aA + i * 64 + 8 * kg + 4);
                const f32x4 b_0 = *(LAS f32x4*)(aB + i * 64 + 8 * kg), b_1 = *(LAS f32x4*)(aB + i * 64 + 8 * kg + 4);
                const f32x4 k_0 = *(LAS f32x4*)(aKD + i * 64 + 8 * kg), k_1 = *(LAS f32x4*)(aKD + i * 64 + 8 * kg + 4);
                const float vv0 = aV[i * 64 + 2 * rg], vv1 = aV[i * 64 + 2 * rg + 1];
                const float wv_[8] = {w_0.x, w_0.y, w_0.z, w_0.w, w_1.x, w_1.y, w_1.z, w_1.w};
                const float av_[8] = {a_0.x, a_0.y, a_0.z, a_0.w, a_1.x, a_1.y, a_1.z, a_1.w};
                const float bv_[8] = {b_0.x, b_0.y, b_0.z, b_0.w, b_1.x, b_1.y, b_1.z, b_1.w};
                const float kv_[8] = {k_0.x, k_0.y, k_0.z, k_0.w, k_1.x, k_1.y, k_1.z, k_1.w};
                float sa0 = 0.f, sa1 = 0.f;
#pragma unroll
                for (int k = 0; k < 8; ++k) { sa0 += S0[k] * av_[k]; sa1 += S1[k] * av_[k]; }
                sa0 = red8(sa0); sa1 = red8(sa1);
#pragma unroll
                for (int k = 0; k < 8; ++k) { S0[k] = S0[k] * wv_[k] + sa0 * bv_[k] + vv0 * kv_[k]; S1[k] = S1[k] * wv_[k] + sa1 * bv_[k] + vv1 * kv_[k]; }
                if (!isctx) {
                    const f32x4 r_0 = *(LAS f32x4*)(aR + i * 64 + 8 * kg), r_1 = *(LAS f32x4*)(aR + i * 64 + 8 * kg + 4);
                    const float rv_[8] = {r_0.x, r_0.y, r_0.z, r_0.w, r_1.x, r_1.y, r_1.z, r_1.w};
                    float y0 = 0.f, y1 = 0.f;
#pragma unroll
                    for (int k = 0; k < 8; ++k) { y0 += S0[k] * rv_[k]; y1 += S1[k] * rv_[k]; }
                    y0 = red8(y0); y1 = red8(y1);
                    if (kg == 0) { aY[i * 64 + 2 * rg] = y0; aY[i * 64 + 2 * rg + 1] = y1; }
                }
            }
            __syncthreads();
            if (!isctx) {
                const int t = 16 * tc + (d ? 15 - pi : pi); const size_t rl = (size_t)bl * 2048 + t;
                const f32x4 y4 = *(LAS f32x4*)(aY + pi * 64 + 4 * nq);
                if (first) {
                    u32x2 o; o.x = pk2(y4.x, y4.y); o.y = pk2(y4.z, y4.w); *(u32x2*)(YP + rl * 4096 + hn4) = o;
                    if (nq == 0) QP[rl * 64 + h] = aQ[pi];
                } else {
                    const u32x2 pp = *(const u32x2*)(YP + rl * 4096 + hn4);
                    const f32x4 ys = {y4.x + blo(pp.x), y4.y + bhi(pp.x), y4.z + blo(pp.y), y4.w + bhi(pp.y)};
                    float sm = (ys.x + ys.y) + (ys.z + ys.w); sm = red16(sm); const float mean = sm * (1.0f / 64.0f);
                    const f32x4 dv = ys - mean; float vs = (dv.x * dv.x + dv.y * dv.y) + (dv.z * dv.z + dv.w * dv.w); vs = red16(vs);
                    const float rstd = 1.0f / sqrtf(vs * (1.0f / 64.0f) + 64e-5f);
                    const float q = aQ[pi] + QP[rl * 64 + h];
                    const f32x4 v4 = *(LAS f32x4*)(aV + pi * 64 + 4 * nq);
                    const f32x4 val = dv * rstd * lw4 + lb4 + v4 * q;
                    bf16* zp = ZB + (1024 + rl) * 4096 + hn4; const u32x2 zr = *(const u32x2*)zp;
                    const float z0 = blo(zr.x), z1 = bhi(zr.x), z2 = blo(zr.y), z3 = bhi(zr.y);
                    u32x2 o; o.x = pk2(val.x * z0 * sigmoidf_(z0), val.y * z1 * sigmoidf_(z1)); o.y = pk2(val.z * z2 * sigmoidf_(z2), val.w * z3 * sigmoidf_(z3));
                    *(u32x2*)zp = o;
                }
                __threadfence();
            }
        }
        __syncthreads();
    }
}

__device__ __forceinline__ void mix_phase(PPtr P, int i0, int i1, int i2, int gtid, int gthreads) {
    const bf16* H = (const bf16*)(P->ws + WS_H1); const float* mu = P->in[22];
    bf16* A0 = (bf16*)(P->ws + WS_A); bf16* A1 = (bf16*)(P->ws + WS_A + A_STRIDE); bf16* A2 = (bf16*)(P->ws + WS_A + 2 * A_STRIDE);
    for (int idx = gtid; idx < 9216 * 256; idx += gthreads) {
        const int row = idx >> 8, c0 = (idx & 255) * 8;
        int nrow = -1;
        if (row < 1024) { const int t = row & 255; if (c0 < 1024) { if (t > 0) nrow = row - 1; } else { if (t < 255) nrow = row + 1; } }
        else { const int t = (row - 1024) & 2047, gx = t & 63, gy = t >> 6, qd = c0 >> 9;
            if (qd == 0) { if (gx > 0) nrow = row - 1; } else if (qd == 1) { if (gx < 63) nrow = row + 1; } else if (qd == 2) { if (gy > 0) nrow = row - 64; } else { if (gy < 31) nrow = row + 64; } }
        const u32x4 hv = *(const u32x4*)(H + (size_t)row * 2048 + c0);
        u32x4 sv = {0u, 0u, 0u, 0u}; if (nrow >= 0) sv = *(const u32x4*)(H + (size_t)nrow * 2048 + c0);
        const float hf[8] = {blo(hv.x), bhi(hv.x), blo(hv.y), bhi(hv.y), blo(hv.z), bhi(hv.z), blo(hv.w), bhi(hv.w)};
        const float sf[8] = {blo(sv.x), bhi(sv.x), blo(sv.y), bhi(sv.y), blo(sv.z), bhi(sv.z), blo(sv.w), bhi(sv.w)};
#pragma unroll
        for (int q = 0; q < 3; ++q) { const int mi = q == 0 ? i0 : (q == 1 ? i1 : i2); bf16* dst = q == 0 ? A0 : (q == 1 ? A1 : A2);
            const f32x4 m0 = *(const f32x4*)(mu + mi * 2048 + c0), m1 = *(const f32x4*)(mu + mi * 2048 + c0 + 4);
            const float mm[8] = {m0.x, m0.y, m0.z, m0.w, m1.x, m1.y, m1.z, m1.w};
            float o[8];
#pragma unroll
            for (int e = 0; e < 8; ++e) o[e] = hf[e] + (sf[e] - hf[e]) * mm[e];
            u32x4 w; w.x = pk2(o[0], o[1]); w.y = pk2(o[2], o[3]); w.z = pk2(o[4], o[5]); w.w = pk2(o[6], o[7]);
            *(u32x4*)(dst + (size_t)row * 2048 + c0) = w; }
    }
}

__global__ void __launch_bounds__(NT, 2) fwd_megakernel(Params Pk) {
    extern __shared__ __attribute__((aligned(16))) unsigned char lds_raw[];
    LAS unsigned char* lds = (LAS unsigned char*)lds_raw;
    cg::grid_group grid = cg::this_grid();
    const int G = gridDim.x, NGW = G * 8, gthreads = G * NT;
#define TID_VARS GETP unsigned char* ws = P->ws; float* MOD = (float*)(ws + WS_MOD); (void)MOD; int tid = threadIdx.x; asm volatile("" : "+v"(tid)); const int lane = tid & 63, wave = __builtin_amdgcn_readfirstlane(tid >> 6); const int gw = blockIdx.x * 8 + wave, gtid = blockIdx.x * NT + tid; LAS float* scr = (LAS float*)(lds + wave * 16384); (void)lane; (void)gw; (void)gtid; (void)scr;

    { TID_VARS
      for (int tk = blockIdx.x; tk < 384; tk += G) mod_task(P, MOD, (LAS float*)(lds + 8 * 16384), tk, tid);
      constexpr int I_IN = 32 * 256, I_GLU = 64 * 128, I_OUT = 64 * 64;
      for (int it = gw; it < I_IN + I_GLU + I_OUT; it += NGW) { int r = it;
          if (r < I_IN) { transpose_item(P->in[7], 2048, 8192, (bf16*)(ws + WB_L0_IN), 0, scr, r, lane); continue; } r -= I_IN;
          if (r < I_GLU) { transpose_item(P->in[16], 4096, 4096, (bf16*)(ws + WB_L0_GLU), 0, scr, r, lane); continue; } r -= I_GLU;
          transpose_item(P->in[18], 4096, 2048, (bf16*)(ws + WB_L0_OUT), 0, scr, r, lane); } }
    grid.sync();
    { TID_VARS bf16* H0 = (bf16*)P->out;
      for (int m = gw; m < 18432; m += NGW) {
          if (m < 2048) normmod_row(P->in[2] + (size_t)m * 2048, P->in[4], MOD + 8 * 6144, H0 + (size_t)m * 2048, lane);
          else { const int r = m - 2048; normmod_row(P->in[0] + (size_t)r * 2048, P->in[4], MOD + (r >> 11) * 6144, H0 + (size_t)m * 2048, lane); } } }
    grid.sync();
    { GETP unsigned char* ws = P->ws; float* MOD = (float*)(ws + WS_MOD); (void)MOD; pg8::Gemm g{(const bf16*)P->out, (const bf16*)(ws + WB_L0_IN), 18432, 8192, 2048, 0, 1, 1 << 30}; pg8::StaticOrder S; S.init(18432, 8192, G, (int)blockIdx.x);
      pg8::EpiSplitBf16 E{(bf16*)(ws + WS_U), 4096, 4096, (size_t)18432 * 4096};
      pg8::gemm_phase<pg8::EpiSplitBf16, pg8::StaticOrder, true, true>(lds, g, S, E); }
    grid.sync();
    { TID_VARS s5_phase(P, lds, wave, lane); }
    grid.sync();
    { GETP unsigned char* ws = P->ws; float* MOD = (float*)(ws + WS_MOD); (void)MOD; pg8::Gemm g{(const bf16*)(ws + WS_Y), (const bf16*)(ws + WB_L0_GLU), 18432, 4096, 4096, 0, 1, 1 << 30}; pg8::StaticOrder S; S.init(18432, 4096, G, (int)blockIdx.x);
      pg8::EpiGlu E{(const bf16*)(ws + WS_Y), (bf16*)(ws + WS_Z), 4096, P->in[17]};
      pg8::gemm_phase<pg8::EpiGlu, pg8::StaticOrder, true, true>(lds, g, S, E); }
    grid.sync();
    { GETP unsigned char* ws = P->ws; float* MOD = (float*)(ws + WS_MOD); (void)MOD; pg8::Gemm g{(const bf16*)(ws + WS_Z), (const bf16*)(ws + WB_L0_OUT), 18432, 2048, 4096, 0, 1, 1 << 30}; pg8::StaticOrder S; S.init(18432, 2048, G, (int)blockIdx.x);
      pg8::EpiResid E{P->in[0], P->out, P->in[2], (float*)(ws + WS_XC), MOD, 2048, 0};
      pg8::gemm_phase<pg8::EpiResid, pg8::StaticOrder, true, true>(lds, g, S, E); }
    grid.sync();
    { TID_VARS constexpr int I_IN = 32 * 128, I_LO = 32 * 3, I_OUT = 64 * 64; bf16* WIN = (bf16*)(ws + WB_L1_IN);
      for (int it = gw; it < 4 * I_IN + 4 * I_LO + I_OUT; it += NGW) { int r = it;
          if (r < 4 * I_IN) { const int q = r / I_IN; transpose_item(P->in[23] + (size_t)q * 2048 * 4096, 2048, 4096, WIN, q * 4096, scr, r % I_IN, lane); continue; } r -= 4 * I_IN;
          if (r < 2 * I_LO) { const int q = r / I_LO; transpose_item(P->in[25] + (size_t)q * 2048 * 96, 2048, 96, WIN, 16384 + q * 96, scr, r % I_LO, lane); continue; } r -= 2 * I_LO;
          if (r < 2 * I_LO) { const int q = r / I_LO; transpose_item(P->in[28] + (size_t)q * 2048 * 96, 2048, 96, WIN, 16640 + q * 96, scr, r % I_LO, lane); continue; } r -= 2 * I_LO;
          transpose_item(P->in[35], 4096, 2048, (bf16*)(ws + WB_L1_OUT), 0, scr, r, lane); }
      for (int idx = gtid; idx < 2 * 64 * 2048 / 8; idx += gthreads) { const int e = idx * 8, pr = e / 2048, c = e % 2048; const int row = (pr < 64) ? 16576 + pr : 16832 + (pr - 64);
          *(u32x4*)(WIN + (size_t)row * 2048 + c) = (u32x4){0u, 0u, 0u, 0u}; }
      bf16* W2T = (bf16*)(ws + WS_W2T); bf16* A2T = (bf16*)(ws + WS_A2T);
      for (int idx = gtid; idx < 2 * 96 * 4096; idx += gthreads) { const int n = idx & 4095, m = (idx >> 12) % 96, dd = idx / (96 * 4096);
          W2T[((size_t)dd * 4096 + n) * 96 + m] = (bf16)f2bf(P->in[26][idx]); A2T[((size_t)dd * 4096 + n) * 96 + m] = (bf16)f2bf(P->in[29][idx]); } }
    for (int hb = 0; hb < 2; ++hb) {
        { TID_VARS bf16* H1 = (bf16*)(ws + WS_H1); const float* MOD1 = MOD + 9 * 6144;
          for (int m = gw; m < 9216; m += NGW) {
              if (m < 1024) normmod_row((const float*)(ws + WS_XC) + (size_t)(hb * 1024 + m) * 2048, P->in[19], MOD1 + 8 * 6144, H1 + (size_t)m * 2048, lane);
              else { const int r = hb * 8192 + (m - 1024); normmod_row(P->out + (size_t)r * 2048, P->in[19], MOD1 + (r >> 11) * 6144, H1 + (size_t)m * 2048, lane); } } }
        grid.sync();
        { TID_VARS mix_phase(P, 0, 1, 2, gtid, gthreads); }
        grid.sync();
        { GETP unsigned char* ws = P->ws; float* MOD = (float*)(ws + WS_MOD); (void)MOD; pg8::Gemm g{(const bf16*)(ws + WS_A), (const bf16*)(ws + WB_L1_IN), 9216, 12288, 2048, A_STRIDE, 16, 48}; pg8::StaticOrder S; S.init(9216, 12288, G, (int)blockIdx.x);
          pg8::EpiSplitBf16 E{(bf16*)(ws + WS_RKV), 4096, 4096, (size_t)9216 * 4096};
          pg8::gemm_phase<pg8::EpiSplitBf16, pg8::StaticOrder, true, true>(lds, g, S, E); }
        grid.sync();
        { TID_VARS mix_phase(P, 3, 4, 5, gtid, gthreads); }
        grid.sync();
        { GETP unsigned char* ws = P->ws; float* MOD = (float*)(ws + WS_MOD); (void)MOD; pg8::Gemm g{(const bf16*)(ws + WS_A), (const bf16*)(ws + WB_L1_IN) + (size_t)12288 * 2048, 9216, 4608, 2048, A_STRIDE, 16, 16}; pg8::StaticOrder S; S.init(9216, 4608, G, (int)blockIdx.x);
          pg8::EpiZLora E{(bf16*)(ws + WS_ZB), (bf16*)(ws + WS_ZB + ZB_LW), (bf16*)(ws + WS_ZB + ZB_LA)};
          pg8::gemm_phase<pg8::EpiZLora, pg8::StaticOrder, true, true>(lds, g, S, E); }
        grid.sync();
        { TID_VARS rwkv_phase(P, lds, hb, tid); }
        grid.sync();
        { GETP unsigned char* ws = P->ws; float* MOD = (float*)(ws + WS_MOD); (void)MOD; pg8::Gemm g{(const bf16*)(ws + WS_ZB) + (size_t)1024 * 4096, (const bf16*)(ws + WB_L1_OUT), 8192, 2048, 4096, 0, 1, 1 << 30}; pg8::StaticOrder S; S.init(8192, 2048, G, (int)blockIdx.x);
          pg8::EpiResid E{P->out, P->out, nullptr, nullptr, MOD + 9 * 6144, 0, hb * 8192};
          pg8::gemm_phase<pg8::EpiResid, pg8::StaticOrder, true, true>(lds, g, S, E); }
        grid.sync();
    }
    { TID_VARS const float* fg = P->in[36];
      for (int m = gw; m < 16384; m += NGW) { float* xr = P->out + (size_t)m * 2048;
          f32x4 v[8]; float s = 0.f;
#pragma unroll
          for (int j = 0; j < 8; ++j) { v[j] = ((const f32x4*)xr)[lane + 64 * j]; s += (v[j].x * v[j].x + v[j].y * v[j].y) + (v[j].z * v[j].z + v[j].w * v[j].w); }
          const float rstd = 1.0f / sqrtf(wave_sum(s) * (1.0f / 2048.0f) + 1e-6f);
#pragma unroll
          for (int j = 0; j < 8; ++j) ((f32x4*)xr)[lane + 64 * j] = v[j] * rstd * ((const f32x4*)fg)[lane + 64 * j]; } }
}

extern "C" void kernel_launch(void* const* d_in, const int* in_sizes, int n_in, void* d_out, int out_size, void* d_ws, size_t ws_size, hipStream_t stream) {
    static int grid = 0;
    if (grid == 0) {
        if (n_in != 37 || ws_size < WS_END) { fprintf(stderr, "kernel_launch: need 37 inputs and >= %zu bytes of workspace; got n_in %d, ws %zu; nothing launched\n", (size_t)WS_END, n_in, ws_size); grid = -1; return; }
        int dev = 0, cus = 0, per_cu = 0;
        if (hipGetDevice(&dev) != hipSuccess || hipDeviceGetAttribute(&cus, hipDeviceAttributeMultiprocessorCount, dev) != hipSuccess) { grid = -1; return; }
        if (hipFuncSetAttribute((const void*)fwd_megakernel, hipFuncAttributeMaxDynamicSharedMemorySize, LDS_BYTES) != hipSuccess) { fprintf(stderr, "kernel_launch: hipFuncSetAttribute failed\n"); grid = -1; return; }
        if (hipOccupancyMaxActiveBlocksPerMultiprocessor(&per_cu, (const void*)fwd_megakernel, NT, LDS_BYTES) != hipSuccess || per_cu < 1) { fprintf(stderr, "kernel_launch: occupancy query says %d\n", per_cu); per_cu = 1; }
        (void)hipGetLastError();
        grid = cus * 1;
    }
    if (grid < 0) return;
    (void)hipMemsetAsync((char*)d_ws + WS_MOD, 0, MOD_BYTES, stream);
    Params p{};
    for (int i = 0; i < 37; ++i) p.in[i] = (const float*)d_in[i];
    p.out = (float*)d_out; p.ws = (unsigned char*)d_ws;
    void* args[] = {&p};
    hipError_t e = hipLaunchCooperativeKernel((const void*)fwd_megakernel, dim3(grid), dim3(NT), args, LDS_BYTES, stream);
    if (e != hipSuccess) fprintf(stderr, "cooperative launch failed: %s (grid %d)\n", hipGetErrorString(e), grid);
}
```

```cpp
#include <hip/hip_runtime.h>
#include <hip/hip_cooperative_groups.h>
#include <cstdio>
#include <cstdint>
namespace cg = cooperative_groups;
namespace pg8 {
#define PG8_LAS __attribute__((address_space(3)))
typedef unsigned short bf16_t;
typedef short bf16x8 __attribute__((ext_vector_type(8)));
typedef float f32x4 __attribute__((ext_vector_type(4)));
typedef unsigned u32x4 __attribute__((ext_vector_type(4)));
constexpr int BM = 256, BK = 64, HALF = 128, HTB = HALF * BK * 2  , STAGE_BYTES = 8 * HTB, NXCD = 8, WGM = 8;

__host__ __device__ __forceinline__ int lds_byte(int r, int c) { const int st = (r >> 4) * 2 + (c >> 5), rr = r & 15, cc = c & 31, ob = rr * 64 + cc * 2; return st * 1024 + (ob ^ (((ob >> 9) & 1) << 5)); }
__host__ __device__ __forceinline__ void stage_rc(int b, int& R, int& C) { const int st = b / 1024, sb = b % 1024, swz = sb ^ (((sb >> 9) & 1) << 5); R = (st >> 1) * 16 + swz / 64; C = (st & 1) * 32 + (swz % 64) / 2; }
__host__ __device__ __forceinline__ int perm32(int rho) { const int n = rho >> 4, i = rho & 15; return 8 * (i >> 2) + 4 * n + (i & 3); }

struct Unit { int pm, pn; };
struct Gemm { const bf16_t* A; const bf16_t* Bt; int M, N, K; size_t a_stride; int a_div, a_n0; };
#define PG8_AIDX(g, pn) ((size_t)((pn) < (g).a_n0 ? (pn) / (g).a_div : (g).a_n0 / (g).a_div + ((pn) - (g).a_n0)) * (g).a_stride)

struct StaticOrder {
    int nM, nN, nwg, G, c;
    __host__ __device__ void init(int M, int N, int G_, int c_) { nM = M / BM; nN = N / BM; nwg = nM * nN; G = G_; c = c_; }
    __host__ __device__ bool next(int i, Unit& u) const {
        const long L = (long)i * G + c; if (L >= nwg) return false;
        int wgid = (int)L; { const int q = nwg / NXCD, r = nwg % NXCD, xcd = wgid % NXCD, off = wgid / NXCD; wgid = (xcd < r ? xcd * (q + 1) : r * (q + 1) + (xcd - r) * q) + off; }
        const int nig = WGM * nN, gid = wgid / nig, fm = gid * WGM, gsz = (nM - fm) < WGM ? (nM - fm) : WGM;
        u.pm = fm + ((wgid % nig) % gsz); u.pn = (wgid % nig) / gsz; return true;
    }
    __device__ __forceinline__ void a_ready(const Unit&) const {}
    __device__ __forceinline__ void done(const Unit&) const {}
};
__device__ __forceinline__ unsigned cvt_pk_bf16(float lo, float hi) { unsigned r; asm volatile("v_cvt_pk_bf16_f32 %0, %1, %2" : "=v"(r) : "v"(lo), "v"(hi)); return r; }
__device__ __forceinline__ float bflo(unsigned w) { return __builtin_bit_cast(float, w << 16); }
__device__ __forceinline__ float bfhi(unsigned w) { return __builtin_bit_cast(float, w & 0xffff0000u); }
__device__ __forceinline__ float sigm(float x) { return 1.0f / (1.0f + __expf(-x)); }
__device__ __forceinline__ float tanh_f(float x) { const float e = __expf(2.0f * x); return 1.0f - 2.0f / (1.0f + e); }

struct EpiSplitBf16 {
    static constexpr bool PERM = true, AFTER_DRAIN = false;
    bf16_t* O; int ldc; int split_cols; size_t split_stride;
    __device__ __forceinline__ void operator()(const f32x4 (&acc)[2][2][4][2], const Unit& u, int wr, int wc, int fr, int fq) const {
        const int row0 = u.pm * BM + wr * 64 + fr; int colt = u.pn * BM; bf16_t* base = O;
        { const int t = colt / split_cols; base += (size_t)t * split_stride; colt -= t * split_cols; }
        const int col0 = colt + wc * 32 + 8 * fq;
#pragma unroll
        for (int ai = 0; ai < 2; ++ai)
#pragma unroll
            for (int m = 0; m < 4; ++m) { bf16_t* rowp = base + (size_t)(row0 + ai * HALF + m * 16) * ldc + col0;
#pragma unroll
                for (int bj = 0; bj < 2; ++bj) { const f32x4 v0 = acc[ai][bj][m][0], v1 = acc[ai][bj][m][1];
                    u32x4 w; w.x = cvt_pk_bf16(v0[0], v0[1]); w.y = cvt_pk_bf16(v0[2], v0[3]); w.z = cvt_pk_bf16(v1[0], v1[1]); w.w = cvt_pk_bf16(v1[2], v1[3]);
                    *(u32x4*)(rowp + bj * HALF) = w; } }
    }
};

struct EpiGlu {
    static constexpr bool PERM = true, AFTER_DRAIN = false;
    const bf16_t* Y; bf16_t* Z; int ldc; const float* bias;
    __device__ __forceinline__ void operator()(const f32x4 (&acc)[2][2][4][2], const Unit& u, int wr, int wc, int fr, int fq) const {
        const int row0 = u.pm * BM + wr * 64 + fr; const int col0 = u.pn * BM + wc * 32 + 8 * fq;
#pragma unroll
        for (int bj = 0; bj < 2; ++bj) {
            const f32x4 b0 = *(const f32x4*)(bias + col0 + bj * HALF), b1 = *(const f32x4*)(bias + col0 + bj * HALF + 4);
#pragma unroll
            for (int ai = 0; ai < 2; ++ai)
#pragma unroll
                for (int m = 0; m < 4; ++m) {
                    const size_t off = (size_t)(row0 + ai * HALF + m * 16) * ldc + col0 + bj * HALF;
                    const u32x4 yy = *(const u32x4*)(Y + off); const u32x4 zz = *(const u32x4*)(Z + off);
                    const f32x4 t0 = acc[ai][bj][m][0] + b0, t1 = acc[ai][bj][m][1] + b1;
                    float o[8];
#define GLU1(k, yv, zv, tv) { const float y_ = (yv), z_ = (zv); o[k] = y_ * sigm(tv) * (z_ * sigm(z_)); }
                    GLU1(0, bflo(yy.x), bflo(zz.x), t0[0]) GLU1(1, bfhi(yy.x), bfhi(zz.x), t0[1])
                    GLU1(2, bflo(yy.y), bflo(zz.y), t0[2]) GLU1(3, bfhi(yy.y), bfhi(zz.y), t0[3])
                    GLU1(4, bflo(yy.z), bflo(zz.z), t1[0]) GLU1(5, bfhi(yy.z), bfhi(zz.z), t1[1])
                    GLU1(6, bflo(yy.w), bflo(zz.w), t1[2]) GLU1(7, bfhi(yy.w), bfhi(zz.w), t1[3])
#undef GLU1
                    u32x4 w; w.x = cvt_pk_bf16(o[0], o[1]); w.y = cvt_pk_bf16(o[2], o[3]); w.z = cvt_pk_bf16(o[4], o[5]); w.w = cvt_pk_bf16(o[6], o[7]);
                    *(u32x4*)(Z + off) = w; }
        }
    }
};

struct EpiResid {
    static constexpr bool PERM = false, AFTER_DRAIN = false;
    const float* XIN; float* OUT; const float* CTXIN; float* XC; const float* MOD; int ctx_rows; int lat_row0;
    __device__ __forceinline__ void operator()(const f32x4 (&acc)[2][2][4][2], const Unit& u, int wr, int wc, int fr, int fq) const {
        const int row0 = u.pm * BM + wr * 64 + fr, col0 = u.pn * BM + wc * 32 + 4 * fq;
        const bool isctx = (u.pm * BM) < ctx_rows;
#pragma unroll
        for (int ai = 0; ai < 2; ++ai)
#pragma unroll
            for (int m = 0; m < 4; ++m) {
                const int row = row0 + ai * HALF + m * 16;
                const int rr = isctx ? row : (row - ctx_rows + lat_row0); const int gj = isctx ? 8 : (rr >> 11);
                const float* src = (isctx ? CTXIN : XIN) + (size_t)rr * 2048; float* dst = (isctx ? XC : OUT) + (size_t)rr * 2048; const float* gate = MOD + gj * 6144 + 4096;
#pragma unroll
                for (int bj = 0; bj < 2; ++bj)
#pragma unroll
                    for (int n = 0; n < 2; ++n) { const int c = col0 + bj * HALF + n * 16;
                        const f32x4 g4 = *(const f32x4*)(gate + c); const f32x4 x4 = *(const f32x4*)(src + c);
                        *(f32x4*)(dst + c) = x4 + g4 * acc[ai][bj][m][n]; }
            }
    }
};

struct EpiZLora {
    static constexpr bool PERM = true, AFTER_DRAIN = false;
    bf16_t* Zb; bf16_t* LW; bf16_t* LA;
    __device__ __forceinline__ void operator()(const f32x4 (&acc)[2][2][4][2], const Unit& u, int wr, int wc, int fr, int fq) const {
        const int row0 = u.pm * BM + wr * 64 + fr;
        if (u.pn < 16) {
            if (u.pm < 4) return;
            const int col0 = u.pn * BM + wc * 32 + 8 * fq;
#pragma unroll
            for (int ai = 0; ai < 2; ++ai)
#pragma unroll
                for (int m = 0; m < 4; ++m) { bf16_t* rowp = Zb + (size_t)(row0 + ai * HALF + m * 16) * 4096 + col0;
#pragma unroll
                    for (int bj = 0; bj < 2; ++bj) { const f32x4 v0 = acc[ai][bj][m][0], v1 = acc[ai][bj][m][1];
                        u32x4 w; w.x = cvt_pk_bf16(v0[0], v0[1]); w.y = cvt_pk_bf16(v0[2], v0[3]); w.z = cvt_pk_bf16(v1[0], v1[1]); w.w = cvt_pk_bf16(v1[2], v1[3]);
                        *(u32x4*)(rowp + bj * HALF) = w; } }
        } else {
            const bool isw = (u.pn == 16); bf16_t* base = isw ? LW : LA;
#pragma unroll
            for (int bj = 0; bj < 2; ++bj) {
                const int col = bj * HALF + wc * 32 + 8 * fq;
                if (col < 192) {
#pragma unroll
                    for (int ai = 0; ai < 2; ++ai)
#pragma unroll
                        for (int m = 0; m < 4; ++m) { f32x4 v0 = acc[ai][bj][m][0], v1 = acc[ai][bj][m][1];
                            if (isw) { v0[0] = tanh_f(v0[0]); v0[1] = tanh_f(v0[1]); v0[2] = tanh_f(v0[2]); v0[3] = tanh_f(v0[3]); v1[0] = tanh_f(v1[0]); v1[1] = tanh_f(v1[1]); v1[2] = tanh_f(v1[2]); v1[3] = tanh_f(v1[3]); }
                            u32x4 w; w.x = cvt_pk_bf16(v0[0], v0[1]); w.y = cvt_pk_bf16(v0[2], v0[3]); w.z = cvt_pk_bf16(v1[0], v1[1]); w.w = cvt_pk_bf16(v1[2], v1[3]);
                            *(u32x4*)(base + (size_t)(row0 + ai * HALF + m * 16) * 192 + col) = w; }
                }
            }
        }
    }
};
template <class Epi, class Sched, bool ALIGN_EPI = false, bool SP2 = false>
__device__ __forceinline__ void gemm_phase(PG8_LAS unsigned char* lds, const Gemm g, const Sched& S, const Epi& E) {
    const int tid = threadIdx.x, wid = __builtin_amdgcn_readfirstlane(tid >> 6), lane = tid & 63, wr = wid >> 2, wc = wid & 3, fr = lane & 15, fq = lane >> 4;
    const int K = g.K, nt = K / BK;
    unsigned voffA[2], voffB[2];
#pragma unroll
    for (int i = 0; i < 2; ++i) { int R, C; stage_rc(tid * 16 + i * 8192, R, C); const int Rb = Epi::PERM ? ((R & ~31) + perm32(R & 31)) : R;
        voffA[i] = (unsigned)(R * K + C) * 2u; voffB[i] = (unsigned)(Rb * K + C) * 2u; }
    const size_t kstep = (size_t)(BK * 2);
    const size_t hstep = (size_t)HALF * K * 2;
    const size_t tstep = 2 * hstep;
    const unsigned ldsw = (unsigned)wid * 1024u;
    const int aoff = lds_byte(wr * 64 + fr, fq * 8), boff = lds_byte(wc * 32 + fr, fq * 8);
#define PG8_SA(b, h) (((b) * 2 + (h)) * HTB)
#define PG8_SB(b, h) ((4 + (b) * 2 + (h)) * HTB)
#define PG8_STAGE(bufoff, gbase, voff) do { _Pragma("unroll") for (int _i = 0; _i < 2; ++_i) \
        __builtin_amdgcn_global_load_lds((const unsigned*)((const char*)(gbase) + (voff)[_i]), (PG8_LAS unsigned*)(lds + (bufoff) + ldsw + _i * 8192), 16, 0, 0); } while (0)
#define PG8_LDA(dst, b, h) do { _Pragma("unroll") for (int m = 0; m < 4; ++m) _Pragma("unroll") for (int k = 0; k < 2; ++k) dst[m][k] = *(const PG8_LAS bf16x8*)(lds + PG8_SA(b, h) + aoff + m * 2048 + k * 1024); } while (0)
#define PG8_LDB(dst, b, h) do { _Pragma("unroll") for (int n = 0; n < 2; ++n) _Pragma("unroll") for (int k = 0; k < 2; ++k) dst[n][k] = *(const PG8_LAS bf16x8*)(lds + PG8_SB(b, h) + boff + n * 2048 + k * 1024); } while (0)
#define PG8_MMA(ai, bj, At, Bt) do { __builtin_amdgcn_s_setprio(1); _Pragma("unroll") for (int m = 0; m < 4; ++m) _Pragma("unroll") for (int n = 0; n < 2; ++n) _Pragma("unroll") for (int k = 0; k < 2; ++k) \
        acc[ai][bj][m][n] = __builtin_amdgcn_mfma_f32_16x16x32_bf16(Bt[n][k], At[m][k], acc[ai][bj][m][n], 0, 0, 0); __builtin_amdgcn_s_setprio(0); } while (0)
#define PG8_WAIT_V(n) asm volatile("s_waitcnt vmcnt(" #n ")" ::: "memory")
#define PG8_WAIT_L(n) asm volatile("s_waitcnt lgkmcnt(" #n ")" ::: "memory")
#define PG8_BAR __builtin_amdgcn_s_barrier()
#define PG8_SCHED __builtin_amdgcn_sched_barrier(0)
    Unit cur, nxt; int ui = 0;
    if (!S.next(0, cur)) return;
    f32x4 acc[2][2][4][2];
#pragma unroll
    for (int a = 0; a < 2; ++a)
#pragma unroll
        for (int b = 0; b < 2; ++b)
#pragma unroll
            for (int m = 0; m < 4; ++m)
#pragma unroll
                for (int n = 0; n < 2; ++n) acc[a][b][m][n] = (f32x4){0.f, 0.f, 0.f, 0.f};
    bf16x8 At[4][2], B0[2][2], B1[2][2];
    const char* cA = (const char*)g.A + PG8_AIDX(g, cur.pn) + (size_t)cur.pm * tstep; const char* cB = (const char*)g.Bt + (size_t)cur.pn * tstep;
    S.a_ready(cur);
    if constexpr (SP2) {
        PG8_STAGE(PG8_SB(0, 0), cB, voffB); PG8_STAGE(PG8_SB(0, 1), cB + hstep, voffB); PG8_STAGE(PG8_SA(0, 0), cA, voffA); PG8_STAGE(PG8_SA(0, 1), cA + hstep, voffA);
        if (wr == 1) PG8_BAR;
        PG8_WAIT_V(2); PG8_BAR;
        PG8_STAGE(PG8_SB(1, 0), cB + kstep, voffB); PG8_STAGE(PG8_SA(1, 0), cA + kstep, voffA); PG8_STAGE(PG8_SB(1, 1), cB + hstep + kstep, voffB);
        PG8_WAIT_V(6); PG8_BAR;
    } else {
        PG8_STAGE(PG8_SB(0, 0), cB, voffB); PG8_STAGE(PG8_SA(0, 0), cA, voffA); PG8_STAGE(PG8_SB(0, 1), cB + hstep, voffB); PG8_STAGE(PG8_SA(0, 1), cA + hstep, voffA);
        if (wr == 1) PG8_BAR;
        PG8_WAIT_V(4); PG8_BAR;
        PG8_STAGE(PG8_SB(1, 0), cB + kstep, voffB); PG8_STAGE(PG8_SA(1, 0), cA + kstep, voffA); PG8_STAGE(PG8_SB(1, 1), cB + hstep + kstep, voffB);
        PG8_WAIT_V(6); PG8_BAR;
    }
    for (;;) {
        const bool has_next = S.next(ui + 1, nxt);
        const char* nA = has_next ? (const char*)g.A + PG8_AIDX(g, nxt.pn) + (size_t)nxt.pm * tstep : cA; const char* nB = has_next ? (const char*)g.Bt + (size_t)nxt.pn * tstep : cB;
        for (int t = 0; t < nt; t += 2) {
            const bool last = (t == nt - 2);
            const char* a1 = cA + (size_t)(t + 1) * kstep;
            const char* a2 = last ? nA : cA + (size_t)(t + 2) * kstep; const char* b2 = last ? nB : cB + (size_t)(t + 2) * kstep;
            const char* a3 = a2 + kstep; const char* b3 = b2 + kstep;
            if (last && has_next) S.a_ready(nxt);
            if constexpr (SP2) {
            PG8_LDB(B0, 0, 0); PG8_LDB(B1, 0, 1); PG8_SCHED; PG8_LDA(At, 0, 0); PG8_STAGE(PG8_SA(1, 1), a1 + hstep, voffA);
            PG8_WAIT_V(8); PG8_WAIT_L(0); PG8_BAR; PG8_MMA(0, 0, At, B0); PG8_MMA(0, 1, At, B1); PG8_BAR; PG8_SCHED;
            PG8_LDA(At, 0, 1); PG8_STAGE(PG8_SB(0, 0), b2, voffB); PG8_STAGE(PG8_SB(0, 1), b2 + hstep, voffB); PG8_STAGE(PG8_SA(0, 0), a2, voffA);
            PG8_WAIT_V(8); PG8_WAIT_L(0); PG8_BAR; PG8_MMA(1, 0, At, B0); PG8_MMA(1, 1, At, B1); PG8_BAR; PG8_SCHED;
            PG8_LDB(B0, 1, 0); PG8_LDB(B1, 1, 1); PG8_SCHED; PG8_LDA(At, 1, 0); PG8_STAGE(PG8_SA(0, 1), a2 + hstep, voffA);
            PG8_WAIT_V(8); PG8_WAIT_L(0); PG8_BAR; PG8_MMA(0, 0, At, B0); PG8_MMA(0, 1, At, B1); PG8_BAR; PG8_SCHED;
            PG8_LDA(At, 1, 1); PG8_STAGE(PG8_SB(1, 0), b3, voffB); PG8_STAGE(PG8_SB(1, 1), b3 + hstep, voffB); PG8_STAGE(PG8_SA(1, 0), a3, voffA);
            PG8_WAIT_V(8); PG8_WAIT_L(0); PG8_BAR; PG8_MMA(1, 0, At, B0); PG8_MMA(1, 1, At, B1); PG8_BAR; PG8_SCHED;
            } else {
            PG8_LDB(B0, 0, 0); PG8_SCHED; PG8_LDA(At, 0, 0); PG8_STAGE(PG8_SA(1, 1), a1 + hstep, voffA);
            PG8_WAIT_L(8); PG8_BAR; PG8_WAIT_L(0); PG8_MMA(0, 0, At, B0); PG8_BAR; PG8_SCHED;
            PG8_LDB(B1, 0, 1); PG8_STAGE(PG8_SB(0, 0), b2, voffB);
            PG8_BAR; PG8_WAIT_L(0); PG8_MMA(0, 1, At, B1); PG8_BAR;
            PG8_LDA(At, 0, 1); PG8_STAGE(PG8_SA(0, 0), a2, voffA);
            PG8_BAR; PG8_WAIT_L(0); PG8_MMA(1, 0, At, B0); PG8_BAR; PG8_SCHED;
            PG8_STAGE(PG8_SB(0, 1), b2 + hstep, voffB);
            PG8_WAIT_V(6); PG8_BAR; PG8_MMA(1, 1, At, B1); PG8_BAR;
            PG8_LDB(B0, 1, 0); PG8_SCHED; PG8_LDA(At, 1, 0); PG8_STAGE(PG8_SA(0, 1), a2 + hstep, voffA);
            PG8_WAIT_L(8); PG8_BAR; PG8_WAIT_L(0); PG8_MMA(0, 0, At, B0); PG8_BAR; PG8_SCHED;
            PG8_LDB(B1, 1, 1); PG8_STAGE(PG8_SB(1, 0), b3, voffB);
            PG8_BAR; PG8_WAIT_L(0); PG8_MMA(0, 1, At, B1); PG8_BAR;
            PG8_LDA(At, 1, 1); PG8_STAGE(PG8_SA(1, 0), a3, voffA);
            PG8_BAR; PG8_WAIT_L(0); PG8_MMA(1, 0, At, B0); PG8_BAR; PG8_SCHED;
            PG8_STAGE(PG8_SB(1, 1), b3 + hstep, voffB);
            PG8_WAIT_V(6); PG8_BAR; PG8_MMA(1, 1, At, B1); PG8_BAR;
            }
        }
        if constexpr (ALIGN_EPI) { if (wr == 0) PG8_BAR; }
        if constexpr (!Epi::AFTER_DRAIN) { E(acc, cur, wr, wc, fr, fq); S.done(cur); }
        if (!has_next) break;
#pragma unroll
        for (int a = 0; a < 2; ++a)
#pragma unroll
            for (int b = 0; b < 2; ++b)
#pragma unroll
                for (int m = 0; m < 4; ++m)
#pragma unroll
                    for (int n = 0; n < 2; ++n) acc[a][b][m][n] = (f32x4){0.f, 0.f, 0.f, 0.f};
        cur = nxt; cA = nA; cB = nB; ++ui;
        if constexpr (ALIGN_EPI) { if (wr == 1) PG8_BAR; }
    }
    PG8_WAIT_V(0);
    if constexpr (!ALIGN_EPI) { if (wr == 0) PG8_BAR; }
    PG8_BAR;
    if constexpr (Epi::AFTER_DRAIN) { E.fused(acc, cur, wr, wc, fr, fq, lds, wid, lane); S.done(cur); }
#undef PG8_SA
#undef PG8_SB
#undef PG8_STAGE
#undef PG8_LDA
#undef PG8_LDB
#undef PG8_MMA
#undef PG8_WAIT_V
#undef PG8_WAIT_L
#undef PG8_BAR
#undef PG8_SCHED
}
}

#define LAS __attribute__((address_space(3)))
typedef unsigned short bf16;
typedef short bf16x8 __attribute__((ext_vector_type(8)));
typedef float f32x4 __attribute__((ext_vector_type(4)));
typedef float f32x16 __attribute__((ext_vector_type(16)));
typedef unsigned u32x4 __attribute__((ext_vector_type(4)));
typedef unsigned u32x2 __attribute__((ext_vector_type(2)));

constexpr int NT = 512;
constexpr int LDS_BYTES = 147456;
constexpr size_t MiB = 1u << 20;
constexpr size_t WS_MOD = 0;
constexpr size_t MOD_BYTES = 2 * 9 * 6144 * 4;
constexpr size_t WS_QP = 1 * MiB;
constexpr size_t WS_W2T = 3 * MiB;
constexpr size_t WS_A2T = WS_W2T + 2 * 4096 * 96 * 2;
constexpr size_t WS_XC = 6 * MiB;
constexpr size_t WS_WB = 22 * MiB;
constexpr size_t WB_L0_IN = WS_WB, WB_L0_GLU = WS_WB + 32 * MiB, WB_L0_OUT = WS_WB + 64 * MiB;
constexpr size_t WB_L1_IN = WS_WB, WB_L1_OUT = WS_WB + 66 * MiB;
constexpr size_t WS_BIG = 106 * MiB;
constexpr size_t WS_U = WS_BIG, WS_Z = WS_BIG + 144 * MiB, WS_Y = WS_BIG + 288 * MiB;
constexpr size_t WS_H1 = WS_BIG, WS_A = WS_BIG + 36 * MiB, WS_RKV = WS_BIG + 144 * MiB, WS_ZB = WS_BIG + 360 * MiB;
constexpr size_t WS_END = WS_BIG + 432 * MiB;
constexpr size_t A_STRIDE = (size_t)9216 * 2048 * 2;
constexpr size_t WS_YP = WS_A;
constexpr size_t ZB_LW = 0, ZB_LA = (size_t)9216 * 192 * 2;

struct Params { const float* in[37]; float* out; unsigned char* ws; };
typedef const __attribute__((address_space(4))) Params* PPtr;
#define GETP PPtr P = (PPtr)__builtin_amdgcn_kernarg_segment_ptr(); asm volatile("" : "+s"(P));

__device__ __forceinline__ unsigned f2bf(float f) { unsigned u = __builtin_bit_cast(unsigned, f); return (u + 0x7fffu + ((u >> 16) & 1u)) >> 16; }
__device__ __forceinline__ unsigned pk2(float lo, float hi) { return f2bf(lo) | (f2bf(hi) << 16); }
__device__ __forceinline__ float bf2f(unsigned h) { return __builtin_bit_cast(float, h << 16); }
__device__ __forceinline__ float blo(unsigned w) { return __builtin_bit_cast(float, w << 16); }
__device__ __forceinline__ float bhi(unsigned w) { return __builtin_bit_cast(float, w & 0xffff0000u); }
__device__ __forceinline__ float wave_sum(float v) {
#pragma unroll
    for (int o = 1; o < 64; o <<= 1) v += __shfl_xor(v, o);
    return v;
}
#define DPPF(v, ctrl) __builtin_bit_cast(float, __builtin_amdgcn_update_dpp(0, __builtin_bit_cast(int, (v)), (ctrl), 0xF, 0xF, true))
__device__ __forceinline__ float red8(float v) { v += DPPF(v, 0xB1); v += DPPF(v, 0x4E); v += DPPF(v, 0x141); return v; }
__device__ __forceinline__ float red16(float v) { v = red8(v); v += DPPF(v, 0x128); return v; }
__device__ __forceinline__ float sigmoidf_(float x) { return 1.0f / (1.0f + __expf(-x)); }

__device__ __forceinline__ void transpose_item(const float* W, int K, int N, bf16* WT, int row_off, LAS float* scr, int item, int lane) {
    const int nblk = N / 32, kb = item / nblk, nb = item % nblk, k0 = 64 * kb, n0 = 32 * nb;
#pragma unroll 8
    for (int i = 0; i < 32; ++i) { const int kk = 2 * i + (lane >> 5); scr[kk * 33 + (lane & 31)] = W[(size_t)(k0 + kk) * N + n0 + (lane & 31)]; }
    asm volatile("s_waitcnt lgkmcnt(0)" ::: "memory");
    const int c = lane & 7;
#pragma unroll
    for (int j = 0; j < 4; ++j) { const int n = (lane >> 3) + 8 * j; const LAS float* s = scr + (8 * c) * 33 + n;
        u32x4 o; o.x = pk2(s[0 * 33], s[1 * 33]); o.y = pk2(s[2 * 33], s[3 * 33]); o.z = pk2(s[4 * 33], s[5 * 33]); o.w = pk2(s[6 * 33], s[7 * 33]);
        *(u32x4*)(WT + (size_t)(row_off + n0 + n) * K + k0 + 8 * c) = o; }
    asm volatile("s_waitcnt lgkmcnt(0)" ::: "memory");
}

__device__ __forceinline__ void mod_task(PPtr P, float* MOD, LAS float* sil, int tk, int tid) {
    const int layer = tk / 192, rem = tk % 192, ks = rem / 12, nb = rem % 12;
    const float* ada_w = P->in[layer ? 20 : 5]; const float* ada_b = P->in[layer ? 21 : 6];
    const float* c = P->in[1]; const float* cc = P->in[3];
    const int k0 = ks * 128, n = nb * 512 + tid;
    __syncthreads();
    for (int idx = tid; idx < 128 * 9; idx += NT) { const int k = idx / 9, j = idx % 9; const float v = (j < 8) ? c[j * 2048 + k0 + k] : cc[k0 + k]; sil[idx] = v * sigmoidf_(v); }
    __syncthreads();
    float acc[9];
#pragma unroll
    for (int j = 0; j < 9; ++j) acc[j] = 0.f;
#pragma unroll 4
    for (int k = 0; k < 128; ++k) { const float w = ada_w[(size_t)(k0 + k) * 6144 + n];
#pragma unroll
        for (int j = 0; j < 9; ++j) acc[j] += sil[k * 9 + j] * w; }
    const float bb = (ks == 0) ? ada_b[n] : 0.f;
#pragma unroll
    for (int j = 0; j < 9; ++j) atomicAdd(MOD + (size_t)(layer * 9 + j) * 6144 + n, acc[j] + bb);
}

__device__ __forceinline__ void normmod_row(const float* xrow, const float* g, const float* mod  , bf16* orow, int lane) {
    f32x4 v[8]; float s = 0.f;
#pragma unroll
    for (int j = 0; j < 8; ++j) { v[j] = ((const f32x4*)xrow)[lane + 64 * j]; s += (v[j].x * v[j].x + v[j].y * v[j].y) + (v[j].z * v[j].z + v[j].w * v[j].w); }
    const float rstd = 1.0f / sqrtf(wave_sum(s) * (1.0f / 2048.0f) + 1e-6f);
#pragma unroll
    for (int j = 0; j < 8; ++j) { const int c4 = lane + 64 * j; const f32x4 gg = ((const f32x4*)g)[c4], sh = ((const f32x4*)mod)[c4], sc = ((const f32x4*)(mod + 2048))[c4];
        const f32x4 y = v[j] * rstd * gg * (sc + 1.0f) + sh;
        u32x2 o; o.x = pk2(y.x, y.y); o.y = pk2(y.z, y.w); ((u32x2*)orow)[c4] = o; }
}

constexpr int S5_ROWB = 528;
constexpr int S5_WLDS = 32 * S5_ROWB;
__device__ __forceinline__ float gelu_tanh(float x) { const float u = 0.7978845608028654f * (x + 0.044715f * x * x * x); const float e = __expf(2.0f * u); return 0.5f * x * (2.0f - 2.0f / (1.0f + e)); }

__device__ __forceinline__ void s5_phase(PPtr P, LAS unsigned char* lds, int wave, int lane) {
    const float* a_re = P->in[8]; const float* a_im = P->in[9]; const float* lstep = P->in[10];
    const float* b_re = P->in[11]; const float* b_im = P->in[12]; const float* c_re = P->in[13]; const float* c_im = P->in[14]; const float* dskip = P->in[15];
    const bf16* U = (const bf16*)(P->ws + WS_U); bf16* Y = (bf16*)(P->ws + WS_Y);
    LAS unsigned char* wl = lds + wave * S5_WLDS;
    const int d = wave >> 2;
    for (int round = blockIdx.x; round < 512; round += gridDim.x) {
        const int unit = round * 4 + (wave & 3), b = unit >> 8, g = unit & 255, dg = d * 256 + g;
        const float dt = expf(lstep[dg]);
        float abr, abi;
        { const float are = a_re[dg * 64 + lane], aim = a_im[dg * 64 + lane]; const float mag = expf(dt * are); abr = mag * cosf(dt * aim); abi = mag * sinf(dt * aim); }
        bf16x8 Bf[4];
#pragma unroll
        for (int nn = 0; nn < 2; ++nn) {
            const int n = (lane & 31) + 32 * nn; const float are = a_re[dg * 64 + n], aim = a_im[dg * 64 + n];
            const float mag = expf(dt * are), cr = mag * cosf(dt * aim), ci = mag * sinf(dt * aim), den = are * are + aim * aim, nr = cr - 1.0f, ni = ci;
            const float fre = (nr * are + ni * aim) / den, fim = (ni * are - nr * aim) / den;
            const float* br = b_re + ((size_t)dg * 64 + n) * 16 + 8 * (lane >> 5); const float* bi = b_im + ((size_t)dg * 64 + n) * 16 + 8 * (lane >> 5);
#pragma unroll
            for (int j = 0; j < 8; ++j) { const float xr = br[j], xi = bi[j]; Bf[nn][j] = (short)f2bf(fre * xr - fim * xi); Bf[2 + nn][j] = (short)f2bf(fre * xi + fim * xr); }
        }
        bf16x8 Cf[4];
#pragma unroll
        for (int ks = 0; ks < 4; ++ks) { const int k = 32 * ks + 8 * (lane >> 4); const int o = lane & 15;
            const float* src = (ks < 2) ? (c_re + ((size_t)dg * 16 + o) * 64 + k) : (c_im + ((size_t)dg * 16 + o) * 64 + (k - 64)); const float sg = (ks < 2) ? 1.0f : -1.0f;
#pragma unroll
            for (int j = 0; j < 8; ++j) Cf[ks][j] = (short)f2bf(sg * src[j]); }
        const float dsk = dskip[g * 16 + (lane & 15)];
        float hr = 0.f, hi = 0.f;
        for (int cs = 0; cs < 72; ++cs) {
            const bool isctx = cs < 8; const int ci = isctx ? cs : cs - 8, nch = isctx ? 8 : 64;
            const int tc = d ? (nch - 1 - ci) : ci; const bool first = ci < (nch >> 1);
            const size_t rowbase = isctx ? (size_t)b * 256 : (size_t)2048 + (size_t)b * 2048;
            { const int i = lane & 31; const int t = 32 * tc + (d ? 31 - i : i);
              const bf16x8 Af = *(const bf16x8*)(U + (rowbase + t) * 4096 + g * 16 + 8 * (lane >> 5));
#pragma unroll
              for (int tl = 0; tl < 4; ++tl) { f32x16 z16; for (int q = 0; q < 16; ++q) z16[q] = 0.f;
                  const f32x16 r = __builtin_amdgcn_mfma_f32_32x32x16_bf16(Af, Bf[tl], z16, 0, 0, 0);
#pragma unroll
                  for (int reg = 0; reg < 16; ++reg) { const int ii = (reg & 3) + 8 * (reg >> 2) + 4 * (lane >> 5);
                      *(LAS float*)(wl + ii * S5_ROWB + (32 * tl + (lane & 31)) * 4) = r[reg]; } } }
#pragma unroll 4
            for (int i = 0; i < 32; ++i) { const float re = *(LAS float*)(wl + i * S5_ROWB + lane * 4), im = *(LAS float*)(wl + i * S5_ROWB + (64 + lane) * 4);
                const float nhr = abr * hr - abi * hi + re, nhi = abr * hi + abi * hr + im; hr = nhr; hi = nhi;
                *(LAS unsigned short*)(wl + i * S5_ROWB + lane * 2) = (unsigned short)f2bf(hr); *(LAS unsigned short*)(wl + i * S5_ROWB + (64 + lane) * 2) = (unsigned short)f2bf(hi); }
#pragma unroll
            for (int mt = 0; mt < 2; ++mt) { f32x4 yv = {0.f, 0.f, 0.f, 0.f};
#pragma unroll
                for (int ks = 0; ks < 4; ++ks) { const bf16x8 Af = *(const LAS bf16x8*)(wl + (16 * mt + (lane & 15)) * S5_ROWB + (32 * ks + 8 * (lane >> 4)) * 2);
                    yv = __builtin_amdgcn_mfma_f32_16x16x32_bf16(Af, Cf[ks], yv, 0, 0, 0); }
#pragma unroll
                for (int reg = 0; reg < 4; ++reg) { const int i = 16 * mt + 4 * (lane >> 4) + reg; const int t = 32 * tc + (d ? 31 - i : i);
                    const size_t pos = (rowbase + t) * 4096 + g * 16 + (lane & 15);
                    if (first) Y[pos] = (bf16)f2bf(yv[reg]);
                    else { const float tot = yv[reg] + bf2f(Y[pos]) + dsk * bf2f(U[pos]); Y[pos] = (bf16)f2bf(gelu_tanh(tot)); } } }
            __syncthreads();
        }
    }
}

constexpr int RW_ARR = 16 * 64 * 4, RW_DIR = 7 * RW_ARR + 64;
__device__ __forceinline__ void rwkv_phase(PPtr P, LAS unsigned char* lds, int hb, int tid) {
    const float* w0 = P->in[24]; const float* a0 = P->in[27]; const float* k_k = P->in[30]; const float* k_a = P->in[31]; const float* r_k = P->in[32];
    const float* ln_w = P->in[33]; const float* ln_b = P->in[34];
    const bf16* RB = (const bf16*)(P->ws + WS_RKV); const bf16* KB = RB + (size_t)9216 * 4096; const bf16* VB = KB + (size_t)9216 * 4096;
    bf16* ZB = (bf16*)(P->ws + WS_ZB); const bf16* LW = (const bf16*)(P->ws + WS_ZB + ZB_LW); const bf16* LA = (const bf16*)(P->ws + WS_ZB + ZB_LA);
    const bf16* W2T = (const bf16*)(P->ws + WS_W2T); const bf16* A2T = (const bf16*)(P->ws + WS_A2T);
    bf16* YP = (bf16*)(P->ws + WS_YP); float* QP = (float*)(P->ws + WS_QP);
    const int d = tid >> 8, lt = tid & 255, lane = tid & 63, wv = (tid >> 6) & 3;
    LAS unsigned char* dl = lds + d * RW_DIR;
    LAS float* aW = (LAS float*)(dl); LAS float* aA = (LAS float*)(dl + RW_ARR); LAS float* aB = (LAS float*)(dl + 2 * RW_ARR); LAS float* aKD = (LAS float*)(dl + 3 * RW_ARR);
    LAS float* aR = (LAS float*)(dl + 4 * RW_ARR); LAS float* aV = (LAS float*)(dl + 5 * RW_ARR); LAS float* aY = (LAS float*)(dl + 6 * RW_ARR); LAS float* aQ = (LAS float*)(dl + 7 * RW_ARR);
    for (int pr = blockIdx.x; pr < 256; pr += gridDim.x) {
        const int bl = pr >> 6, h = pr & 63;
        bf16x8 Bw[3], Ba[3];
        { const size_t rowo = ((size_t)d * 4096 + h * 64 + 16 * wv + (lane & 15)) * 96 + 8 * (lane >> 4);
#pragma unroll
          for (int ks = 0; ks < 3; ++ks) { Bw[ks] = *(const bf16x8*)(W2T + rowo + 32 * ks); Ba[ks] = *(const bf16x8*)(A2T + rowo + 32 * ks); } }
        const int hn1 = h * 64 + 16 * wv + (lane & 15);
        const float w0v = w0[d * 4096 + hn1], a0v = a0[d * 4096 + hn1];
        const int pi = lt >> 4, nq = lt & 15, hn4 = h * 64 + 4 * nq;
        const f32x4 kk4 = *(const f32x4*)(k_k + hn4), ka4 = *(const f32x4*)(k_a + hn4), rk4 = *(const f32x4*)(r_k + hn4), lw4 = *(const f32x4*)(ln_w + hn4), lb4 = *(const f32x4*)(ln_b + hn4);
        const int rg = lt >> 3, kg = lt & 7;
        float S0[8], S1[8];
#pragma unroll
        for (int k = 0; k < 8; ++k) { S0[k] = 0.f; S1[k] = 0.f; }
        for (int cs = 0; cs < 144; ++cs) {
            const bool isctx = cs < 16; const int ci = isctx ? cs : cs - 16, nch = isctx ? 16 : 128;
            const int tc = d ? (nch - 1 - ci) : ci; const bool first = ci < 64;
            const size_t rowbase = isctx ? (size_t)bl * 256 : (size_t)1024 + (size_t)bl * 2048;
            { const int i = lane & 15; const int t = 16 * tc + (d ? 15 - i : i); const size_t row = rowbase + t;
              const bf16* lwr = LW + row * 192 + d * 96 + 8 * (lane >> 4); const bf16* lar = LA + row * 192 + d * 96 + 8 * (lane >> 4);
              f32x4 cw = {0.f, 0.f, 0.f, 0.f}, ca = {0.f, 0.f, 0.f, 0.f};
#pragma unroll
              for (int ks = 0; ks < 3; ++ks) { const bf16x8 Aw = *(const bf16x8*)(lwr + 32 * ks), Aa = *(const bf16x8*)(lar + 32 * ks);
                  cw = __builtin_amdgcn_mfma_f32_16x16x32_bf16(Aw, Bw[ks], cw, 0, 0, 0); ca = __builtin_amdgcn_mfma_f32_16x16x32_bf16(Aa, Ba[ks], ca, 0, 0, 0); }
#pragma unroll
              for (int reg = 0; reg < 4; ++reg) { const int ii = 4 * (lane >> 4) + reg; const int n = 16 * wv + (lane & 15);
                  const float x = -(w0v + cw[reg]);
                  const float sp = fmaxf(x, 0.f) + log1pf(__expf(-fabsf(x)));
                  const float wlog = -sp - 0.5f; const float dec = __expf(-__expf(wlog));
                  aW[ii * 64 + n] = dec; aB[ii * 64 + n] = sigmoidf_(a0v + ca[reg]); } }
            __syncthreads();
            { const int t = 16 * tc + (d ? 15 - pi : pi); const size_t off = (rowbase + t) * 4096 + hn4;
              const u32x2 kr = *(const u32x2*)(KB + off), rr = *(const u32x2*)(RB + off), vr = *(const u32x2*)(VB + off);
              const f32x4 k4 = {blo(kr.x), bhi(kr.x), blo(kr.y), bhi(kr.y)}, r4 = {blo(rr.x), bhi(rr.x), blo(rr.y), bhi(rr.y)}, v4 = {blo(vr.x), bhi(vr.x), blo(vr.y), bhi(vr.y)};
              f32x4 kk = k4 * kk4; float ss = (kk.x * kk.x + kk.y * kk.y) + (kk.z * kk.z + kk.w * kk.w); ss = red16(ss);
              const float inv = 1.0f / fmaxf(sqrtf(ss), 1e-12f); kk = kk * inv;
              const f32x4 ar = *(LAS f32x4*)(aB + pi * 64 + 4 * nq);
              const f32x4 kd = k4 * ((ar - 1.0f) * ka4 + 1.0f);
              *(LAS f32x4*)(aA + pi * 64 + 4 * nq) = -kk; *(LAS f32x4*)(aB + pi * 64 + 4 * nq) = kk * ar; *(LAS f32x4*)(aKD + pi * 64 + 4 * nq) = kd;
              *(LAS f32x4*)(aR + pi * 64 + 4 * nq) = r4; *(LAS f32x4*)(aV + pi * 64 + 4 * nq) = v4;
              const f32x4 qq = r4 * kd * rk4; float q = (qq.x + qq.y) + (qq.z + qq.w); q = red16(q); if (nq == 0) aQ[pi] = q; }
            __syncthreads();
#pragma unroll 2
            for (int i = 0; i < 16; ++i) {
                const f32x4 w_0 = *(LAS f32x4*)(aW + i * 64 + 8 * kg), w_1 = *(LAS f32x4*)(aW + i * 64 + 8 * kg + 4);
                const f32x4 a_0 = *(LAS f32x4*)(aA + i * 64 + 8 * kg), a_1 = *(LAS f32x4*)(aA + i * 64 + 8 * kg + 4);
                const f32x4 b_0 = *(LAS f32x4*)(aB + i * 64 + 8 * kg), b_1 = *(LAS f32x4*)(aB + i * 64 + 8 * kg + 4);
                const f32x4 k_0 = *(LAS f32x4*)(aKD + i * 64 + 8 * kg), k_1 = *(LAS f32x4*)(aKD + i * 64 + 8 * kg + 4);
                const float vv0 = aV[i * 64 + 2 * rg], vv1 = aV[i * 64 + 2 * rg + 1];
                const float wv_[8] = {w_0.x, w_0.y, w_0.z, w_0.w, w_1.x, w_1.y, w_1.z, w_1.w};
                const float av_[8] = {a_0.x, a_0.y, a_0.z, a_0.w, a_1.x, a_1.y, a_1.z, a_1.w};
                const float bv_[8] = {b_0.x, b_0.y, b_0.z, b_0.w, b_1.x, b_1.y, b_1.z, b_1.w};
                const float kv_[8] = {k_0.x, k_0.y, k_0.z, k_0.w, k_1.x, k_1.y, k_1.z, k_1.w};
                float sa0 = 0.f, sa1 = 0.f;
#pragma unroll
                for (int k = 0; k < 8; ++k) { sa0 += S0[k] * av_[k]; sa1 += S1[k] * av_[k]; }
                sa0 = red8(sa0); sa1 = red8(sa1);
#pragma unroll
                for (int k = 0; k < 8; ++k) { S0[k] = S0[k] * wv_[k] + sa0 * bv_[k] + vv0 * kv_[k]; S1[k] = S1[k] * wv_[k] + sa1 * bv_[k] + vv1 * kv_[k]; }
                if (!isctx) {
                    const f32x4 r_0 = *(LAS f32x4*)(aR + i * 64 + 8 * kg), r_1 = *(LAS f32x4*)(aR + i * 64 + 8 * kg + 4);
                    const float rv_[8] = {r_0.x, r_0.y, r_0.z, r_0.w, r_1.x, r_1.y, r_1.z, r_1.w};
                    float y0 = 0.f, y1 = 0.f;
#pragma unroll
                    for (int k = 0; k < 8; ++k) { y0 += S0[k] * rv_[k]; y1 += S1[k] * rv_[k]; }
                    y0 = red8(y0); y1 = red8(y1);
                    if (kg == 0) { aY[i * 64 + 2 * rg] = y0; aY[i * 64 + 2 * rg + 1] = y1; }
                }
            }
            __syncthreads();
            if (!isctx) {
                const int t = 16 * tc + (d ? 15 - pi : pi); const size_t rl = (size_t)bl * 2048 + t;
                const f32x4 y4 = *(LAS f32x4*)(aY + pi * 64 + 4 * nq);
                if (first) {
                    u32x2 o; o.x = pk2(y4.x, y4.y); o.y = pk2(y4.z, y4.w); *(u32x2*)(YP + rl * 4096 + hn4) = o;
                    if (nq == 0) QP[rl * 64 + h] = aQ[pi];
                } else {
                    const u32x2 pp = *(const u32x2*)(YP + rl * 4096 + hn4);
                    const f32x4 ys = {y4.x + blo(pp.x), y4.y + bhi(pp.x), y4.z + blo(pp.y), y4.w + bhi(pp.y)};
                    float sm = (ys.x + ys.y) + (ys.z + ys.w); sm = red16(sm); const float mean = sm * (1.0f / 64.0f);
                    const f32x4 dv = ys - mean; float vs = (dv.x * dv.x + dv.y * dv.y) + (dv.z * dv.z + dv.w * dv.w); vs = red16(vs);
                    const float rstd = 1.0f / sqrtf(vs * (1.0f / 64.0f) + 64e-5f);
                    const float q = aQ[pi] + QP[rl * 64 + h];
                    const f32x4 v4 = *(LAS f32x4*)(aV + pi * 64 + 4 * nq);
                    const f32x4 val = dv * rstd * lw4 + lb4 + v4 * q;
                    bf16* zp = ZB + (1024 + rl) * 4096 + hn4; const u32x2 zr = *(const u32x2*)zp;
                    const float z0 = blo(zr.x), z1 = bhi(zr.x), z2 = blo(zr.y), z3 = bhi(zr.y);
                    u32x2 o; o.x = pk2(val.x * z0 * sigmoidf_(z0), val.y * z1 * sigmoidf_(z1)); o.y = pk2(val.z * z2 * sigmoidf_(z2), val.w * z3 * sigmoidf_(z3));
                    *(u32x2*)zp = o;
                }
            }
        }
        __syncthreads();
    }
}

__device__ __forceinline__ void mix_phase(PPtr P, int i0, int i1, int i2, int gtid, int gthreads) {
    const bf16* H = (const bf16*)(P->ws + WS_H1); const float* mu = P->in[22];
    bf16* A0 = (bf16*)(P->ws + WS_A); bf16* A1 = (bf16*)(P->ws + WS_A + A_STRIDE); bf16* A2 = (bf16*)(P->ws + WS_A + 2 * A_STRIDE);
    for (int idx = gtid; idx < 9216 * 256; idx += gthreads) {
        const int row = idx >> 8, c0 = (idx & 255) * 8;
        int nrow = -1;
        if (row < 1024) { const int t = row & 255; if (c0 < 1024) { if (t > 0) nrow = row - 1; } else { if (t < 255) nrow = row + 1; } }
        else { const int t = (row - 1024) & 2047, gx = t & 63, gy = t >> 6, qd = c0 >> 9;
            if (qd == 0) { if (gx > 0) nrow = row - 1; } else if (qd == 1) { if (gx < 63) nrow = row + 1; } else if (qd == 2) { if (gy > 0) nrow = row - 64; } else { if (gy < 31) nrow = row + 64; } }
        const u32x4 hv = *(const u32x4*)(H + (size_t)row * 2048 + c0);
        u32x4 sv = {0u, 0u, 0u, 0u}; if (nrow >= 0) sv = *(const u32x4*)(H + (size_t)nrow * 2048 + c0);
        const float hf[8] = {blo(hv.x), bhi(hv.x), blo(hv.y), bhi(hv.y), blo(hv.z), bhi(hv.z), blo(hv.w), bhi(hv.w)};
        const float sf[8] = {blo(sv.x), bhi(sv.x), blo(sv.y), bhi(sv.y), blo(sv.z), bhi(sv.z), blo(sv.w), bhi(sv.w)};
#pragma unroll
        for (int q = 0; q < 3; ++q) { const int mi = q == 0 ? i0 : (q == 1 ? i1 : i2); bf16* dst = q == 0 ? A0 : (q == 1 ? A1 : A2);
            const f32x4 m0 = *(const f32x4*)(mu + mi * 2048 + c0), m1 = *(const f32x4*)(mu + mi * 2048 + c0 + 4);
            const float mm[8] = {m0.x, m0.y, m0.z, m0.w, m1.x, m1.y, m1.z, m1.w};
            float o[8];
#pragma unroll
            for (int e = 0; e < 8; ++e) o[e] = hf[e] + (sf[e] - hf[e]) * mm[e];
            u32x4 w; w.x = pk2(o[0], o[1]); w.y = pk2(o[2], o[3]); w.z = pk2(o[4], o[5]); w.w = pk2(o[6], o[7]);
            *(u32x4*)(dst + (size_t)row * 2048 + c0) = w; }
    }
}

__global__ void __launch_bounds__(NT, 2) fwd_megakernel(Params Pk) {
    extern __shared__ __attribute__((aligned(16))) unsigned char lds_raw[];
    LAS unsigned char* lds = (LAS unsigned char*)lds_raw;
    cg::grid_group grid = cg::this_grid();
    const int G = gridDim.x, NGW = G * 8, gthreads = G * NT;
#define TID_VARS GETP unsigned char* ws = P->ws; float* MOD = (float*)(ws + WS_MOD); (void)MOD; int tid = threadIdx.x; asm volatile("" : "+v"(tid)); const int lane = tid & 63, wave = __builtin_amdgcn_readfirstlane(tid >> 6); const int gw = blockIdx.x * 8 + wave, gtid = blockIdx.x * NT + tid; LAS float* scr = (LAS float*)(lds + wave * 16384); (void)lane; (void)gw; (void)gtid; (void)scr;

    { TID_VARS
      for (int tk = blockIdx.x; tk < 384; tk += G) mod_task(P, MOD, (LAS float*)(lds + 8 * 16384), tk, tid);
      constexpr int I_IN = 32 * 256, I_GLU = 64 * 128, I_OUT = 64 * 64;
      for (int it = gw; it < I_IN + I_GLU + I_OUT; it += NGW) { int r = it;
          if (r < I_IN) { transpose_item(P->in[7], 2048, 8192, (bf16*)(ws + WB_L0_IN), 0, scr, r, lane); continue; } r -= I_IN;
          if (r < I_GLU) { transpose_item(P->in[16], 4096, 4096, (bf16*)(ws + WB_L0_GLU), 0, scr, r, lane); continue; } r -= I_GLU;
          transpose_item(P->in[18], 4096, 2048, (bf16*)(ws + WB_L0_OUT), 0, scr, r, lane); } }
    grid.sync();
    { TID_VARS bf16* H0 = (bf16*)P->out;
      for (int m = gw; m < 18432; m += NGW) {
          if (m < 2048) normmod_row(P->in[2] + (size_t)m * 2048, P->in[4], MOD + 8 * 6144, H0 + (size_t)m * 2048, lane);
          else { const int r = m - 2048; normmod_row(P->in[0] + (size_t)r * 2048, P->in[4], MOD + (r >> 11) * 6144, H0 + (size_t)m * 2048, lane); } } }
    grid.sync();
    { GETP unsigned char* ws = P->ws; float* MOD = (float*)(ws + WS_MOD); (void)MOD; pg8::Gemm g{(const bf16*)P->out, (const bf16*)(ws + WB_L0_IN), 18432, 8192, 2048, 0, 1, 1 << 30}; pg8::StaticOrder S; S.init(18432, 8192, G, (int)blockIdx.x);
      pg8::EpiSplitBf16 E{(bf16*)(ws + WS_U), 4096, 4096, (size_t)18432 * 4096};
      pg8::gemm_phase<pg8::EpiSplitBf16, pg8::StaticOrder, true, true>(lds, g, S, E); }
    grid.sync();
    { TID_VARS s5_phase(P, lds, wave, lane); }
    grid.sync();
    { GETP unsigned char* ws = P->ws; float* MOD = (float*)(ws + WS_MOD); (void)MOD; pg8::Gemm g{(const bf16*)(ws + WS_Y), (const bf16*)(ws + WB_L0_GLU), 18432, 4096, 4096, 0, 1, 1 << 30}; pg8::StaticOrder S; S.init(18432, 4096, G, (int)blockIdx.x);
      pg8::EpiGlu E{(const bf16*)(ws + WS_Y), (bf16*)(ws + WS_Z), 4096, P->in[17]};
      pg8::gemm_phase<pg8::EpiGlu, pg8::StaticOrder, true, true>(lds, g, S, E); }
    grid.sync();
    { GETP unsigned char* ws = P->ws; float* MOD = (float*)(ws + WS_MOD); (void)MOD; pg8::Gemm g{(const bf16*)(ws + WS_Z), (const bf16*)(ws + WB_L0_OUT), 18432, 2048, 4096, 0, 1, 1 << 30}; pg8::StaticOrder S; S.init(18432, 2048, G, (int)blockIdx.x);
      pg8::EpiResid E{P->in[0], P->out, P->in[2], (float*)(ws + WS_XC), MOD, 2048, 0};
      pg8::gemm_phase<pg8::EpiResid, pg8::StaticOrder, true, true>(lds, g, S, E); }
    grid.sync();
    { TID_VARS constexpr int I_IN = 32 * 128, I_LO = 32 * 3, I_OUT = 64 * 64; bf16* WIN = (bf16*)(ws + WB_L1_IN);
      for (int it = gw; it < 4 * I_IN + 4 * I_LO + I_OUT; it += NGW) { int r = it;
          if (r < 4 * I_IN) { const int q = r / I_IN; transpose_item(P->in[23] + (size_t)q * 2048 * 4096, 2048, 4096, WIN, q * 4096, scr, r % I_IN, lane); continue; } r -= 4 * I_IN;
          if (r < 2 * I_LO) { const int q = r / I_LO; transpose_item(P->in[25] + (size_t)q * 2048 * 96, 2048, 96, WIN, 16384 + q * 96, scr, r % I_LO, lane); continue; } r -= 2 * I_LO;
          if (r < 2 * I_LO) { const int q = r / I_LO; transpose_item(P->in[28] + (size_t)q * 2048 * 96, 2048, 96, WIN, 16640 + q * 96, scr, r % I_LO, lane); continue; } r -= 2 * I_LO;
          transpose_item(P->in[35], 4096, 2048, (bf16*)(ws + WB_L1_OUT), 0, scr, r, lane); }
      for (int idx = gtid; idx < 2 * 64 * 2048 / 8; idx += gthreads) { const int e = idx * 8, pr = e / 2048, c = e % 2048; const int row = (pr < 64) ? 16576 + pr : 16832 + (pr - 64);
          *(u32x4*)(WIN + (size_t)row * 2048 + c) = (u32x4){0u, 0u, 0u, 0u}; }
      bf16* W2T = (bf16*)(ws + WS_W2T); bf16* A2T = (bf16*)(ws + WS_A2T);
      for (int idx = gtid; idx < 2 * 96 * 4096; idx += gthreads) { const int n = idx & 4095, m = (idx >> 12) % 96, dd = idx / (96 * 4096);
          W2T[((size_t)dd * 4096 + n) * 96 + m] = (bf16)f2bf(P->in[26][idx]); A2T[((size_t)dd * 4096 + n) * 96 + m] = (bf16)f2bf(P->in[29][idx]); } }
    for (int hb = 0; hb < 2; ++hb) {
        { TID_VARS bf16* H1 = (bf16*)(ws + WS_H1); const float* MOD1 = MOD + 9 * 6144;
          for (int m = gw; m < 9216; m += NGW) {
              if (m < 1024) normmod_row((const float*)(ws + WS_XC) + (size_t)(hb * 1024 + m) * 2048, P->in[19], MOD1 + 8 * 6144, H1 + (size_t)m * 2048, lane);
              else { const int r = hb * 8192 + (m - 1024); normmod_row(P->out + (size_t)r * 2048, P->in[19], MOD1 + (r >> 11) * 6144, H1 + (size_t)m * 2048, lane); } } }
        grid.sync();
        { TID_VARS mix_phase(P, 0, 1, 2, gtid, gthreads); }
        grid.sync();
        { GETP unsigned char* ws = P->ws; float* MOD = (float*)(ws + WS_MOD); (void)MOD; pg8::Gemm g{(const bf16*)(ws + WS_A), (const bf16*)(ws + WB_L1_IN), 9216, 12288, 2048, A_STRIDE, 16, 48}; pg8::StaticOrder S; S.init(9216, 12288, G, (int)blockIdx.x);
          pg8::EpiSplitBf16 E{(bf16*)(ws + WS_RKV), 4096, 4096, (size_t)9216 * 4096};
          pg8::gemm_phase<pg8::EpiSplitBf16, pg8::StaticOrder, true, true>(lds, g, S, E); }
        grid.sync();
        { TID_VARS mix_phase(P, 3, 4, 5, gtid, gthreads); }
        grid.sync();
        { GETP unsigned char* ws = P->ws; float* MOD = (float*)(ws + WS_MOD); (void)MOD; pg8::Gemm g{(const bf16*)(ws + WS_A), (const bf16*)(ws + WB_L1_IN) + (size_t)12288 * 2048, 9216, 4608, 2048, A_STRIDE, 16, 16}; pg8::StaticOrder S; S.init(9216, 4608, G, (int)blockIdx.x);
          pg8::EpiZLora E{(bf16*)(ws + WS_ZB), (bf16*)(ws + WS_ZB + ZB_LW), (bf16*)(ws + WS_ZB + ZB_LA)};
          pg8::gemm_phase<pg8::EpiZLora, pg8::StaticOrder, true, true>(lds, g, S, E); }
        grid.sync();
        { TID_VARS rwkv_phase(P, lds, hb, tid); }
        grid.sync();
        { GETP unsigned char* ws = P->ws; float* MOD = (float*)(ws + WS_MOD); (void)MOD; pg8::Gemm g{(const bf16*)(ws + WS_ZB) + (size_t)1024 * 4096, (const bf16*)(ws + WB_L1_OUT), 8192, 2048, 4096, 0, 1, 1 << 30}; pg8::StaticOrder S; S.init(8192, 2048, G, (int)blockIdx.x);
          pg8::EpiResid E{P->out, P->out, nullptr, nullptr, MOD + 9 * 6144, 0, hb * 8192};
          pg8::gemm_phase<pg8::EpiResid, pg8::StaticOrder, true, true>(lds, g, S, E); }
        grid.sync();
    }
    { TID_VARS const float* fg = P->in[36];
      for (int m = gw; m < 16384; m += NGW) { float* xr = P->out + (size_t)m * 2048;
          f32x4 v[8]; float s = 0.f;
#pragma unroll
          for (int j = 0; j < 8; ++j) { v[j] = ((const f32x4*)xr)[lane + 64 * j]; s += (v[j].x * v[j].x + v[j].y * v[j].y) + (v[j].z * v[j].z + v[j].w * v[j].w); }
          const float rstd = 1.0f / sqrtf(wave_sum(s) * (1.0f / 2048.0f) + 1e-6f);
#pragma unroll
          for (int j = 0; j < 8; ++j) ((f32x4*)xr)[lane + 64 * j] = v[j] * rstd * ((const f32x4*)fg)[lane + 64 * j]; } }
}

extern "C" void kernel_launch(void* const* d_in, const int* in_sizes, int n_in, void* d_out, int out_size, void* d_ws, size_t ws_size, hipStream_t stream) {
    static int grid = 0;
    if (grid == 0) {
        if (n_in != 37 || ws_size < WS_END) { fprintf(stderr, "kernel_launch: need 37 inputs and >= %zu bytes of workspace; got n_in %d, ws %zu; nothing launched\n", (size_t)WS_END, n_in, ws_size); grid = -1; return; }
        int dev = 0, cus = 0, per_cu = 0;
        if (hipGetDevice(&dev) != hipSuccess || hipDeviceGetAttribute(&cus, hipDeviceAttributeMultiprocessorCount, dev) != hipSuccess) { grid = -1; return; }
        if (hipFuncSetAttribute((const void*)fwd_megakernel, hipFuncAttributeMaxDynamicSharedMemorySize, LDS_BYTES) != hipSuccess) { fprintf(stderr, "kernel_launch: hipFuncSetAttribute failed\n"); grid = -1; return; }
        if (hipOccupancyMaxActiveBlocksPerMultiprocessor(&per_cu, (const void*)fwd_megakernel, NT, LDS_BYTES) != hipSuccess || per_cu < 1) { fprintf(stderr, "kernel_launch: occupancy query says %d\n", per_cu); per_cu = 1; }
        (void)hipGetLastError();
        grid = cus * 1;
    }
    if (grid < 0) return;
    (void)hipMemsetAsync((char*)d_ws + WS_MOD, 0, MOD_BYTES, stream);
    Params p{};
    for (int i = 0; i < 37; ++i) p.in[i] = (const float*)d_in[i];
    p.out = (float*)d_out; p.ws = (unsigned char*)d_ws;
    void* args[] = {&p};
    hipError_t e = hipLaunchCooperativeKernel((const void*)fwd_megakernel, dim3(grid), dim3(NT), args, LDS_BYTES, stream);
    if (e != hipSuccess) fprintf(stderr, "cooperative launch failed: %s (grid %d)\n", hipGetErrorString(e), grid);
}
```

```cpp
#include <hip/hip_runtime.h>
#include <hip/hip_cooperative_groups.h>
#include <cstdio>
#include <cstdint>
namespace cg = cooperative_groups;
namespace pg8 {
#define PG8_LAS __attribute__((address_space(3)))
typedef unsigned short bf16_t;
typedef short bf16x8 __attribute__((ext_vector_type(8)));
typedef float f32x4 __attribute__((ext_vector_type(4)));
typedef unsigned u32x4 __attribute__((ext_vector_type(4)));
constexpr int BM = 256, BK = 64, HALF = 128, HTB = HALF * BK * 2  , STAGE_BYTES = 8 * HTB, NXCD = 8, WGM = 8;

__host__ __device__ __forceinline__ int lds_byte(int r, int c) { const int st = (r >> 4) * 2 + (c >> 5), rr = r & 15, cc = c & 31, ob = rr * 64 + cc * 2; return st * 1024 + (ob ^ (((ob >> 9) & 1) << 5)); }
__host__ __device__ __forceinline__ void stage_rc(int b, int& R, int& C) { const int st = b / 1024, sb = b % 1024, swz = sb ^ (((sb >> 9) & 1) << 5); R = (st >> 1) * 16 + swz / 64; C = (st & 1) * 32 + (swz % 64) / 2; }
__host__ __device__ __forceinline__ int perm32(int rho) { const int n = rho >> 4, i = rho & 15; return 8 * (i >> 2) + 4 * n + (i & 3); }

struct Unit { int pm, pn; };
struct Gemm { const bf16_t* A; const bf16_t* Bt; int M, N, K; size_t a_stride; int a_div, a_n0; };
#define PG8_AIDX(g, pn) ((size_t)((pn) < (g).a_n0 ? (pn) / (g).a_div : (g).a_n0 / (g).a_div + ((pn) - (g).a_n0)) * (g).a_stride)

struct StaticOrder {
    int nM, nN, nwg, G, c;
    __host__ __device__ void init(int M, int N, int G_, int c_) { nM = M / BM; nN = N / BM; nwg = nM * nN; G = G_; c = c_; }
    __host__ __device__ bool next(int i, Unit& u) const {
        const long L = (long)i * G + c; if (L >= nwg) return false;
        int wgid = (int)L; { const int q = nwg / NXCD, r = nwg % NXCD, xcd = wgid % NXCD, off = wgid / NXCD; wgid = (xcd < r ? xcd * (q + 1) : r * (q + 1) + (xcd - r) * q) + off; }
        const int nig = WGM * nN, gid = wgid / nig, fm = gid * WGM, gsz = (nM - fm) < WGM ? (nM - fm) : WGM;
        u.pm = fm + ((wgid % nig) % gsz); u.pn = (wgid % nig) / gsz; return true;
    }
    __device__ __forceinline__ void a_ready(const Unit&) const {}
    __device__ __forceinline__ void done(const Unit&) const {}
};
typedef float f32x2g __attribute__((ext_vector_type(2))); typedef __bf16 bf16x2g __attribute__((ext_vector_type(2)));
__device__ __forceinline__ unsigned cvt_pk_bf16(float lo, float hi) { const f32x2g v = {lo, hi}; const bf16x2g b = __builtin_convertvector(v, bf16x2g); return __builtin_bit_cast(unsigned, b); }
__device__ __forceinline__ float bflo(unsigned w) { return __builtin_bit_cast(float, w << 16); }
__device__ __forceinline__ float bfhi(unsigned w) { return __builtin_bit_cast(float, w & 0xffff0000u); }
__device__ __forceinline__ float sigm(float x) { return __builtin_amdgcn_rcpf(1.0f + __expf(-x)); }
__device__ __forceinline__ float tanh_f(float x) { const float e = __expf(2.0f * x); return 1.0f - 2.0f * __builtin_amdgcn_rcpf(1.0f + e); }

struct EpiSplitBf16 {
    static constexpr bool PERM = true, AFTER_DRAIN = false;
    bf16_t* O; int ldc; int split_cols; size_t split_stride;
    __device__ __forceinline__ void operator()(const f32x4 (&acc)[2][2][4][2], const Unit& u, int wr, int wc, int fr, int fq) const {
        const int row0 = u.pm * BM + wr * 64 + fr; int colt = u.pn * BM; bf16_t* base = O;
        { const int t = colt / split_cols; base += (size_t)t * split_stride; colt -= t * split_cols; }
        const int col0 = colt + wc * 32 + 8 * fq;
#pragma unroll
        for (int ai = 0; ai < 2; ++ai)
#pragma unroll
            for (int m = 0; m < 4; ++m) { bf16_t* rowp = base + (size_t)(row0 + ai * HALF + m * 16) * ldc + col0;
#pragma unroll
                for (int bj = 0; bj < 2; ++bj) { const f32x4 v0 = acc[ai][bj][m][0], v1 = acc[ai][bj][m][1];
                    u32x4 w; w.x = cvt_pk_bf16(v0[0], v0[1]); w.y = cvt_pk_bf16(v0[2], v0[3]); w.z = cvt_pk_bf16(v1[0], v1[1]); w.w = cvt_pk_bf16(v1[2], v1[3]);
                    *(u32x4*)(rowp + bj * HALF) = w; } }
    }
};

struct EpiGlu {
    static constexpr bool PERM = true, AFTER_DRAIN = false;
    const bf16_t* Y; bf16_t* Z; int ldc; const float* bias;
    __device__ __forceinline__ void operator()(const f32x4 (&acc)[2][2][4][2], const Unit& u, int wr, int wc, int fr, int fq) const {
        const int row0 = u.pm * BM + wr * 64 + fr; const int col0 = u.pn * BM + wc * 32 + 8 * fq;
#pragma unroll
        for (int bj = 0; bj < 2; ++bj) {
            const f32x4 b0 = *(const f32x4*)(bias + col0 + bj * HALF), b1 = *(const f32x4*)(bias + col0 + bj * HALF + 4);
#pragma unroll
            for (int ai = 0; ai < 2; ++ai)
#pragma unroll
                for (int m = 0; m < 4; ++m) {
                    const size_t off = (size_t)(row0 + ai * HALF + m * 16) * ldc + col0 + bj * HALF;
                    const u32x4 yy = *(const u32x4*)(Y + off); const u32x4 zz = *(const u32x4*)(Z + off);
                    const f32x4 t0 = acc[ai][bj][m][0] + b0, t1 = acc[ai][bj][m][1] + b1;
                    float o[8];
#define GLU1(k, yv, zv, tv) { const float y_ = (yv), z_ = (zv); o[k] = (y_ * z_) * __builtin_amdgcn_rcpf((1.0f + __expf(-(tv))) * (1.0f + __expf(-z_))); }
                    GLU1(0, bflo(yy.x), bflo(zz.x), t0[0]) GLU1(1, bfhi(yy.x), bfhi(zz.x), t0[1])
                    GLU1(2, bflo(yy.y), bflo(zz.y), t0[2]) GLU1(3, bfhi(yy.y), bfhi(zz.y), t0[3])
                    GLU1(4, bflo(yy.z), bflo(zz.z), t1[0]) GLU1(5, bfhi(yy.z), bfhi(zz.z), t1[1])
                    GLU1(6, bflo(yy.w), bflo(zz.w), t1[2]) GLU1(7, bfhi(yy.w), bfhi(zz.w), t1[3])
#undef GLU1
                    u32x4 w; w.x = cvt_pk_bf16(o[0], o[1]); w.y = cvt_pk_bf16(o[2], o[3]); w.z = cvt_pk_bf16(o[4], o[5]); w.w = cvt_pk_bf16(o[6], o[7]);
                    *(u32x4*)(Z + off) = w; }
        }
    }
};

struct EpiResid {
    static constexpr bool PERM = false, AFTER_DRAIN = false;
    const float* XIN; float* OUT; const float* CTXIN; float* XC; const float* MOD; int ctx_rows; int lat_row0;
    __device__ __forceinline__ void operator()(const f32x4 (&acc)[2][2][4][2], const Unit& u, int wr, int wc, int fr, int fq) const {
        const int row0 = u.pm * BM + wr * 64 + fr, col0 = u.pn * BM + wc * 32 + 4 * fq;
        const bool isctx = (u.pm * BM) < ctx_rows;
#pragma unroll
        for (int ai = 0; ai < 2; ++ai)
#pragma unroll
            for (int m = 0; m < 4; ++m) {
                const int row = row0 + ai * HALF + m * 16;
                const int rr = isctx ? row : (row - ctx_rows + lat_row0); const int gj = isctx ? 8 : (rr >> 11);
                const float* src = (isctx ? CTXIN : XIN) + (size_t)rr * 2048; float* dst = (isctx ? XC : OUT) + (size_t)rr * 2048; const float* gate = MOD + gj * 6144 + 4096;
#pragma unroll
                for (int bj = 0; bj < 2; ++bj)
#pragma unroll
                    for (int n = 0; n < 2; ++n) { const int c = col0 + bj * HALF + n * 16;
                        const f32x4 g4 = *(const f32x4*)(gate + c); const f32x4 x4 = *(const f32x4*)(src + c);
                        *(f32x4*)(dst + c) = x4 + g4 * acc[ai][bj][m][n]; }
            }
    }
};

struct EpiZLora {
    static constexpr bool PERM = true, AFTER_DRAIN = false;
    bf16_t* Zb; bf16_t* LW; bf16_t* LA;
    __device__ __forceinline__ void operator()(const f32x4 (&acc)[2][2][4][2], const Unit& u, int wr, int wc, int fr, int fq) const {
        const int row0 = u.pm * BM + wr * 64 + fr;
        if (u.pn < 16) {
            if (u.pm < 4) return;
            const int col0 = u.pn * BM + wc * 32 + 8 * fq;
#pragma unroll
            for (int ai = 0; ai < 2; ++ai)
#pragma unroll
                for (int m = 0; m < 4; ++m) { bf16_t* rowp = Zb + (size_t)(row0 + ai * HALF + m * 16) * 4096 + col0;
#pragma unroll
                    for (int bj = 0; bj < 2; ++bj) { const f32x4 v0 = acc[ai][bj][m][0], v1 = acc[ai][bj][m][1];
                        u32x4 w; w.x = cvt_pk_bf16(v0[0], v0[1]); w.y = cvt_pk_bf16(v0[2], v0[3]); w.z = cvt_pk_bf16(v1[0], v1[1]); w.w = cvt_pk_bf16(v1[2], v1[3]);
                        *(u32x4*)(rowp + bj * HALF) = w; } }
        } else {
            const bool isw = (u.pn == 16); bf16_t* base = isw ? LW : LA;
#pragma unroll
            for (int bj = 0; bj < 2; ++bj) {
                const int col = bj * HALF + wc * 32 + 8 * fq;
                if (col < 192) {
#pragma unroll
                    for (int ai = 0; ai < 2; ++ai)
#pragma unroll
                        for (int m = 0; m < 4; ++m) { f32x4 v0 = acc[ai][bj][m][0], v1 = acc[ai][bj][m][1];
                            if (isw) { v0[0] = tanh_f(v0[0]); v0[1] = tanh_f(v0[1]); v0[2] = tanh_f(v0[2]); v0[3] = tanh_f(v0[3]); v1[0] = tanh_f(v1[0]); v1[1] = tanh_f(v1[1]); v1[2] = tanh_f(v1[2]); v1[3] = tanh_f(v1[3]); }
                            u32x4 w; w.x = cvt_pk_bf16(v0[0], v0[1]); w.y = cvt_pk_bf16(v0[2], v0[3]); w.z = cvt_pk_bf16(v1[0], v1[1]); w.w = cvt_pk_bf16(v1[2], v1[3]);
                            *(u32x4*)(base + (size_t)(row0 + ai * HALF + m * 16) * 192 + col) = w; }
                }
            }
        }
    }
};
template <class Epi, class Sched, bool ALIGN_EPI = false, bool SP2 = false>
__device__ __forceinline__ void gemm_phase(PG8_LAS unsigned char* lds, const Gemm g, const Sched& S, const Epi& E) {
    int tid_l = threadIdx.x; asm volatile("" : "+v"(tid_l));
    const int tid = tid_l, wid = __builtin_amdgcn_readfirstlane(tid >> 6), lane = tid & 63, wr = wid >> 2, wc = wid & 3, fr = lane & 15, fq = lane >> 4;
    const int K = g.K, nt = K / BK;
    unsigned voffA[2], voffB[2];
#pragma unroll
    for (int i = 0; i < 2; ++i) { int R, C; stage_rc(tid * 16 + i * 8192, R, C); const int Rb = Epi::PERM ? ((R & ~31) + perm32(R & 31)) : R;
        voffA[i] = (unsigned)(R * K + C) * 2u; voffB[i] = (unsigned)(Rb * K + C) * 2u; }
    const size_t kstep = (size_t)(BK * 2);
    const size_t hstep = (size_t)HALF * K * 2;
    const size_t tstep = 2 * hstep;
    const unsigned ldsw = (unsigned)wid * 1024u;
    const int aoff = lds_byte(wr * 64 + fr, fq * 8), boff = lds_byte(wc * 32 + fr, fq * 8);
#define PG8_SA(b, h) (((b) * 2 + (h)) * HTB)
#define PG8_SB(b, h) ((4 + (b) * 2 + (h)) * HTB)
#define PG8_STAGE(bufoff, gbase, voff) do { _Pragma("unroll") for (int _i = 0; _i < 2; ++_i) \
        __builtin_amdgcn_global_load_lds((const unsigned*)((const char*)(gbase) + (voff)[_i]), (PG8_LAS unsigned*)(lds + (bufoff) + ldsw + _i * 8192), 16, 0, 0); } while (0)
#define PG8_LDA(dst, b, h) do { _Pragma("unroll") for (int m = 0; m < 4; ++m) _Pragma("unroll") for (int k = 0; k < 2; ++k) dst[m][k] = *(const PG8_LAS bf16x8*)(lds + PG8_SA(b, h) + aoff + m * 2048 + k * 1024); } while (0)
#define PG8_LDB(dst, b, h) do { _Pragma("unroll") for (int n = 0; n < 2; ++n) _Pragma("unroll") for (int k = 0; k < 2; ++k) dst[n][k] = *(const PG8_LAS bf16x8*)(lds + PG8_SB(b, h) + boff + n * 2048 + k * 1024); } while (0)
#define PG8_MMA(ai, bj, At, Bt) do { __builtin_amdgcn_s_setprio(1); _Pragma("unroll") for (int m = 0; m < 4; ++m) _Pragma("unroll") for (int n = 0; n < 2; ++n) _Pragma("unroll") for (int k = 0; k < 2; ++k) \
        acc[ai][bj][m][n] = __builtin_amdgcn_mfma_f32_16x16x32_bf16(Bt[n][k], At[m][k], acc[ai][bj][m][n], 0, 0, 0); __builtin_amdgcn_s_setprio(0); } while (0)
#define PG8_WAIT_V(n) asm volatile("s_waitcnt vmcnt(" #n ")" ::: "memory")
#define PG8_WAIT_L(n) asm volatile("s_waitcnt lgkmcnt(" #n ")" ::: "memory")
#define PG8_BAR __builtin_amdgcn_s_barrier()
#define PG8_SCHED __builtin_amdgcn_sched_barrier(0)
    Unit cur, nxt; int ui = 0;
    if (!S.next(0, cur)) return;
    f32x4 acc[2][2][4][2];
#pragma unroll
    for (int a = 0; a < 2; ++a)
#pragma unroll
        for (int b = 0; b < 2; ++b)
#pragma unroll
            for (int m = 0; m < 4; ++m)
#pragma unroll
                for (int n = 0; n < 2; ++n) acc[a][b][m][n] = (f32x4){0.f, 0.f, 0.f, 0.f};
    bf16x8 At[4][2], B0[2][2], B1[2][2];
    const char* cA = (const char*)g.A + PG8_AIDX(g, cur.pn) + (size_t)cur.pm * tstep; const char* cB = (const char*)g.Bt + (size_t)cur.pn * tstep;
    S.a_ready(cur);
    if constexpr (SP2) {
        PG8_STAGE(PG8_SB(0, 0), cB, voffB); PG8_STAGE(PG8_SB(0, 1), cB + hstep, voffB); PG8_STAGE(PG8_SA(0, 0), cA, voffA); PG8_STAGE(PG8_SA(0, 1), cA + hstep, voffA);
        if (wr == 1) PG8_BAR;
        PG8_WAIT_V(2); PG8_BAR;
        PG8_STAGE(PG8_SB(1, 0), cB + kstep, voffB); PG8_STAGE(PG8_SA(1, 0), cA + kstep, voffA); PG8_STAGE(PG8_SB(1, 1), cB + hstep + kstep, voffB);
        PG8_WAIT_V(6); PG8_BAR;
    } else {
        PG8_STAGE(PG8_SB(0, 0), cB, voffB); PG8_STAGE(PG8_SA(0, 0), cA, voffA); PG8_STAGE(PG8_SB(0, 1), cB + hstep, voffB); PG8_STAGE(PG8_SA(0, 1), cA + hstep, voffA);
        if (wr == 1) PG8_BAR;
        PG8_WAIT_V(4); PG8_BAR;
        PG8_STAGE(PG8_SB(1, 0), cB + kstep, voffB); PG8_STAGE(PG8_SA(1, 0), cA + kstep, voffA); PG8_STAGE(PG8_SB(1, 1), cB + hstep + kstep, voffB);
        PG8_WAIT_V(6); PG8_BAR;
    }
    for (;;) {
        const bool has_next = S.next(ui + 1, nxt);
        const char* nA = has_next ? (const char*)g.A + PG8_AIDX(g, nxt.pn) + (size_t)nxt.pm * tstep : cA; const char* nB = has_next ? (const char*)g.Bt + (size_t)nxt.pn * tstep : cB;
        for (int t = 0; t < nt; t += 2) {
            const bool last = (t == nt - 2);
            const char* a1 = cA + (size_t)(t + 1) * kstep;
            const char* a2 = last ? nA : cA + (size_t)(t + 2) * kstep; const char* b2 = last ? nB : cB + (size_t)(t + 2) * kstep;
            const char* a3 = a2 + kstep; const char* b3 = b2 + kstep;
            if (last && has_next) S.a_ready(nxt);
            if constexpr (SP2) {
            PG8_LDB(B0, 0, 0); PG8_LDB(B1, 0, 1); PG8_SCHED; PG8_LDA(At, 0, 0); PG8_STAGE(PG8_SA(1, 1), a1 + hstep, voffA);
            PG8_WAIT_V(8); PG8_WAIT_L(0); PG8_BAR; PG8_MMA(0, 0, At, B0); PG8_MMA(0, 1, At, B1); PG8_BAR; PG8_SCHED;
            PG8_LDA(At, 0, 1); PG8_STAGE(PG8_SB(0, 0), b2, voffB); PG8_STAGE(PG8_SB(0, 1), b2 + hstep, voffB); PG8_STAGE(PG8_SA(0, 0), a2, voffA);
            PG8_WAIT_V(8); PG8_WAIT_L(0); PG8_BAR; PG8_MMA(1, 0, At, B0); PG8_MMA(1, 1, At, B1); PG8_BAR; PG8_SCHED;
            PG8_LDB(B0, 1, 0); PG8_LDB(B1, 1, 1); PG8_SCHED; PG8_LDA(At, 1, 0); PG8_STAGE(PG8_SA(0, 1), a2 + hstep, voffA);
            PG8_WAIT_V(8); PG8_WAIT_L(0); PG8_BAR; PG8_MMA(0, 0, At, B0); PG8_MMA(0, 1, At, B1); PG8_BAR; PG8_SCHED;
            PG8_LDA(At, 1, 1); PG8_STAGE(PG8_SB(1, 0), b3, voffB); PG8_STAGE(PG8_SB(1, 1), b3 + hstep, voffB); PG8_STAGE(PG8_SA(1, 0), a3, voffA);
            PG8_WAIT_V(8); PG8_WAIT_L(0); PG8_BAR; PG8_MMA(1, 0, At, B0); PG8_MMA(1, 1, At, B1); PG8_BAR; PG8_SCHED;
            } else {
            PG8_LDB(B0, 0, 0); PG8_SCHED; PG8_LDA(At, 0, 0); PG8_STAGE(PG8_SA(1, 1), a1 + hstep, voffA);
            PG8_WAIT_L(8); PG8_BAR; PG8_WAIT_L(0); PG8_MMA(0, 0, At, B0); PG8_BAR; PG8_SCHED;
            PG8_LDB(B1, 0, 1); PG8_STAGE(PG8_SB(0, 0), b2, voffB);
            PG8_BAR; PG8_WAIT_L(0); PG8_MMA(0, 1, At, B1); PG8_BAR;
            PG8_LDA(At, 0, 1); PG8_STAGE(PG8_SA(0, 0), a2, voffA);
            PG8_BAR; PG8_WAIT_L(0); PG8_MMA(1, 0, At, B0); PG8_BAR; PG8_SCHED;
            PG8_STAGE(PG8_SB(0, 1), b2 + hstep, voffB);
            PG8_WAIT_V(6); PG8_BAR; PG8_MMA(1, 1, At, B1); PG8_BAR;
            PG8_LDB(B0, 1, 0); PG8_SCHED; PG8_LDA(At, 1, 0); PG8_STAGE(PG8_SA(0, 1), a2 + hstep, voffA);
            PG8_WAIT_L(8); PG8_BAR; PG8_WAIT_L(0); PG8_MMA(0, 0, At, B0); PG8_BAR; PG8_SCHED;
            PG8_LDB(B1, 1, 1); PG8_STAGE(PG8_SB(1, 0), b3, voffB);
            PG8_BAR; PG8_WAIT_L(0); PG8_MMA(0, 1, At, B1); PG8_BAR;
            PG8_LDA(At, 1, 1); PG8_STAGE(PG8_SA(1, 0), a3, voffA);
            PG8_BAR; PG8_WAIT_L(0); PG8_MMA(1, 0, At, B0); PG8_BAR; PG8_SCHED;
            PG8_STAGE(PG8_SB(1, 1), b3 + hstep, voffB);
            PG8_WAIT_V(6); PG8_BAR; PG8_MMA(1, 1, At, B1); PG8_BAR;
            }
        }
        if constexpr (ALIGN_EPI) { if (wr == 0) PG8_BAR; }
        if constexpr (!Epi::AFTER_DRAIN) { E(acc, cur, wr, wc, fr, fq); S.done(cur); }
        if (!has_next) break;
#pragma unroll
        for (int a = 0; a < 2; ++a)
#pragma unroll
            for (int b = 0; b < 2; ++b)
#pragma unroll
                for (int m = 0; m < 4; ++m)
#pragma unroll
                    for (int n = 0; n < 2; ++n) acc[a][b][m][n] = (f32x4){0.f, 0.f, 0.f, 0.f};
        cur = nxt; cA = nA; cB = nB; ++ui;
        if constexpr (ALIGN_EPI) { if (wr == 1) PG8_BAR; }
    }
    PG8_WAIT_V(0);
    if constexpr (!ALIGN_EPI) { if (wr == 0) PG8_BAR; }
    PG8_BAR;
    if constexpr (Epi::AFTER_DRAIN) { E.fused(acc, cur, wr, wc, fr, fq, lds, wid, lane); S.done(cur); }
#undef PG8_SA
#undef PG8_SB
#undef PG8_STAGE
#undef PG8_LDA
#undef PG8_LDB
#undef PG8_MMA
#undef PG8_WAIT_V
#undef PG8_WAIT_L
#undef PG8_BAR
#undef PG8_SCHED
}
}

#define LAS __attribute__((address_space(3)))
typedef unsigned short bf16;
typedef short bf16x8 __attribute__((ext_vector_type(8)));
typedef float f32x4 __attribute__((ext_vector_type(4)));
typedef float f32x16 __attribute__((ext_vector_type(16)));
typedef unsigned u32x4 __attribute__((ext_vector_type(4)));
typedef unsigned u32x2 __attribute__((ext_vector_type(2)));

constexpr int NT = 512;
constexpr int LDS_BYTES = 147456;
constexpr size_t MiB = 1u << 20;
constexpr size_t WS_MOD = 0;
constexpr size_t MOD_BYTES = 2 * 9 * 6144 * 4;
constexpr size_t WS_BAR = 448 * 1024;
constexpr size_t ZERO_BYTES = WS_BAR + 3456 * 4;
constexpr int LDS_BARST = LDS_BYTES - 64;
constexpr size_t WS_QP = 1 * MiB;
constexpr size_t WS_W2T = 3 * MiB;
constexpr size_t WS_A2T = WS_W2T + 2 * 4096 * 96 * 2;
constexpr size_t WS_XC = 6 * MiB;
constexpr size_t WS_WB = 22 * MiB;
constexpr size_t WB_L0_IN = WS_WB, WB_L0_GLU = WS_WB + 32 * MiB, WB_L0_OUT = WS_WB + 64 * MiB;
constexpr size_t WB_L1_IN = WS_WB, WB_L1_OUT = WS_WB + 66 * MiB;
constexpr size_t WS_BIG = 106 * MiB;
constexpr size_t WS_U = WS_BIG, WS_Z = WS_BIG + 144 * MiB, WS_Y = WS_BIG + 288 * MiB;
constexpr size_t WS_H1 = WS_BIG, WS_A = WS_BIG + 36 * MiB, WS_RKV = WS_BIG + 144 * MiB, WS_ZB = WS_BIG + 360 * MiB;
constexpr size_t WS_END = WS_BIG + 432 * MiB;
constexpr size_t A_STRIDE = (size_t)9216 * 2048 * 2;
constexpr size_t WS_YP = WS_A;
constexpr size_t ZB_LW = 0, ZB_LA = (size_t)9216 * 192 * 2;

struct Params { const float* in[37]; float* out; unsigned char* ws; };
typedef const __attribute__((address_space(4))) Params* PPtr;
#define GETP PPtr P = (PPtr)__builtin_amdgcn_kernarg_segment_ptr(); asm volatile("" : "+s"(P));

typedef float f32x2c __attribute__((ext_vector_type(2)));
typedef __bf16 bf16x2c __attribute__((ext_vector_type(2)));
__device__ __forceinline__ unsigned pk2(float lo, float hi) { const f32x2c v = {lo, hi}; const bf16x2c b = __builtin_convertvector(v, bf16x2c); return __builtin_bit_cast(unsigned, b); }
__device__ __forceinline__ unsigned f2bf(float f) { const __bf16 b = (__bf16)f; return (unsigned)__builtin_bit_cast(unsigned short, b); }
__device__ __forceinline__ unsigned f2bf_lo16(float f) { return f2bf(f); }
__device__ __forceinline__ float bf2f(unsigned h) { return __builtin_bit_cast(float, h << 16); }
__device__ __forceinline__ float blo(unsigned w) { return __builtin_bit_cast(float, w << 16); }
__device__ __forceinline__ float bhi(unsigned w) { return __builtin_bit_cast(float, w & 0xffff0000u); }
__device__ __forceinline__ float wave_sum(float v) {
#pragma unroll
    for (int o = 1; o < 64; o <<= 1) v += __shfl_xor(v, o);
    return v;
}
#define DPPF(v, ctrl) __builtin_bit_cast(float, __builtin_amdgcn_update_dpp(0, __builtin_bit_cast(int, (v)), (ctrl), 0xF, 0xF, true))
__device__ __forceinline__ float red8(float v) { v += DPPF(v, 0xB1); v += DPPF(v, 0x4E); v += DPPF(v, 0x141); return v; }
__device__ __forceinline__ float red16(float v) { v = red8(v); v += DPPF(v, 0x128); return v; }
__device__ __forceinline__ float sigmoidf_(float x) { return __builtin_amdgcn_rcpf(1.0f + __expf(-x)); }

#define XB_TMO      128
#define XB_XCNT(j)  (256  + 64 * (j))
#define XB_XSUB(j)  (1280 + 64 * (j))
#define XB_XGEN(j)  (2304 + 64 * (j))
#define XB_TOP      3328
#define XB_TOPGEN   3392
#define XCD_BAR_WORDS 3456
#define XB_SPIN_CAP (1u << 18)

__device__ __forceinline__ unsigned xb_ld(unsigned* p)              { return __hip_atomic_load(p, __ATOMIC_RELAXED, __HIP_MEMORY_SCOPE_AGENT); }
__device__ __forceinline__ unsigned xb_add(unsigned* p, unsigned v) { return __hip_atomic_fetch_add(p, v, __ATOMIC_RELAXED, __HIP_MEMORY_SCOPE_AGENT); }
__device__ __forceinline__ unsigned xb_xcc_id() { return (unsigned)__builtin_amdgcn_s_getreg((3 << 11) | 20) & 0xFu; }
#define XB_SPIN(cond, bar) do { unsigned _sp = 0; while (cond) { __builtin_amdgcn_s_sleep(1); \
    if ((++_sp & 255u) == 0u) { if (xb_ld(&(bar)[XB_TMO])) break; if (_sp > XB_SPIN_CAP) { atomicAdd(&(bar)[XB_TMO], 1u); break; } } } } while (0)

struct XcdBarrier {
    unsigned* bar; unsigned x;
    volatile LAS unsigned* st;
};

__device__ __forceinline__ XcdBarrier xcd_barrier_post(unsigned* bar, volatile LAS unsigned* st) {
    XcdBarrier b; b.bar = bar; b.x = xb_xcc_id(); b.st = st;
    if (threadIdx.x == 0) (void)xb_add(&bar[XB_XCNT(b.x)], 1u);
    return b;
}
__device__ __forceinline__ void xcd_barrier_complete(unsigned* bar, unsigned x, unsigned& nloc, unsigned& nx) {
    const unsigned G = gridDim.x * gridDim.y * gridDim.z;
    unsigned sum, cnt, mine, sp = 0u;
    for (;;) {
        sum = 0u; cnt = 0u; mine = 0u;
#pragma unroll
        for (unsigned j = 0; j < 16; ++j) { const unsigned c = xb_ld(&bar[XB_XCNT(j)]); sum += c; cnt += (c > 0u) ? 1u : 0u; mine = (j == x) ? c : mine; }
        if (sum == G) break;
        __builtin_amdgcn_s_sleep(1);
        if ((++sp & 255u) == 0u) { if (xb_ld(&bar[XB_TMO])) break; if (sp > XB_SPIN_CAP) { atomicAdd(&bar[XB_TMO], 1u); break; } }
    }
    nloc = mine > 0u ? mine : 1u; nx = cnt > 0u ? cnt : 1u;
}

__device__ __forceinline__ void xcd_barrier(const XcdBarrier& b) {
    asm volatile("s_waitcnt vmcnt(0)" ::: "memory");
    __syncthreads();
    if (threadIdx.x == 0) {
        unsigned* bar = b.bar;
        __builtin_amdgcn_s_waitcnt(0);
        unsigned nloc = b.st[0], nx = b.st[1];
        if (nloc == 0u) { xcd_barrier_complete(bar, b.x, nloc, nx); b.st[0] = nloc; b.st[1] = nx; }
        const unsigned old = xb_add(&bar[XB_XSUB(b.x)], 1u);
        const unsigned gen = old / nloc;
        if (old + 1u == (gen + 1u) * nloc) {
            __builtin_amdgcn_fence(__ATOMIC_RELEASE, "agent");
            asm volatile("s_waitcnt vmcnt(0)" ::: "memory");
            const unsigned og = xb_add(&bar[XB_TOP], 1u);
            const unsigned tg = og / nx;
            if (og + 1u == (tg + 1u) * nx) xb_add(&bar[XB_TOPGEN], 1u);
            else XB_SPIN(xb_ld(&bar[XB_TOPGEN]) == tg, bar);
            __builtin_amdgcn_fence(__ATOMIC_ACQUIRE, "agent");
            xb_add(&bar[XB_XGEN(b.x)], 1u);
            asm volatile("s_waitcnt vmcnt(0)" ::: "memory");
        } else {
            XB_SPIN(xb_ld(&bar[XB_XGEN(b.x)]) == gen, bar);
            __builtin_amdgcn_fence(__ATOMIC_ACQUIRE, "agent");
            asm volatile("s_waitcnt vmcnt(0)" ::: "memory");
        }
    }
    __syncthreads();
}

__device__ __forceinline__ void transpose_item(const float* W, int K, int N, bf16* WT, int row_off, LAS float* scr, int item, int lane) {
    const int nblk = N / 32, kb = item / nblk, nb = item % nblk, k0 = 64 * kb, n0 = 32 * nb;
    float tv[32];
#pragma unroll
    for (int i = 0; i < 32; ++i) { const int kk = 2 * i + (lane >> 5); tv[i] = W[(size_t)(k0 + kk) * N + n0 + (lane & 31)]; }
#pragma unroll
    for (int i = 0; i < 32; ++i) { const int kk = 2 * i + (lane >> 5); scr[kk * 33 + (lane & 31)] = tv[i]; }
    asm volatile("s_waitcnt lgkmcnt(0)" ::: "memory");
    const int c = lane & 7;
#pragma unroll
    for (int j = 0; j < 4; ++j) { const int n = (lane >> 3) + 8 * j; const LAS float* s = scr + (8 * c) * 33 + n;
        u32x4 o; o.x = pk2(s[0 * 33], s[1 * 33]); o.y = pk2(s[2 * 33], s[3 * 33]); o.z = pk2(s[4 * 33], s[5 * 33]); o.w = pk2(s[6 * 33], s[7 * 33]);
        *(u32x4*)(WT + (size_t)(row_off + n0 + n) * K + k0 + 8 * c) = o; }
    asm volatile("s_waitcnt lgkmcnt(0)" ::: "memory");
}

__device__ __forceinline__ void mod_task(PPtr P, float* MOD, LAS float* sil, int tk, int tid) {
    const int layer = tk / 384, rem = tk % 384, ks = rem / 12, nb = rem % 12;
    const float* ada_w = P->in[layer ? 20 : 5]; const float* ada_b = P->in[layer ? 21 : 6];
    const float* c = P->in[1]; const float* cc = P->in[3];
    const int k0 = ks * 64, n = nb * 512 + tid;
    __syncthreads();
    for (int idx = tid; idx < 64 * 9; idx += NT) { const int k = idx / 9, j = idx % 9; const float v = (j < 8) ? c[j * 2048 + k0 + k] : cc[k0 + k]; sil[idx] = v * sigmoidf_(v); }
    __syncthreads();
    float acc[9];
#pragma unroll
    for (int j = 0; j < 9; ++j) acc[j] = 0.f;
#pragma unroll 1
    for (int kb = 0; kb < 64; kb += 16) { float w[16];
#pragma unroll
        for (int k = 0; k < 16; ++k) w[k] = ada_w[(size_t)(k0 + kb + k) * 6144 + n];
#pragma unroll
        for (int k = 0; k < 16; ++k)
#pragma unroll
            for (int j = 0; j < 9; ++j) acc[j] += sil[(kb + k) * 9 + j] * w[k]; }
    const float bb = (ks == 0) ? ada_b[n] : 0.f;
#pragma unroll
    for (int j = 0; j < 9; ++j) atomicAdd(MOD + (size_t)(layer * 9 + j) * 6144 + n, acc[j] + bb);
}

__device__ __forceinline__ void normmod_row(const float* xrow, const float* g, const float* mod  , bf16* orow, int lane) {
    f32x4 v[8]; float s = 0.f;
#pragma unroll
    for (int j = 0; j < 8; ++j) { v[j] = ((const f32x4*)xrow)[lane + 64 * j]; s += (v[j].x * v[j].x + v[j].y * v[j].y) + (v[j].z * v[j].z + v[j].w * v[j].w); }
    const float rstd = 1.0f / sqrtf(wave_sum(s) * (1.0f / 2048.0f) + 1e-6f);
#pragma unroll
    for (int j = 0; j < 8; ++j) { const int c4 = lane + 64 * j; const f32x4 gg = ((const f32x4*)g)[c4], sh = ((const f32x4*)mod)[c4], sc = ((const f32x4*)(mod + 2048))[c4];
        const f32x4 y = v[j] * rstd * gg * (sc + 1.0f) + sh;
        u32x2 o; o.x = pk2(y.x, y.y); o.y = pk2(y.z, y.w); ((u32x2*)orow)[c4] = o; }
}

constexpr int S5_ROWB = 528;
constexpr int S5_WLDS = 32 * S5_ROWB;
__device__ __forceinline__ float gelu_tanh(float x) { const float u = 0.7978845608028654f * (x + 0.044715f * x * x * x); const float e = __expf(2.0f * u); return x * (1.0f - __builtin_amdgcn_rcpf(1.0f + e)); }

__device__ __forceinline__ void s5_phase(PPtr P, LAS unsigned char* lds, int wave, int lane) {
    const float* a_re = P->in[8]; const float* a_im = P->in[9]; const float* lstep = P->in[10];
    const float* b_re = P->in[11]; const float* b_im = P->in[12]; const float* c_re = P->in[13]; const float* c_im = P->in[14]; const float* dskip = P->in[15];
    const bf16* U = (const bf16*)(P->ws + WS_U); bf16* Y = (bf16*)(P->ws + WS_Y);
    LAS unsigned char* wl = lds + wave * S5_WLDS;
    const int d = wave >> 2;
    for (int round = blockIdx.x; round < 512; round += gridDim.x) {
        const int unit = round * 4 + (wave & 3), b = unit >> 8, g = unit & 255, dg = d * 256 + g;
        const float dt = expf(lstep[dg]);
        float abr, abi;
        { const float are = a_re[dg * 64 + lane], aim = a_im[dg * 64 + lane]; const float mag = expf(dt * are); abr = mag * cosf(dt * aim); abi = mag * sinf(dt * aim); }
        bf16x8 Bf[4];
#pragma unroll
        for (int nn = 0; nn < 2; ++nn) {
            const int n = (lane & 31) + 32 * nn; const float are = a_re[dg * 64 + n], aim = a_im[dg * 64 + n];
            const float mag = expf(dt * are), cr = mag * cosf(dt * aim), ci = mag * sinf(dt * aim), den = are * are + aim * aim, nr = cr - 1.0f, ni = ci;
            const float fre = (nr * are + ni * aim) / den, fim = (ni * are - nr * aim) / den;
            const float* br = b_re + ((size_t)dg * 64 + n) * 16 + 8 * (lane >> 5); const float* bi = b_im + ((size_t)dg * 64 + n) * 16 + 8 * (lane >> 5);
#pragma unroll
            for (int j = 0; j < 8; ++j) { const float xr = br[j], xi = bi[j]; Bf[nn][j] = (short)f2bf(fre * xr - fim * xi); Bf[2 + nn][j] = (short)f2bf(fre * xi + fim * xr); }
        }
        bf16x8 Cf[4];
#pragma unroll
        for (int ks = 0; ks < 4; ++ks) { const int k = 32 * ks + 8 * (lane >> 4); const int o = lane & 15;
            const float* cr = c_re + ((size_t)dg * 16 + o) * 64 + (k >> 1); const float* cim = c_im + ((size_t)dg * 16 + o) * 64 + (k >> 1);
#pragma unroll
            for (int j = 0; j < 8; ++j) Cf[ks][j] = (short)f2bf((j & 1) ? -cim[j >> 1] : cr[j >> 1]); }
        const f32x4 dska = *(const f32x4*)(dskip + g * 16 + (lane & 1) * 8), dskb = *(const f32x4*)(dskip + g * 16 + (lane & 1) * 8 + 4);
        float hr = 0.f, hi = 0.f;
#define S5CH(cs_) const bool isctx = (cs_) < 8; const int ci = isctx ? (cs_) : (cs_) - 8, nch = isctx ? 8 : 64; const int tc = d ? (nch - 1 - ci) : ci; \
        const size_t rowbase = isctx ? (size_t)b * 256 : (size_t)2048 + (size_t)b * 2048;
#define S5AF(dst, cs_) { S5CH(cs_) (void)ci; const int i_ = lane & 31; const int t_ = 32 * tc + (d ? 31 - i_ : i_); dst = *(const bf16x8*)(U + (rowbase + t_) * 4096 + g * 16 + 8 * (lane >> 5)); }
        bf16x8 Anext; { const int c0 = 0; S5AF(Anext, c0) }
        for (int cs = 0; cs < 72; ++cs) {
            S5CH(cs) const bool first = ci < (nch >> 1);
            const bf16x8 Af = Anext;
            if (cs + 1 < 72) { const int c1 = cs + 1; S5AF(Anext, c1) }
            const int oi = lane >> 1, oh = lane & 1; const int ot = 32 * tc + (d ? 31 - oi : oi);
            const size_t opos = (rowbase + ot) * 4096 + g * 16 + oh * 8;
            u32x4 pyv = {0u, 0u, 0u, 0u}, puv = {0u, 0u, 0u, 0u};
            if (!first) { pyv = *(const u32x4*)(Y + opos); puv = *(const u32x4*)(U + opos); }
            { f32x16 z16; for (int q = 0; q < 16; ++q) z16[q] = 0.f;
#pragma unroll
              for (int nh = 0; nh < 2; ++nh) {
                  const f32x16 rr = __builtin_amdgcn_mfma_f32_32x32x16_bf16(Af, Bf[nh], z16, 0, 0, 0), ri = __builtin_amdgcn_mfma_f32_32x32x16_bf16(Af, Bf[2 + nh], z16, 0, 0, 0);
#pragma unroll
                  for (int reg = 0; reg < 16; ++reg) { const int ii = (reg & 3) + 8 * (reg >> 2) + 4 * (lane >> 5);
                      *(LAS f32x2c*)(wl + ii * S5_ROWB + ((lane & 31) + 32 * nh) * 8) = (f32x2c){rr[reg], ri[reg]}; } } }
#pragma unroll 8
            for (int i = 0; i < 32; ++i) { const f32x2c bu = *(LAS f32x2c*)(wl + i * S5_ROWB + lane * 8);
                const float nhr = abr * hr - abi * hi + bu.x, nhi = abr * hi + abi * hr + bu.y; hr = nhr; hi = nhi;
                *(LAS unsigned*)(wl + i * S5_ROWB + lane * 4) = pk2(hr, hi); }
#pragma unroll
            for (int mt = 0; mt < 2; ++mt) { f32x4 yv = {0.f, 0.f, 0.f, 0.f};
#pragma unroll
                for (int ks = 0; ks < 4; ++ks) { const bf16x8 Hf = *(const LAS bf16x8*)(wl + (16 * mt + (lane & 15)) * S5_ROWB + (32 * ks + 8 * (lane >> 4)) * 2);
                    yv = __builtin_amdgcn_mfma_f32_16x16x32_bf16(Hf, Cf[ks], yv, 0, 0, 0); }
#pragma unroll
                for (int reg = 0; reg < 4; ++reg) *(LAS float*)(wl + (16 * mt + 4 * (lane >> 4) + reg) * S5_ROWB + 256 + (lane & 15) * 4) = yv[reg]; }
            asm volatile("" ::: "memory");
            { const f32x4 ya = *(LAS f32x4*)(wl + oi * S5_ROWB + 256 + oh * 32), yb = *(LAS f32x4*)(wl + oi * S5_ROWB + 256 + oh * 32 + 16);
              u32x4 o;
              if (first) { o = (u32x4){pk2(ya.x, ya.y), pk2(ya.z, ya.w), pk2(yb.x, yb.y), pk2(yb.z, yb.w)}; }
              else {
#define S5G(yv_, pw_, uw_, dk_, hi_) gelu_tanh((yv_) + ((hi_) ? bhi(pw_) : blo(pw_)) + (dk_) * ((hi_) ? bhi(uw_) : blo(uw_)))
                  o.x = pk2(S5G(ya.x, pyv.x, puv.x, dska.x, 0), S5G(ya.y, pyv.x, puv.x, dska.y, 1)); o.y = pk2(S5G(ya.z, pyv.y, puv.y, dska.z, 0), S5G(ya.w, pyv.y, puv.y, dska.w, 1));
                  o.z = pk2(S5G(yb.x, pyv.z, puv.z, dskb.x, 0), S5G(yb.y, pyv.z, puv.z, dskb.y, 1)); o.w = pk2(S5G(yb.z, pyv.w, puv.w, dskb.z, 0), S5G(yb.w, pyv.w, puv.w, dskb.w, 1));
#undef S5G
              }
              *(u32x4*)(Y + opos) = o; }
            asm volatile("" ::: "memory");
            if (ci == (nch >> 1) - 1) __syncthreads();
        }
        __syncthreads();
#undef S5CH
#undef S5AF
    }
}

typedef float f32x2 __attribute__((ext_vector_type(2)));
constexpr int RW_ARR = 16 * 64 * 4;
constexpr int RO_TT = 0, RO_WD = 8704, RO_PA = 21760, RO_Q = 62720, RO_AR = 63232, RO_BK = 77056, RO_BKT = 86272, RO_WL = 103168, RO_VB = 103936, RO_G = 112640, RO_ZT = 117248, RO_MM = 120064, RO_PW = 122880, RO_Y = 133120, RO_CST = 141824, RW_END = 143104;
constexpr int T_ROW = 88, BKT_SLOT = 64 * T_ROW, ZT_SLOT = 16 * T_ROW;
constexpr int W_ROW = 68, W_SLOT = 16 * W_ROW * 4;
constexpr int VB_ROW = 136, VB_SLOT = 16 * VB_ROW, Y_ROW = 68, Y_SLOT = 16 * Y_ROW * 4;
static_assert(RW_END <= LDS_BYTES - 64, "rwkv LDS map");
__device__ __forceinline__ void rwkv_phase(PPtr P, LAS unsigned char* lds, int hb, int tid) {
    const float* w0 = P->in[24]; const float* a0 = P->in[27]; const float* k_k = P->in[30]; const float* k_a = P->in[31]; const float* r_k = P->in[32];
    const float* ln_w = P->in[33]; const float* ln_b = P->in[34];
    const bf16* RB = (const bf16*)(P->ws + WS_RKV); const bf16* KB = RB + (size_t)9216 * 4096; const bf16* VB = KB + (size_t)9216 * 4096;
    bf16* ZB = (bf16*)(P->ws + WS_ZB); const bf16* LW = (const bf16*)(P->ws + WS_ZB + ZB_LW); const bf16* LA = (const bf16*)(P->ws + WS_ZB + ZB_LA);
    const bf16* W2T = (const bf16*)(P->ws + WS_W2T); const bf16* A2T = (const bf16*)(P->ws + WS_A2T);
    bf16* YP = (bf16*)(P->ws + WS_YP); float* QP = (float*)(P->ws + WS_QP);
    const int wid = __builtin_amdgcn_readfirstlane(tid >> 6), lane0 = tid & 63;
#define LANEVARS int lnv = lane0; asm volatile("" : "+v"(lnv)); const int lane = lnv, fr = lane & 15, fq = lane >> 4; (void)fr; (void)fq;
#define BAR_LDS() do { asm volatile("s_waitcnt lgkmcnt(0)" ::: "memory"); __builtin_amdgcn_s_barrier(); asm volatile("" ::: "memory"); } while (0)
#define STH(p, v) (*(LAS unsigned short*)(p) = (unsigned short)f2bf_lo16(v))
#define CHUNK(c_, tc_, rb_) const bool ic_##c_ = (c_) < 16; const int ci_##c_ = ic_##c_ ? (c_) : (c_) - 16, nch_##c_ = ic_##c_ ? 16 : 128; \
        const int tc_ = d ? (nch_##c_ - 1 - ci_##c_) : ci_##c_; const size_t rb_ = ic_##c_ ? (size_t)bl * 256 : (size_t)1024 + (size_t)bl * 2048;
#define CST(a_, nq_) (*(LAS f32x4*)((LAS float*)(lds + RO_CST) + (a_) * 64 + 4 * (nq_)))
    for (int pr = blockIdx.x; pr < 256; pr += gridDim.x) {
        const int bl = pr >> 6, h = pr & 63;
        __syncthreads();
        if (tid < 320) { const int a_ = tid >> 6, c_ = tid & 63; const float* src = a_ == 0 ? k_k : (a_ == 1 ? k_a : (a_ == 2 ? r_k : (a_ == 3 ? ln_w : ln_b))); ((LAS float*)(lds + RO_CST))[tid] = src[h * 64 + c_]; }
        for (int d = 0; d < 2; ++d) {
            __syncthreads();
            f32x4 St[4];
#pragma unroll
            for (int nt = 0; nt < 4; ++nt) St[nt] = (f32x4){0.f, 0.f, 0.f, 0.f};
            bf16x8 Bw[3], Ba[3]; float w0v = 0.f, a0v = 0.f;
            u32x4 PF[6];
#pragma unroll
            for (int j = 0; j < 6; ++j) PF[j] = (u32x4){0u, 0u, 0u, 0u};
#pragma unroll
            for (int ks = 0; ks < 3; ++ks) { Bw[ks] = (bf16x8){0, 0, 0, 0, 0, 0, 0, 0}; Ba[ks] = Bw[ks]; }
#define PFLO(v, j) ((j) & 1 ? (u32x2){(v).z, (v).w} : (u32x2){(v).x, (v).y})
#define PFSET(v, j, val) { const u32x2 t_ = (val); if ((j) & 1) { (v).z = t_.x; (v).w = t_.y; } else { (v).x = t_.x; (v).y = t_.y; } }
#define LPREF(c_) { CHUNK(c_, tc_, rb_) const size_t row_ = rb_ + 16 * tc_ + (d ? 15 - fr : fr); const bf16* lwr = LW + row_ * 192 + d * 96 + 8 * fq; const bf16* lar = LA + row_ * 192 + d * 96 + 8 * fq; \
                _Pragma("unroll") for (int ks = 0; ks < 3; ++ks) { PF[ks] = *(const u32x4*)(lwr + 32 * ks); PF[3 + ks] = *(const u32x4*)(lar + 32 * ks); } }
            if (wid < 4) { LANEVARS
                const size_t rowo = ((size_t)d * 4096 + h * 64 + 16 * wid + fr) * 96 + 8 * fq;
#pragma unroll
                for (int ks = 0; ks < 3; ++ks) { Bw[ks] = *(const bf16x8*)(W2T + rowo + 32 * ks); Ba[ks] = *(const bf16x8*)(A2T + rowo + 32 * ks); }
                const int hn1 = h * 64 + 16 * wid + fr; w0v = w0[d * 4096 + hn1]; a0v = a0[d * 4096 + hn1];
                { const int c0 = 0; LPREF(c0) } }
            for (int it = -4; it <= 144; ++it) {
                LANEVARS
                if (wid < 4) {
                    if (it >= 0 && it <= 143) { const int c = it;
                        LAS unsigned char* oAR = lds + RO_AR + (c % 3) * 4608; LAS unsigned char* oBKT = lds + RO_BKT + (c % 3) * BKT_SLOT; LAS float* aWL = (LAS float*)(lds + RO_WL + (c % 3) * 256);
                        LAS unsigned char* oVB = lds + RO_VB + (c & 3) * VB_SLOT; LAS unsigned char* oZT = lds + RO_ZT + (c & 1) * ZT_SLOT; LAS unsigned char* oMM = lds + RO_MM + (c & 1) * ZT_SLOT;
                        LAS float* aY = (LAS float*)(lds + RO_Y + (c & 1) * Y_SLOT);
#define PERMK(base_, rowbytes_) ({ const u32x2 lo_ = *(const LAS u32x2*)((base_) + (rowbytes_) + 8 * fq), hi_ = *(const LAS u32x2*)((base_) + (rowbytes_) + 32 + 8 * fq); __builtin_bit_cast(bf16x8, (u32x4){lo_.x, lo_.y, hi_.x, hi_.y}); })
                        f32x4 XuT = {0.f, 0.f, 0.f, 0.f}, XrT = {0.f, 0.f, 0.f, 0.f};
#pragma unroll
                        for (int ks = 0; ks < 2; ++ks) {
                            const u32x4 bs = {pk2(St[2 * ks][0], St[2 * ks][1]), pk2(St[2 * ks][2], St[2 * ks][3]), pk2(St[2 * ks + 1][0], St[2 * ks + 1][1]), pk2(St[2 * ks + 1][2], St[2 * ks + 1][3])};
                            const bf16x8 A0 = PERMK(oAR, fr * 144 + 64 * ks), A1 = PERMK(oAR, (16 + fr) * 144 + 64 * ks);
                            XuT = __builtin_amdgcn_mfma_f32_16x16x32_bf16(A0, __builtin_bit_cast(bf16x8, bs), XuT, 0, 0, 0); XrT = __builtin_amdgcn_mfma_f32_16x16x32_bf16(A1, __builtin_bit_cast(bf16x8, bs), XrT, 0, 0, 0); }
                        unsigned vlo, vhi;
                        { const unsigned v0 = *(LAS unsigned short*)(oVB + (4 * fq + 0) * VB_ROW + (16 * wid + fr) * 2), v1 = *(LAS unsigned short*)(oVB + (4 * fq + 1) * VB_ROW + (16 * wid + fr) * 2);
                          const unsigned v2 = *(LAS unsigned short*)(oVB + (4 * fq + 2) * VB_ROW + (16 * wid + fr) * 2), v3 = *(LAS unsigned short*)(oVB + (4 * fq + 3) * VB_ROW + (16 * wid + fr) * 2);
                          vlo = v0 | (v1 << 16); vhi = v2 | (v3 << 16); }
                        f32x4 UT = {0.f, 0.f, 0.f, 0.f};
                        { const u32x4 bu = {pk2(XuT[0], XuT[1]), pk2(XuT[2], XuT[3]), vlo, vhi};
                          UT = __builtin_amdgcn_mfma_f32_16x16x32_bf16(PERMK(oZT, fr * T_ROW), __builtin_bit_cast(bf16x8, bu), UT, 0, 0, 0); }
                        const u32x4 buv = {pk2(UT[0], UT[1]), pk2(UT[2], UT[3]), vlo, vhi};
                        if (c >= 16) {
                            const f32x4 y = __builtin_amdgcn_mfma_f32_16x16x32_bf16(PERMK(oMM, fr * T_ROW), __builtin_bit_cast(bf16x8, buv), XrT, 0, 0, 0);
#pragma unroll
                            for (int reg = 0; reg < 4; ++reg) aY[(4 * fq + reg) * Y_ROW + 16 * wid + fr] = y[reg]; }
#pragma unroll
                        for (int nt = 0; nt < 4; ++nt) { const f32x4 r = __builtin_amdgcn_mfma_f32_16x16x32_bf16(PERMK(oBKT, (16 * nt + fr) * T_ROW), __builtin_bit_cast(bf16x8, buv), St[nt], 0, 0, 0);
                            St[nt] = r * *(LAS f32x4*)(aWL + 16 * nt + 4 * fq); }
#undef PERMK
                    }
                    if (it + 4 <= 143) { const int c = it + 4;
                        LAS float* aWd = (LAS float*)(lds + RO_WD + (c % 3) * W_SLOT); LAS float* aTt = (LAS float*)(lds + RO_TT + (c & 1) * W_SLOT);
                        f32x4 cw = {0.f, 0.f, 0.f, 0.f}, ca = {0.f, 0.f, 0.f, 0.f};
#pragma unroll
                        for (int ks = 0; ks < 3; ++ks) { cw = __builtin_amdgcn_mfma_f32_16x16x32_bf16(__builtin_bit_cast(bf16x8, PF[ks]), Bw[ks], cw, 0, 0, 0); ca = __builtin_amdgcn_mfma_f32_16x16x32_bf16(__builtin_bit_cast(bf16x8, PF[3 + ks]), Ba[ks], ca, 0, 0, 0); }
#pragma unroll
                        for (int reg = 0; reg < 4; ++reg) { const int ii = 4 * fq + reg; const int n = 16 * wid + fr;
                            const float sg = sigmoidf_(w0v + cw[reg]);
                            aWd[ii * W_ROW + n] = __expf(-0.60653065971263342f * sg); aTt[ii * W_ROW + n] = sigmoidf_(a0v + ca[reg]); }
                    }
                    if (it + 5 >= 0 && it + 5 <= 143) { const int c5 = it + 5; LPREF(c5) }
                    if (wid == 0 && it + 2 >= 0 && it + 2 <= 143) { const int c = it + 2; const int k = lane;
                        LAS float* aWd = (LAS float*)(lds + RO_WD + (c % 3) * W_SLOT); LAS float* pa = (LAS float*)(lds + RO_PA + (c & 1) * 20480);
                        LAS unsigned char* oAR = lds + RO_AR + (c % 3) * 4608; LAS float* aWL = (LAS float*)(lds + RO_WL + (c % 3) * 256);
                        float Wc = 1.0f;
#pragma unroll
                        for (int t = 0; t < 16; ++t) { const float Wp = Wc; Wc *= aWd[t * W_ROW + k];
                            STH(oAR + t * 144 + k * 2, pa[0 * 1024 + t * 64 + k] * Wp); }
                        aWL[k] = Wc; }
                    if (wid == 1 && it + 2 >= 0 && it + 2 <= 143) { const int c = it + 2; const int k = lane;
                        LAS float* aWd = (LAS float*)(lds + RO_WD + (c % 3) * W_SLOT); LAS float* pa = (LAS float*)(lds + RO_PA + (c & 1) * 20480);
                        LAS unsigned char* oAR = lds + RO_AR + (c % 3) * 4608; LAS unsigned char* oVB = lds + RO_VB + (c & 3) * VB_SLOT;
                        float Wc = 1.0f;
#pragma unroll
                        for (int t = 0; t < 16; ++t) { Wc *= aWd[t * W_ROW + k]; STH(oAR + (16 + t) * 144 + k * 2, pa[3 * 1024 + t * 64 + k] * Wc); STH(oVB + t * VB_ROW + k * 2, pa[4 * 1024 + t * 64 + k]); } }
                } else if (wid == 4) {
                    if (it - 1 >= 16 && it - 1 <= 143) { const int c = it - 1; CHUNK(c, tc_, rb_) (void)rb_;
                        LAS float* aY = (LAS float*)(lds + RO_Y + (c & 1) * Y_SLOT); LAS float* aQ = (LAS float*)(lds + RO_Q + (c & 7) * 64); LAS unsigned char* oVB = lds + RO_VB + (c & 3) * VB_SLOT;
#pragma unroll
                        for (int j = 0; j < 4; ++j) { const int pi = fq + 4 * j, nq = fr, hn4 = h * 64 + 4 * nq;
                            const size_t rl = (size_t)bl * 2048 + 16 * tc_ + (d ? 15 - pi : pi);
                            const f32x4 y4 = *(LAS f32x4*)(aY + pi * Y_ROW + 4 * nq); const float qown = aQ[pi];
                            if (d == 0) {
                                u32x2 o; o.x = pk2(y4.x, y4.y); o.y = pk2(y4.z, y4.w); *(u32x2*)(YP + rl * 4096 + hn4) = o;
                                if (nq == 0) QP[rl * 64 + h] = qown;
                            } else {
                                const u32x2 py_ = PFLO(PF[j >> 1], j), pz_ = PFLO(PF[2 + (j >> 1)], j); const float pq_ = __builtin_bit_cast(float, j == 0 ? PF[4].x : (j == 1 ? PF[4].y : (j == 2 ? PF[4].z : PF[4].w)));
                                const f32x4 ys = {y4.x + blo(py_.x), y4.y + bhi(py_.x), y4.z + blo(py_.y), y4.w + bhi(py_.y)};
                                float sm = (ys.x + ys.y) + (ys.z + ys.w); sm = red16(sm); const float mean = sm * (1.0f / 64.0f);
                                const f32x4 dv = ys - mean; float vs = (dv.x * dv.x + dv.y * dv.y) + (dv.z * dv.z + dv.w * dv.w); vs = red16(vs);
                                const float rstd = __builtin_amdgcn_rsqf(vs * (1.0f / 64.0f) + 64e-5f);
                                const float q = qown + pq_;
                                const u32x2 vb = *(LAS u32x2*)(oVB + pi * VB_ROW + nq * 8);
                                const f32x4 v4 = {blo(vb.x), bhi(vb.x), blo(vb.y), bhi(vb.y)};
                                const f32x4 val = dv * rstd * CST(3, nq) + CST(4, nq) + v4 * q;
                                const float z0 = blo(pz_.x), z1 = bhi(pz_.x), z2 = blo(pz_.y), z3 = bhi(pz_.y);
                                u32x2 o; o.x = pk2(val.x * z0 * sigmoidf_(z0), val.y * z1 * sigmoidf_(z1)); o.y = pk2(val.z * z2 * sigmoidf_(z2), val.w * z3 * sigmoidf_(z3));
                                *(u32x2*)(ZB + (1024 + rl) * 4096 + hn4) = o;
                            } }
                    }
                    if (d == 1 && it >= 16 && it <= 143) { const int c = it; CHUNK(c, tc_, rb_) (void)rb_;
                        u32x2 ty[4], tz[4]; unsigned tq[4];
#pragma unroll
                        for (int j = 0; j < 4; ++j) { const int pi = fq + 4 * j, nq = fr, hn4 = h * 64 + 4 * nq; const size_t rl = (size_t)bl * 2048 + 16 * tc_ + (15 - pi);
                            ty[j] = *(const u32x2*)(YP + rl * 4096 + hn4); tq[j] = __builtin_bit_cast(unsigned, QP[rl * 64 + h]); tz[j] = *(const u32x2*)(ZB + (1024 + rl) * 4096 + hn4); }
                        PF[0] = (u32x4){ty[0].x, ty[0].y, ty[1].x, ty[1].y}; PF[1] = (u32x4){ty[2].x, ty[2].y, ty[3].x, ty[3].y};
                        PF[2] = (u32x4){tz[0].x, tz[0].y, tz[1].x, tz[1].y}; PF[3] = (u32x4){tz[2].x, tz[2].y, tz[3].x, tz[3].y};
                        PF[4] = (u32x4){tq[0], tq[1], tq[2], tq[3]}; }
                    if (it + 1 >= 0 && it + 1 <= 143) { const int c = it + 1;
                        LAS unsigned char* oAR = lds + RO_AR + (c % 3) * 4608; LAS unsigned char* oBK = lds + RO_BK + (c & 1) * 4608; LAS unsigned char* oMM = lds + RO_MM + (c & 1) * ZT_SLOT;
#pragma unroll
                        for (int mi = 0; mi < 2; ++mi) { f32x4 g = {0.f, 0.f, 0.f, 0.f};
#pragma unroll
                            for (int ks = 0; ks < 2; ++ks) { const bf16x8 Af = *(const LAS bf16x8*)(oBK + (16 * mi + fr) * 144 + (32 * ks + 8 * fq) * 2), Bf = *(const LAS bf16x8*)(oAR + (16 + fr) * 144 + (32 * ks + 8 * fq) * 2);
                                g = __builtin_amdgcn_mfma_f32_16x16x32_bf16(Af, Bf, g, 0, 0, 0); }
#pragma unroll
                            for (int reg = 0; reg < 4; ++reg) { const int s_ = 4 * fq + reg; STH(oMM + fr * T_ROW + (16 * mi + s_) * 2, (s_ <= fr) ? g[reg] : 0.f); } } }
                } else if (wid == 5) {
                    if (it + 3 >= 0 && it + 3 <= 143) { const int c = it + 3;
                        LAS float* aTt = (LAS float*)(lds + RO_TT + (c & 1) * W_SLOT); LAS float* pa = (LAS float*)(lds + RO_PA + (c & 1) * 20480); LAS float* aQ = (LAS float*)(lds + RO_Q + (c & 7) * 64);
#pragma unroll
                        for (int j = 0; j < 3; ++j) { const int pi = fq + 4 * j, nq = fr;
                            const u32x2 pk_ = PFLO(PF[j >> 1], j), pr_ = PFLO(PF[2 + (j >> 1)], j), pv_ = PFLO(PF[4 + (j >> 1)], j);
                            const f32x4 k4 = {blo(pk_.x), bhi(pk_.x), blo(pk_.y), bhi(pk_.y)}, r4 = {blo(pr_.x), bhi(pr_.x), blo(pr_.y), bhi(pr_.y)}, v4 = {blo(pv_.x), bhi(pv_.x), blo(pv_.y), bhi(pv_.y)};
                            f32x4 kk = k4 * CST(0, nq); float ss = (kk.x * kk.x + kk.y * kk.y) + (kk.z * kk.z + kk.w * kk.w); ss = red16(ss);
                            const float inv = __builtin_amdgcn_rsqf(fmaxf(ss, 1e-24f)); kk = kk * inv;
                            const f32x4 ar = *(LAS f32x4*)(aTt + pi * W_ROW + 4 * nq);
                            const f32x4 kd = k4 * ((ar - 1.0f) * CST(1, nq) + 1.0f);
                            *(LAS f32x4*)(pa + 0 * 1024 + pi * 64 + 4 * nq) = -kk; *(LAS f32x4*)(pa + 1 * 1024 + pi * 64 + 4 * nq) = kk * ar; *(LAS f32x4*)(pa + 2 * 1024 + pi * 64 + 4 * nq) = kd;
                            *(LAS f32x4*)(pa + 3 * 1024 + pi * 64 + 4 * nq) = r4; *(LAS f32x4*)(pa + 4 * 1024 + pi * 64 + 4 * nq) = v4;
                            const f32x4 q3 = kd * r4 * CST(2, nq); float qq = (q3.x + q3.y) + (q3.z + q3.w); qq = red16(qq);
                            if (nq == 0) aQ[pi] = qq; }
                    }
                    if (it + 4 >= 0 && it + 4 <= 143) { const int c4 = it + 4; CHUNK(c4, tc_, rb_)
#pragma unroll
                        for (int j = 0; j < 3; ++j) { const int pi = fq + 4 * j; const size_t off_ = (rb_ + 16 * tc_ + (d ? 15 - pi : pi)) * 4096 + h * 64 + 4 * fr;
                            PFSET(PF[j >> 1], j, *(const u32x2*)(KB + off_)) PFSET(PF[2 + (j >> 1)], j, *(const u32x2*)(RB + off_)) PFSET(PF[4 + (j >> 1)], j, *(const u32x2*)(VB + off_)) } }
                } else if (wid == 6) {
                    if (it + 3 >= 0 && it + 3 <= 143) { const int c = it + 3;
                        LAS float* aTt = (LAS float*)(lds + RO_TT + (c & 1) * W_SLOT); LAS float* pa = (LAS float*)(lds + RO_PA + (c & 1) * 20480); LAS float* aQ = (LAS float*)(lds + RO_Q + (c & 7) * 64);
#pragma unroll
                        for (int j = 3; j < 4; ++j) { const int pi = fq + 4 * j, nq = fr;
                            const u32x2 pk_ = PFLO(PF[j >> 1], j), pr_ = PFLO(PF[2 + (j >> 1)], j), pv_ = PFLO(PF[4 + (j >> 1)], j);
                            const f32x4 k4 = {blo(pk_.x), bhi(pk_.x), blo(pk_.y), bhi(pk_.y)}, r4 = {blo(pr_.x), bhi(pr_.x), blo(pr_.y), bhi(pr_.y)}, v4 = {blo(pv_.x), bhi(pv_.x), blo(pv_.y), bhi(pv_.y)};
                            f32x4 kk = k4 * CST(0, nq); float ss = (kk.x * kk.x + kk.y * kk.y) + (kk.z * kk.z + kk.w * kk.w); ss = red16(ss);
                            const float inv = __builtin_amdgcn_rsqf(fmaxf(ss, 1e-24f)); kk = kk * inv;
                            const f32x4 ar = *(LAS f32x4*)(aTt + pi * W_ROW + 4 * nq);
                            const f32x4 kd = k4 * ((ar - 1.0f) * CST(1, nq) + 1.0f);
                            *(LAS f32x4*)(pa + 0 * 1024 + pi * 64 + 4 * nq) = -kk; *(LAS f32x4*)(pa + 1 * 1024 + pi * 64 + 4 * nq) = kk * ar; *(LAS f32x4*)(pa + 2 * 1024 + pi * 64 + 4 * nq) = kd;
                            *(LAS f32x4*)(pa + 3 * 1024 + pi * 64 + 4 * nq) = r4; *(LAS f32x4*)(pa + 4 * 1024 + pi * 64 + 4 * nq) = v4;
                            const f32x4 q3 = kd * r4 * CST(2, nq); float qq = (q3.x + q3.y) + (q3.z + q3.w); qq = red16(qq);
                            if (nq == 0) aQ[pi] = qq; }
                    }
                    if (it + 4 >= 0 && it + 4 <= 143) { const int c4 = it + 4; CHUNK(c4, tc_, rb_)
#pragma unroll
                        for (int j = 3; j < 4; ++j) { const int pi = fq + 4 * j; const size_t off_ = (rb_ + 16 * tc_ + (d ? 15 - pi : pi)) * 4096 + h * 64 + 4 * fr;
                            PFSET(PF[j >> 1], j, *(const u32x2*)(KB + off_)) PFSET(PF[2 + (j >> 1)], j, *(const u32x2*)(RB + off_)) PFSET(PF[4 + (j >> 1)], j, *(const u32x2*)(VB + off_)) } }
                    if (it + 2 >= 0 && it + 2 <= 143) { const int c = it + 2; const int k = lane;
                        LAS float* aWd = (LAS float*)(lds + RO_WD + (c % 3) * W_SLOT); LAS float* pa = (LAS float*)(lds + RO_PA + (c & 1) * 20480);
                        LAS unsigned char* oBK = lds + RO_BK + (c & 1) * 4608; LAS unsigned char* oBKT = lds + RO_BKT + (c % 3) * BKT_SLOT; LAS unsigned char* oAR = lds + RO_AR + (c % 3) * 4608; LAS unsigned char* oVB = lds + RO_VB + (c & 3) * VB_SLOT;
                        float Wc = 1.0f, pxb = 0.f, pxk = 0.f;
#pragma unroll
                        for (int t = 0; t < 16; ++t) { Wc *= aWd[t * W_ROW + k]; const float rW = __builtin_amdgcn_rcpf(Wc);
                            const float xb = pa[1 * 1024 + t * 64 + k] * rW, xk = pa[2 * 1024 + t * 64 + k] * rW;
                            STH(oBK + t * 144 + k * 2, xb); STH(oBK + (16 + t) * 144 + k * 2, xk);
                            if (t & 1) { *(LAS unsigned*)(oBKT + k * T_ROW + (t - 1) * 2) = pk2(pxb, xb); *(LAS unsigned*)(oBKT + k * T_ROW + (16 + t - 1) * 2) = pk2(pxk, xk); } pxb = xb; pxk = xk;
                            } }
                } else {
                    if (it + 1 >= 0 && it + 1 <= 143) { const int c = it + 1;
                        LAS unsigned char* oAR = lds + RO_AR + (c % 3) * 4608; LAS unsigned char* oBK = lds + RO_BK + (c & 1) * 4608; LAS float* aG = (LAS float*)(lds + RO_G);
                        LAS unsigned char* oZT = lds + RO_ZT + (c & 1) * ZT_SLOT;
#pragma unroll
                        for (int mi = 0; mi < 2; ++mi) { const int ni = 0; f32x4 g = {0.f, 0.f, 0.f, 0.f};
#pragma unroll
                            for (int ks = 0; ks < 2; ++ks) { const bf16x8 Af = *(const LAS bf16x8*)(oBK + (16 * mi + fr) * 144 + (32 * ks + 8 * fq) * 2), Bf = *(const LAS bf16x8*)(oAR + (16 * ni + fr) * 144 + (32 * ks + 8 * fq) * 2);
                                g = __builtin_amdgcn_mfma_f32_16x16x32_bf16(Af, Bf, g, 0, 0, 0); }
#pragma unroll
                            for (int reg = 0; reg < 4; ++reg) aG[(16 * mi + 4 * fq + reg) * 36 + 16 * ni + fr] = g[reg]; }
                        asm volatile("" ::: "memory");
                        { const int rp = lane & 31; float z[16], grow[16];
#pragma unroll
                          for (int t4 = 0; t4 < 4; ++t4) { const f32x4 gr = *(LAS f32x4*)(aG + rp * 36 + 4 * t4); grow[4 * t4] = gr.x; grow[4 * t4 + 1] = gr.y; grow[4 * t4 + 2] = gr.z; grow[4 * t4 + 3] = gr.w; }
#pragma unroll
                          for (int t = 0; t < 16; ++t) z[t] = (rp < 16) ? ((t == rp) ? 1.0f : 0.0f) : ((rp - 16 < t) ? grow[t] : 0.0f);
#pragma unroll
                          for (int s = 0; s < 15; ++s) {
#pragma unroll
                              for (int t = s + 1; t < 16; ++t) { const float gst = __builtin_bit_cast(float, __builtin_amdgcn_readlane(__builtin_bit_cast(int, grow[t]), s)); z[t] += z[s] * gst; } }
                          if (lane < 32) {
#pragma unroll
                              for (int t = 0; t < 16; ++t) STH(oZT + t * T_ROW + rp * 2, z[t]); } }
                    }
                }
                BAR_LDS();
            }
        }
    }
    __syncthreads();
#undef LANEVARS
#undef BAR_LDS
#undef STH
#undef CHUNK
#undef CST
#undef LPREF
#undef PFLO
#undef PFSET
}

__device__ __forceinline__ void mix_phase(PPtr P, int i0, int i1, int i2, int gtid, int gthreads) {
    const bf16* H = (const bf16*)(P->ws + WS_H1); const float* mu = P->in[22];
    bf16* A0 = (bf16*)(P->ws + WS_A); bf16* A1 = (bf16*)(P->ws + WS_A + A_STRIDE); bf16* A2 = (bf16*)(P->ws + WS_A + 2 * A_STRIDE);
    for (int idx = gtid; idx < 9216 * 256; idx += gthreads) {
        const int row = idx >> 8, c0 = (idx & 255) * 8;
        int nrow = -1;
        if (row < 1024) { const int t = row & 255; if (c0 < 1024) { if (t > 0) nrow = row - 1; } else { if (t < 255) nrow = row + 1; } }
        else { const int t = (row - 1024) & 2047, gx = t & 63, gy = t >> 6, qd = c0 >> 9;
            if (qd == 0) { if (gx > 0) nrow = row - 1; } else if (qd == 1) { if (gx < 63) nrow = row + 1; } else if (qd == 2) { if (gy > 0) nrow = row - 64; } else { if (gy < 31) nrow = row + 64; } }
        const u32x4 hv = *(const u32x4*)(H + (size_t)row * 2048 + c0);
        u32x4 sv = {0u, 0u, 0u, 0u}; if (nrow >= 0) sv = *(const u32x4*)(H + (size_t)nrow * 2048 + c0);
        const float hf[8] = {blo(hv.x), bhi(hv.x), blo(hv.y), bhi(hv.y), blo(hv.z), bhi(hv.z), blo(hv.w), bhi(hv.w)};
        const float sf[8] = {blo(sv.x), bhi(sv.x), blo(sv.y), bhi(sv.y), blo(sv.z), bhi(sv.z), blo(sv.w), bhi(sv.w)};
#pragma unroll
        for (int q = 0; q < 3; ++q) { const int mi = q == 0 ? i0 : (q == 1 ? i1 : i2); bf16* dst = q == 0 ? A0 : (q == 1 ? A1 : A2);
            const f32x4 m0 = *(const f32x4*)(mu + mi * 2048 + c0), m1 = *(const f32x4*)(mu + mi * 2048 + c0 + 4);
            const float mm[8] = {m0.x, m0.y, m0.z, m0.w, m1.x, m1.y, m1.z, m1.w};
            float o[8];
#pragma unroll
            for (int e = 0; e < 8; ++e) o[e] = hf[e] + (sf[e] - hf[e]) * mm[e];
            u32x4 w; w.x = pk2(o[0], o[1]); w.y = pk2(o[2], o[3]); w.z = pk2(o[4], o[5]); w.w = pk2(o[6], o[7]);
            *(u32x4*)(dst + (size_t)row * 2048 + c0) = w; }
    }
}

__global__ void __launch_bounds__(NT, 2) fwd_megakernel(Params Pk) {
    extern __shared__ __attribute__((aligned(16))) unsigned char lds_raw[];
    LAS unsigned char* lds = (LAS unsigned char*)lds_raw;
    cg::grid_group grid = cg::this_grid();
    const int G = gridDim.x, NGW = G * 8, gthreads = G * NT;
#ifdef PROBE_CAT
    unsigned long long pb_acc = 0, pb_t0 = 0;
#define PB_BEGIN(cat) if (PROBE_CAT == (cat)) pb_t0 = __builtin_amdgcn_s_memrealtime();
#define PB_END(cat) if (PROBE_CAT == (cat)) pb_acc += __builtin_amdgcn_s_memrealtime() - pb_t0;
#else
#define PB_BEGIN(cat)
#define PB_END(cat)
#endif
    { int t_ = threadIdx.x; if (t_ < 16) ((LAS unsigned*)(lds + LDS_BARST))[t_] = 0u; }
    __syncthreads();
    XcdBarrier xbar;
    { GETP xbar = xcd_barrier_post((unsigned*)(P->ws + WS_BAR), (volatile LAS unsigned*)(lds + LDS_BARST)); }
#define GSYNC_CG() do { PB_BEGIN(4) grid.sync(); PB_END(4) } while (0)
#define GSYNC() do { PB_BEGIN(4) xcd_barrier(xbar); PB_END(4) } while (0)
#define TID_VARS GETP unsigned char* ws = P->ws; float* MOD = (float*)(ws + WS_MOD); (void)MOD; int tid = threadIdx.x; asm volatile("" : "+v"(tid)); const int lane = tid & 63, wave = __builtin_amdgcn_readfirstlane(tid >> 6); const int gw = blockIdx.x * 8 + wave, gtid = blockIdx.x * NT + tid; LAS float* scr = (LAS float*)(lds + wave * 16384); (void)lane; (void)gw; (void)gtid; (void)scr;

    { TID_VARS
      for (int tk = blockIdx.x; tk < 768; tk += G) mod_task(P, MOD, (LAS float*)(lds + 8 * 16384), tk, tid);
      constexpr int I_IN = 32 * 256, I_GLU = 64 * 128, I_OUT = 64 * 64;
      for (int it = gw; it < I_IN + I_GLU + I_OUT; it += NGW) { int r = it;
          if (r < I_IN) { transpose_item(P->in[7], 2048, 8192, (bf16*)(ws + WB_L0_IN), 0, scr, r, lane); continue; } r -= I_IN;
          if (r < I_GLU) { transpose_item(P->in[16], 4096, 4096, (bf16*)(ws + WB_L0_GLU), 0, scr, r, lane); continue; } r -= I_GLU;
          transpose_item(P->in[18], 4096, 2048, (bf16*)(ws + WB_L0_OUT), 0, scr, r, lane); } }
    GSYNC(); if (gridDim.x == 0u) GSYNC_CG();
    { TID_VARS bf16* H0 = (bf16*)P->out;
      for (int m = gw; m < 18432; m += NGW) {
          if (m < 2048) normmod_row(P->in[2] + (size_t)m * 2048, P->in[4], MOD + 8 * 6144, H0 + (size_t)m * 2048, lane);
          else { const int r = m - 2048; normmod_row(P->in[0] + (size_t)r * 2048, P->in[4], MOD + (r >> 11) * 6144, H0 + (size_t)m * 2048, lane); } } }
    GSYNC();
    { GETP unsigned char* ws = P->ws; float* MOD = (float*)(ws + WS_MOD); (void)MOD; pg8::Gemm g{(const bf16*)P->out, (const bf16*)(ws + WB_L0_IN), 18432, 8192, 2048, 0, 1, 1 << 30}; pg8::StaticOrder S; S.init(18432, 8192, G, (int)blockIdx.x);
      pg8::EpiSplitBf16 E{(bf16*)(ws + WS_U), 4096, 4096, (size_t)18432 * 4096};
      PB_BEGIN(1) pg8::gemm_phase<pg8::EpiSplitBf16, pg8::StaticOrder, true, true>(lds, g, S, E); PB_END(1) }
    GSYNC();
    { PB_BEGIN(2) TID_VARS s5_phase(P, lds, wave, lane); PB_END(2) }
    GSYNC();
    { GETP unsigned char* ws = P->ws; float* MOD = (float*)(ws + WS_MOD); (void)MOD; pg8::Gemm g{(const bf16*)(ws + WS_Y), (const bf16*)(ws + WB_L0_GLU), 18432, 4096, 4096, 0, 1, 1 << 30}; pg8::StaticOrder S; S.init(18432, 4096, G, (int)blockIdx.x);
      pg8::EpiGlu E{(const bf16*)(ws + WS_Y), (bf16*)(ws + WS_Z), 4096, P->in[17]};
      PB_BEGIN(1) pg8::gemm_phase<pg8::EpiGlu, pg8::StaticOrder, true, true>(lds, g, S, E); PB_END(1) }
    GSYNC();
    { GETP unsigned char* ws = P->ws; float* MOD = (float*)(ws + WS_MOD); (void)MOD; pg8::Gemm g{(const bf16*)(ws + WS_Z), (const bf16*)(ws + WB_L0_OUT), 18432, 2048, 4096, 0, 1, 1 << 30}; pg8::StaticOrder S; S.init(18432, 2048, G, (int)blockIdx.x);
      pg8::EpiResid E{P->in[0], P->out, P->in[2], (float*)(ws + WS_XC), MOD, 2048, 0};
      PB_BEGIN(1) pg8::gemm_phase<pg8::EpiResid, pg8::StaticOrder, true, true>(lds, g, S, E); PB_END(1) }
    GSYNC();
    { TID_VARS constexpr int I_IN = 32 * 128, I_LO = 32 * 3, I_OUT = 64 * 64; bf16* WIN = (bf16*)(ws + WB_L1_IN);
      for (int it = gw; it < 4 * I_IN + 4 * I_LO + I_OUT; it += NGW) { int r = it;
          if (r < 4 * I_IN) { const int q = r / I_IN; transpose_item(P->in[23] + (size_t)q * 2048 * 4096, 2048, 4096, WIN, q * 4096, scr, r % I_IN, lane); continue; } r -= 4 * I_IN;
          if (r < 2 * I_LO) { const int q = r / I_LO; transpose_item(P->in[25] + (size_t)q * 2048 * 96, 2048, 96, WIN, 16384 + q * 96, scr, r % I_LO, lane); continue; } r -= 2 * I_LO;
          if (r < 2 * I_LO) { const int q = r / I_LO; transpose_item(P->in[28] + (size_t)q * 2048 * 96, 2048, 96, WIN, 16640 + q * 96, scr, r % I_LO, lane); continue; } r -= 2 * I_LO;
          transpose_item(P->in[35], 4096, 2048, (bf16*)(ws + WB_L1_OUT), 0, scr, r, lane); }
      for (int idx = gtid; idx < 2 * 64 * 2048 / 8; idx += gthreads) { const int e = idx * 8, pr = e / 2048, c = e % 2048; const int row = (pr < 64) ? 16576 + pr : 16832 + (pr - 64);
          *(u32x4*)(WIN + (size_t)row * 2048 + c) = (u32x4){0u, 0u, 0u, 0u}; }
      bf16* W2T = (bf16*)(ws + WS_W2T); bf16* A2T = (bf16*)(ws + WS_A2T);
      for (int idx = gtid; idx < 2 * 96 * 4096; idx += gthreads) { const int n = idx & 4095, m = (idx >> 12) % 96, dd = idx / (96 * 4096);
          W2T[((size_t)dd * 4096 + n) * 96 + m] = (bf16)f2bf(P->in[26][idx]); A2T[((size_t)dd * 4096 + n) * 96 + m] = (bf16)f2bf(P->in[29][idx]); } }
    for (int hb = 0; hb < 2; ++hb) {
        { TID_VARS bf16* H1 = (bf16*)(ws + WS_H1); const float* MOD1 = MOD + 9 * 6144;
          for (int m = gw; m < 9216; m += NGW) {
              if (m < 1024) normmod_row((const float*)(ws + WS_XC) + (size_t)(hb * 1024 + m) * 2048, P->in[19], MOD1 + 8 * 6144, H1 + (size_t)m * 2048, lane);
              else { const int r = hb * 8192 + (m - 1024); normmod_row(P->out + (size_t)r * 2048, P->in[19], MOD1 + (r >> 11) * 6144, H1 + (size_t)m * 2048, lane); } } }
        GSYNC();
        { TID_VARS mix_phase(P, 0, 1, 2, gtid, gthreads); }
        GSYNC();
        { GETP unsigned char* ws = P->ws; float* MOD = (float*)(ws + WS_MOD); (void)MOD; pg8::Gemm g{(const bf16*)(ws + WS_A), (const bf16*)(ws + WB_L1_IN), 9216, 12288, 2048, A_STRIDE, 16, 48}; pg8::StaticOrder S; S.init(9216, 12288, G, (int)blockIdx.x);
          pg8::EpiSplitBf16 E{(bf16*)(ws + WS_RKV), 4096, 4096, (size_t)9216 * 4096};
          PB_BEGIN(1) pg8::gemm_phase<pg8::EpiSplitBf16, pg8::StaticOrder, true, true>(lds, g, S, E); PB_END(1) }
        GSYNC();
        { TID_VARS mix_phase(P, 3, 4, 5, gtid, gthreads); }
        GSYNC();
        { GETP unsigned char* ws = P->ws; float* MOD = (float*)(ws + WS_MOD); (void)MOD; pg8::Gemm g{(const bf16*)(ws + WS_A), (const bf16*)(ws + WB_L1_IN) + (size_t)12288 * 2048, 9216, 4608, 2048, A_STRIDE, 16, 16}; pg8::StaticOrder S; S.init(9216, 4608, G, (int)blockIdx.x);
          pg8::EpiZLora E{(bf16*)(ws + WS_ZB), (bf16*)(ws + WS_ZB + ZB_LW), (bf16*)(ws + WS_ZB + ZB_LA)};
          PB_BEGIN(1) pg8::gemm_phase<pg8::EpiZLora, pg8::StaticOrder, true, true>(lds, g, S, E); PB_END(1) }
        GSYNC();
        { PB_BEGIN(3) TID_VARS rwkv_phase(P, lds, hb, tid); PB_END(3) }
        GSYNC();
        { GETP unsigned char* ws = P->ws; float* MOD = (float*)(ws + WS_MOD); (void)MOD; pg8::Gemm g{(const bf16*)(ws + WS_ZB) + (size_t)1024 * 4096, (const bf16*)(ws + WB_L1_OUT), 8192, 2048, 4096, 0, 1, 1 << 30}; pg8::StaticOrder S; S.init(8192, 2048, G, (int)blockIdx.x);
          pg8::EpiResid E{P->out, P->out, nullptr, nullptr, MOD + 9 * 6144, 0, hb * 8192};
          PB_BEGIN(1) pg8::gemm_phase<pg8::EpiResid, pg8::StaticOrder, true, true>(lds, g, S, E); PB_END(1) }
        GSYNC();
    }
    { TID_VARS const float* fg = P->in[36];
      for (int m = gw; m < 16384; m += NGW) { float* xr = P->out + (size_t)m * 2048;
          f32x4 v[8]; float s = 0.f;
#pragma unroll
          for (int j = 0; j < 8; ++j) { v[j] = ((const f32x4*)xr)[lane + 64 * j]; s += (v[j].x * v[j].x + v[j].y * v[j].y) + (v[j].z * v[j].z + v[j].w * v[j].w); }
          const float rstd = 1.0f / sqrtf(wave_sum(s) * (1.0f / 2048.0f) + 1e-6f);
#pragma unroll
          for (int j = 0; j < 8; ++j) ((f32x4*)xr)[lane + 64 * j] = v[j] * rstd * ((const f32x4*)fg)[lane + 64 * j]; } }
#ifdef PROBE_CAT
    { const unsigned long long t1 = __builtin_amdgcn_s_memrealtime(); while (__builtin_amdgcn_s_memrealtime() - t1 < pb_acc) __builtin_amdgcn_s_sleep(8); }
#endif
}

extern "C" void kernel_launch(void* const* d_in, const int* in_sizes, int n_in, void* d_out, int out_size, void* d_ws, size_t ws_size, hipStream_t stream) {
    static int grid = 0;
    if (grid == 0) {
        if (n_in != 37 || ws_size < WS_END) { fprintf(stderr, "kernel_launch: need 37 inputs and >= %zu bytes of workspace; got n_in %d, ws %zu; nothing launched\n", (size_t)WS_END, n_in, ws_size); grid = -1; return; }
        int dev = 0, cus = 0, per_cu = 0;
        if (hipGetDevice(&dev) != hipSuccess || hipDeviceGetAttribute(&cus, hipDeviceAttributeMultiprocessorCount, dev) != hipSuccess) { grid = -1; return; }
        if (hipFuncSetAttribute((const void*)fwd_megakernel, hipFuncAttributeMaxDynamicSharedMemorySize, LDS_BYTES) != hipSuccess) { fprintf(stderr, "kernel_launch: hipFuncSetAttribute failed\n"); grid = -1; return; }
        if (hipOccupancyMaxActiveBlocksPerMultiprocessor(&per_cu, (const void*)fwd_megakernel, NT, LDS_BYTES) != hipSuccess || per_cu < 1) { fprintf(stderr, "kernel_launch: occupancy query says %d\n", per_cu); per_cu = 1; }
        (void)hipGetLastError();
        grid = cus * 1;
    }
    if (grid < 0) return;
    (void)hipMemsetAsync((char*)d_ws + WS_MOD, 0, ZERO_BYTES, stream);
    Params p{};
    for (int i = 0; i < 37; ++i) p.in[i] = (const float*)d_in[i];
    p.out = (float*)d_out; p.ws = (unsigned char*)d_ws;
    void* args[] = {&p};
    hipError_t e = hipLaunchCooperativeKernel((const void*)fwd_megakernel, dim3(grid), dim3(NT), args, LDS_BYTES, stream);
    if (e != hipSuccess) fprintf(stderr, "cooperative launch failed: %s (grid %d)\n", hipGetErrorString(e), grid);
}
```

```cpp
#include <hip/hip_runtime.h>
#include <hip/hip_cooperative_groups.h>
#include <cstdio>
#include <cstdint>
namespace cg = cooperative_groups;
namespace pg8 {
#define PG8_LAS __attribute__((address_space(3)))
typedef unsigned short bf16_t;
typedef short bf16x8 __attribute__((ext_vector_type(8)));
typedef float f32x4 __attribute__((ext_vector_type(4)));
typedef unsigned u32x4 __attribute__((ext_vector_type(4)));
constexpr int BM = 256, BK = 64, HALF = 128, HTB = HALF * BK * 2  , STAGE_BYTES = 8 * HTB, NXCD = 8, WGM = 8;

__host__ __device__ __forceinline__ int lds_byte(int r, int c) { const int st = (r >> 4) * 2 + (c >> 5), rr = r & 15, cc = c & 31, ob = rr * 64 + cc * 2; return st * 1024 + (ob ^ (((ob >> 9) & 1) << 5)); }
__host__ __device__ __forceinline__ void stage_rc(int b, int& R, int& C) { const int st = b / 1024, sb = b % 1024, swz = sb ^ (((sb >> 9) & 1) << 5); R = (st >> 1) * 16 + swz / 64; C = (st & 1) * 32 + (swz % 64) / 2; }
__host__ __device__ __forceinline__ int perm32(int rho) { const int n = rho >> 4, i = rho & 15; return 8 * (i >> 2) + 4 * n + (i & 3); }

struct Unit { int pm, pn; };
struct Gemm { const bf16_t* A; const bf16_t* Bt; int M, N, K; size_t a_stride; int a_div, a_n0; };
#define PG8_AIDX(g, pn) ((size_t)((pn) < (g).a_n0 ? (pn) / (g).a_div : (g).a_n0 / (g).a_div + ((pn) - (g).a_n0)) * (g).a_stride)

struct StaticOrder {
    int nM, nN, nwg, G, c;
    __host__ __device__ void init(int M, int N, int G_, int c_) { nM = M / BM; nN = N / BM; nwg = nM * nN; G = G_; c = c_; }
    __host__ __device__ bool next(int i, Unit& u) const {
        const long L = (long)i * G + c; if (L >= nwg) return false;
        int wgid = (int)L; { const int q = nwg / NXCD, r = nwg % NXCD, xcd = wgid % NXCD, off = wgid / NXCD; wgid = (xcd < r ? xcd * (q + 1) : r * (q + 1) + (xcd - r) * q) + off; }
        const int nig = WGM * nN, gid = wgid / nig, fm = gid * WGM, gsz = (nM - fm) < WGM ? (nM - fm) : WGM;
        u.pm = fm + ((wgid % nig) % gsz); u.pn = (wgid % nig) / gsz; return true;
    }
    __device__ __forceinline__ void a_ready(const Unit&) const {}
    __device__ __forceinline__ void done(const Unit&) const {}
};
typedef float f32x2g __attribute__((ext_vector_type(2))); typedef __bf16 bf16x2g __attribute__((ext_vector_type(2)));
__device__ __forceinline__ unsigned cvt_pk_bf16(float lo, float hi) { const f32x2g v = {lo, hi}; const bf16x2g b = __builtin_convertvector(v, bf16x2g); return __builtin_bit_cast(unsigned, b); }
__device__ __forceinline__ float bflo(unsigned w) { return __builtin_bit_cast(float, w << 16); }
__device__ __forceinline__ float bfhi(unsigned w) { return __builtin_bit_cast(float, w & 0xffff0000u); }
__device__ __forceinline__ float sigm(float x) { return __builtin_amdgcn_rcpf(1.0f + __expf(-x)); }
__device__ __forceinline__ float tanh_f(float x) { const float e = __expf(2.0f * x); return 1.0f - 2.0f * __builtin_amdgcn_rcpf(1.0f + e); }

struct EpiSplitBf16 {
    static constexpr bool PERM = true, AFTER_DRAIN = false;
    bf16_t* O; int ldc; int split_cols; size_t split_stride;
    __device__ __forceinline__ void operator()(const f32x4 (&acc)[2][2][4][2], const Unit& u, int wr, int wc, int fr, int fq) const {
        const int row0 = u.pm * BM + wr * 64 + fr; int colt = u.pn * BM; bf16_t* base = O;
        { const int t = colt / split_cols; base += (size_t)t * split_stride; colt -= t * split_cols; }
        const int col0 = colt + wc * 32 + 8 * fq;
#pragma unroll
        for (int ai = 0; ai < 2; ++ai)
#pragma unroll
            for (int m = 0; m < 4; ++m) { bf16_t* rowp = base + (size_t)(row0 + ai * HALF + m * 16) * ldc + col0;
#pragma unroll
                for (int bj = 0; bj < 2; ++bj) { const f32x4 v0 = acc[ai][bj][m][0], v1 = acc[ai][bj][m][1];
                    u32x4 w; w.x = cvt_pk_bf16(v0[0], v0[1]); w.y = cvt_pk_bf16(v0[2], v0[3]); w.z = cvt_pk_bf16(v1[0], v1[1]); w.w = cvt_pk_bf16(v1[2], v1[3]);
                    *(u32x4*)(rowp + bj * HALF) = w; } }
    }
};

struct EpiGlu {
    static constexpr bool PERM = true, AFTER_DRAIN = false;
    const bf16_t* Y; bf16_t* Z; int ldc; const float* bias;
    __device__ __forceinline__ void operator()(const f32x4 (&acc)[2][2][4][2], const Unit& u, int wr, int wc, int fr, int fq) const {
        const int row0 = u.pm * BM + wr * 64 + fr; const int col0 = u.pn * BM + wc * 32 + 8 * fq;
#pragma unroll
        for (int bj = 0; bj < 2; ++bj) {
            const f32x4 b0 = *(const f32x4*)(bias + col0 + bj * HALF), b1 = *(const f32x4*)(bias + col0 + bj * HALF + 4);
#pragma unroll
            for (int ai = 0; ai < 2; ++ai)
#pragma unroll
                for (int m = 0; m < 4; ++m) {
                    const size_t off = (size_t)(row0 + ai * HALF + m * 16) * ldc + col0 + bj * HALF;
                    const u32x4 yy = *(const u32x4*)(Y + off); const u32x4 zz = *(const u32x4*)(Z + off);
                    const f32x4 t0 = acc[ai][bj][m][0] + b0, t1 = acc[ai][bj][m][1] + b1;
                    float o[8];
#define GLU1(k, yv, zv, tv) { const float y_ = (yv), z_ = (zv); o[k] = (y_ * z_) * __builtin_amdgcn_rcpf((1.0f + __expf(-(tv))) * (1.0f + __expf(-z_))); }
                    GLU1(0, bflo(yy.x), bflo(zz.x), t0[0]) GLU1(1, bfhi(yy.x), bfhi(zz.x), t0[1])
                    GLU1(2, bflo(yy.y), bflo(zz.y), t0[2]) GLU1(3, bfhi(yy.y), bfhi(zz.y), t0[3])
                    GLU1(4, bflo(yy.z), bflo(zz.z), t1[0]) GLU1(5, bfhi(yy.z), bfhi(zz.z), t1[1])
                    GLU1(6, bflo(yy.w), bflo(zz.w), t1[2]) GLU1(7, bfhi(yy.w), bfhi(zz.w), t1[3])
#undef GLU1
                    u32x4 w; w.x = cvt_pk_bf16(o[0], o[1]); w.y = cvt_pk_bf16(o[2], o[3]); w.z = cvt_pk_bf16(o[4], o[5]); w.w = cvt_pk_bf16(o[6], o[7]);
                    *(u32x4*)(Z + off) = w; }
        }
    }
};

struct EpiResid {
    static constexpr bool PERM = false, AFTER_DRAIN = false;
    const float* XIN; float* OUT; const float* CTXIN; float* XC; const float* MOD; int ctx_rows; int lat_row0;
    __device__ __forceinline__ void operator()(const f32x4 (&acc)[2][2][4][2], const Unit& u, int wr, int wc, int fr, int fq) const {
        const int row0 = u.pm * BM + wr * 64 + fr, col0 = u.pn * BM + wc * 32 + 4 * fq;
        const bool isctx = (u.pm * BM) < ctx_rows;
#pragma unroll
        for (int ai = 0; ai < 2; ++ai)
#pragma unroll
            for (int m = 0; m < 4; ++m) {
                const int row = row0 + ai * HALF + m * 16;
                const int rr = isctx ? row : (row - ctx_rows + lat_row0); const int gj = isctx ? 8 : (rr >> 11);
                const float* src = (isctx ? CTXIN : XIN) + (size_t)rr * 2048; float* dst = (isctx ? XC : OUT) + (size_t)rr * 2048; const float* gate = MOD + gj * 6144 + 4096;
#pragma unroll
                for (int bj = 0; bj < 2; ++bj)
#pragma unroll
                    for (int n = 0; n < 2; ++n) { const int c = col0 + bj * HALF + n * 16;
                        const f32x4 g4 = *(const f32x4*)(gate + c); const f32x4 x4 = *(const f32x4*)(src + c);
                        *(f32x4*)(dst + c) = x4 + g4 * acc[ai][bj][m][n]; }
            }
    }
};

struct EpiZLora {
    static constexpr bool PERM = true, AFTER_DRAIN = false;
    bf16_t* Zb; bf16_t* LW; bf16_t* LA;
    __device__ __forceinline__ void operator()(const f32x4 (&acc)[2][2][4][2], const Unit& u, int wr, int wc, int fr, int fq) const {
        const int row0 = u.pm * BM + wr * 64 + fr;
        if (u.pn < 16) {
            if (u.pm < 4) return;
            const int col0 = u.pn * BM + wc * 32 + 8 * fq;
#pragma unroll
            for (int ai = 0; ai < 2; ++ai)
#pragma unroll
                for (int m = 0; m < 4; ++m) { bf16_t* rowp = Zb + (size_t)(row0 + ai * HALF + m * 16) * 4096 + col0;
#pragma unroll
                    for (int bj = 0; bj < 2; ++bj) { const f32x4 v0 = acc[ai][bj][m][0], v1 = acc[ai][bj][m][1];
                        u32x4 w; w.x = cvt_pk_bf16(v0[0], v0[1]); w.y = cvt_pk_bf16(v0[2], v0[3]); w.z = cvt_pk_bf16(v1[0], v1[1]); w.w = cvt_pk_bf16(v1[2], v1[3]);
                        *(u32x4*)(rowp + bj * HALF) = w; } }
        } else {
            const bool isw = (u.pn == 16); bf16_t* base = isw ? LW : LA;
#pragma unroll
            for (int bj = 0; bj < 2; ++bj) {
                const int col = bj * HALF + wc * 32 + 8 * fq;
                if (col < 192) {
#pragma unroll
                    for (int ai = 0; ai < 2; ++ai)
#pragma unroll
                        for (int m = 0; m < 4; ++m) { f32x4 v0 = acc[ai][bj][m][0], v1 = acc[ai][bj][m][1];
                            if (isw) { v0[0] = tanh_f(v0[0]); v0[1] = tanh_f(v0[1]); v0[2] = tanh_f(v0[2]); v0[3] = tanh_f(v0[3]); v1[0] = tanh_f(v1[0]); v1[1] = tanh_f(v1[1]); v1[2] = tanh_f(v1[2]); v1[3] = tanh_f(v1[3]); }
                            u32x4 w; w.x = cvt_pk_bf16(v0[0], v0[1]); w.y = cvt_pk_bf16(v0[2], v0[3]); w.z = cvt_pk_bf16(v1[0], v1[1]); w.w = cvt_pk_bf16(v1[2], v1[3]);
                            *(u32x4*)(base + (size_t)(row0 + ai * HALF + m * 16) * 192 + col) = w; }
                }
            }
        }
    }
};
template <class Epi, class Sched, bool ALIGN_EPI = false, bool SP2 = false>
__device__ __forceinline__ void gemm_phase(PG8_LAS unsigned char* lds, const Gemm g, const Sched& S, const Epi& E) {
    int tid_l = threadIdx.x; asm volatile("" : "+v"(tid_l));
    const int tid = tid_l, wid = __builtin_amdgcn_readfirstlane(tid >> 6), lane = tid & 63, wr = wid >> 2, wc = wid & 3, fr = lane & 15, fq = lane >> 4;
    const int K = g.K, nt = K / BK;
    unsigned voffA[2], voffB[2];
#pragma unroll
    for (int i = 0; i < 2; ++i) { int R, C; stage_rc(tid * 16 + i * 8192, R, C); const int Rb = Epi::PERM ? ((R & ~31) + perm32(R & 31)) : R;
        voffA[i] = (unsigned)(R * K + C) * 2u; voffB[i] = (unsigned)(Rb * K + C) * 2u; }
    const size_t kstep = (size_t)(BK * 2);
    const size_t hstep = (size_t)HALF * K * 2;
    const size_t tstep = 2 * hstep;
    const unsigned ldsw = (unsigned)wid * 1024u;
    const int aoff = lds_byte(wr * 64 + fr, fq * 8), boff = lds_byte(wc * 32 + fr, fq * 8);
#define PG8_SA(b, h) (((b) * 2 + (h)) * HTB)
#define PG8_SB(b, h) ((4 + (b) * 2 + (h)) * HTB)
#define PG8_STAGE(bufoff, gbase, voff) do { _Pragma("unroll") for (int _i = 0; _i < 2; ++_i) \
        __builtin_amdgcn_global_load_lds((const unsigned*)((const char*)(gbase) + (voff)[_i]), (PG8_LAS unsigned*)(lds + (bufoff) + ldsw + _i * 8192), 16, 0, 0); } while (0)
#define PG8_LDA(dst, b, h) do { _Pragma("unroll") for (int m = 0; m < 4; ++m) _Pragma("unroll") for (int k = 0; k < 2; ++k) dst[m][k] = *(const PG8_LAS bf16x8*)(lds + PG8_SA(b, h) + aoff + m * 2048 + k * 1024); } while (0)
#define PG8_LDB(dst, b, h) do { _Pragma("unroll") for (int n = 0; n < 2; ++n) _Pragma("unroll") for (int k = 0; k < 2; ++k) dst[n][k] = *(const PG8_LAS bf16x8*)(lds + PG8_SB(b, h) + boff + n * 2048 + k * 1024); } while (0)
#define PG8_MMA(ai, bj, At, Bt) do { __builtin_amdgcn_s_setprio(1); _Pragma("unroll") for (int m = 0; m < 4; ++m) _Pragma("unroll") for (int n = 0; n < 2; ++n) _Pragma("unroll") for (int k = 0; k < 2; ++k) \
        acc[ai][bj][m][n] = __builtin_amdgcn_mfma_f32_16x16x32_bf16(Bt[n][k], At[m][k], acc[ai][bj][m][n], 0, 0, 0); __builtin_amdgcn_s_setprio(0); } while (0)
#define PG8_WAIT_V(n) asm volatile("s_waitcnt vmcnt(" #n ")" ::: "memory")
#define PG8_WAIT_L(n) asm volatile("s_waitcnt lgkmcnt(" #n ")" ::: "memory")
#define PG8_BAR __builtin_amdgcn_s_barrier()
#define PG8_SCHED __builtin_amdgcn_sched_barrier(0)
    Unit cur, nxt; int ui = 0;
    if (!S.next(0, cur)) return;
    f32x4 acc[2][2][4][2];
#pragma unroll
    for (int a = 0; a < 2; ++a)
#pragma unroll
        for (int b = 0; b < 2; ++b)
#pragma unroll
            for (int m = 0; m < 4; ++m)
#pragma unroll
                for (int n = 0; n < 2; ++n) acc[a][b][m][n] = (f32x4){0.f, 0.f, 0.f, 0.f};
    bf16x8 At[4][2], B0[2][2], B1[2][2];
    const char* cA = (const char*)g.A + PG8_AIDX(g, cur.pn) + (size_t)cur.pm * tstep; const char* cB = (const char*)g.Bt + (size_t)cur.pn * tstep;
    S.a_ready(cur);
    if constexpr (SP2) {
        PG8_STAGE(PG8_SB(0, 0), cB, voffB); PG8_STAGE(PG8_SB(0, 1), cB + hstep, voffB); PG8_STAGE(PG8_SA(0, 0), cA, voffA); PG8_STAGE(PG8_SA(0, 1), cA + hstep, voffA);
        if (wr == 1) PG8_BAR;
        PG8_WAIT_V(2); PG8_BAR;
        PG8_STAGE(PG8_SB(1, 0), cB + kstep, voffB); PG8_STAGE(PG8_SA(1, 0), cA + kstep, voffA); PG8_STAGE(PG8_SB(1, 1), cB + hstep + kstep, voffB);
        PG8_WAIT_V(6); PG8_BAR;
    } else {
        PG8_STAGE(PG8_SB(0, 0), cB, voffB); PG8_STAGE(PG8_SA(0, 0), cA, voffA); PG8_STAGE(PG8_SB(0, 1), cB + hstep, voffB); PG8_STAGE(PG8_SA(0, 1), cA + hstep, voffA);
        if (wr == 1) PG8_BAR;
        PG8_WAIT_V(4); PG8_BAR;
        PG8_STAGE(PG8_SB(1, 0), cB + kstep, voffB); PG8_STAGE(PG8_SA(1, 0), cA + kstep, voffA); PG8_STAGE(PG8_SB(1, 1), cB + hstep + kstep, voffB);
        PG8_WAIT_V(6); PG8_BAR;
    }
    for (;;) {
        const bool has_next = S.next(ui + 1, nxt);
        const char* nA = has_next ? (const char*)g.A + PG8_AIDX(g, nxt.pn) + (size_t)nxt.pm * tstep : cA; const char* nB = has_next ? (const char*)g.Bt + (size_t)nxt.pn * tstep : cB;
        for (int t = 0; t < nt; t += 2) {
            const bool last = (t == nt - 2);
            const char* a1 = cA + (size_t)(t + 1) * kstep;
            const char* a2 = last ? nA : cA + (size_t)(t + 2) * kstep; const char* b2 = last ? nB : cB + (size_t)(t + 2) * kstep;
            const char* a3 = a2 + kstep; const char* b3 = b2 + kstep;
            if (last && has_next) S.a_ready(nxt);
            if constexpr (SP2) {
            PG8_LDB(B0, 0, 0); PG8_LDB(B1, 0, 1); PG8_SCHED; PG8_LDA(At, 0, 0); PG8_STAGE(PG8_SA(1, 1), a1 + hstep, voffA);
            PG8_WAIT_V(8); PG8_WAIT_L(0); PG8_BAR; PG8_MMA(0, 0, At, B0); PG8_MMA(0, 1, At, B1); PG8_BAR; PG8_SCHED;
            PG8_LDA(At, 0, 1); PG8_STAGE(PG8_SB(0, 0), b2, voffB); PG8_STAGE(PG8_SB(0, 1), b2 + hstep, voffB); PG8_STAGE(PG8_SA(0, 0), a2, voffA);
            PG8_WAIT_V(8); PG8_WAIT_L(0); PG8_BAR; PG8_MMA(1, 0, At, B0); PG8_MMA(1, 1, At, B1); PG8_BAR; PG8_SCHED;
            PG8_LDB(B0, 1, 0); PG8_LDB(B1, 1, 1); PG8_SCHED; PG8_LDA(At, 1, 0); PG8_STAGE(PG8_SA(0, 1), a2 + hstep, voffA);
            PG8_WAIT_V(8); PG8_WAIT_L(0); PG8_BAR; PG8_MMA(0, 0, At, B0); PG8_MMA(0, 1, At, B1); PG8_BAR; PG8_SCHED;
            PG8_LDA(At, 1, 1); PG8_STAGE(PG8_SB(1, 0), b3, voffB); PG8_STAGE(PG8_SB(1, 1), b3 + hstep, voffB); PG8_STAGE(PG8_SA(1, 0), a3, voffA);
            PG8_WAIT_V(8); PG8_WAIT_L(0); PG8_BAR; PG8_MMA(1, 0, At, B0); PG8_MMA(1, 1, At, B1); PG8_BAR; PG8_SCHED;
            } else {
            PG8_LDB(B0, 0, 0); PG8_SCHED; PG8_LDA(At, 0, 0); PG8_STAGE(PG8_SA(1, 1), a1 + hstep, voffA);
            PG8_WAIT_L(8); PG8_BAR; PG8_WAIT_L(0); PG8_MMA(0, 0, At, B0); PG8_BAR; PG8_SCHED;
            PG8_LDB(B1, 0, 1); PG8_STAGE(PG8_SB(0, 0), b2, voffB);
            PG8_BAR; PG8_WAIT_L(0); PG8_MMA(0, 1, At, B1); PG8_BAR;
            PG8_LDA(At, 0, 1); PG8_STAGE(PG8_SA(0, 0), a2, voffA);
            PG8_BAR; PG8_WAIT_L(0); PG8_MMA(1, 0, At, B0); PG8_BAR; PG8_SCHED;
            PG8_STAGE(PG8_SB(0, 1), b2 + hstep, voffB);
            PG8_WAIT_V(6); PG8_BAR; PG8_MMA(1, 1, At, B1); PG8_BAR;
            PG8_LDB(B0, 1, 0); PG8_SCHED; PG8_LDA(At, 1, 0); PG8_STAGE(PG8_SA(0, 1), a2 + hstep, voffA);
            PG8_WAIT_L(8); PG8_BAR; PG8_WAIT_L(0); PG8_MMA(0, 0, At, B0); PG8_BAR; PG8_SCHED;
            PG8_LDB(B1, 1, 1); PG8_STAGE(PG8_SB(1, 0), b3, voffB);
            PG8_BAR; PG8_WAIT_L(0); PG8_MMA(0, 1, At, B1); PG8_BAR;
            PG8_LDA(At, 1, 1); PG8_STAGE(PG8_SA(1, 0), a3, voffA);
            PG8_BAR; PG8_WAIT_L(0); PG8_MMA(1, 0, At, B0); PG8_BAR; PG8_SCHED;
            PG8_STAGE(PG8_SB(1, 1), b3 + hstep, voffB);
            PG8_WAIT_V(6); PG8_BAR; PG8_MMA(1, 1, At, B1); PG8_BAR;
            }
        }
        if constexpr (ALIGN_EPI) { if (wr == 0) PG8_BAR; }
        if constexpr (!Epi::AFTER_DRAIN) { E(acc, cur, wr, wc, fr, fq); S.done(cur); }
        if (!has_next) break;
#pragma unroll
        for (int a = 0; a < 2; ++a)
#pragma unroll
            for (int b = 0; b < 2; ++b)
#pragma unroll
                for (int m = 0; m < 4; ++m)
#pragma unroll
                    for (int n = 0; n < 2; ++n) acc[a][b][m][n] = (f32x4){0.f, 0.f, 0.f, 0.f};
        cur = nxt; cA = nA; cB = nB; ++ui;
        if constexpr (ALIGN_EPI) { if (wr == 1) PG8_BAR; }
    }
    PG8_WAIT_V(0);
    if constexpr (!ALIGN_EPI) { if (wr == 0) PG8_BAR; }
    PG8_BAR;
    if constexpr (Epi::AFTER_DRAIN) { E.fused(acc, cur, wr, wc, fr, fq, lds, wid, lane); S.done(cur); }
#undef PG8_SA
#undef PG8_SB
#undef PG8_STAGE
#undef PG8_LDA
#undef PG8_LDB
#undef PG8_MMA
#undef PG8_WAIT_V
#undef PG8_WAIT_L
#undef PG8_BAR
#undef PG8_SCHED
}
}

#define LAS __attribute__((address_space(3)))
typedef unsigned short bf16;
typedef short bf16x8 __attribute__((ext_vector_type(8)));
typedef float f32x4 __attribute__((ext_vector_type(4)));
typedef float f32x16 __attribute__((ext_vector_type(16)));
typedef unsigned u32x4 __attribute__((ext_vector_type(4)));
typedef unsigned u32x2 __attribute__((ext_vector_type(2)));

constexpr int NT = 512;
constexpr int LDS_BYTES = 147456;
constexpr size_t MiB = 1u << 20;
constexpr size_t WS_MOD = 0;
constexpr size_t MOD_BYTES = 2 * 9 * 6144 * 4;
constexpr size_t WS_BAR = 448 * 1024;
constexpr size_t ZERO_BYTES = WS_BAR + 3456 * 4;
constexpr int LDS_BARST = LDS_BYTES - 64;
constexpr size_t WS_QP = 1 * MiB;
constexpr size_t WS_W2T = 3 * MiB;
constexpr size_t WS_A2T = WS_W2T + 2 * 4096 * 96 * 2;
constexpr size_t WS_XC = 6 * MiB;
constexpr size_t WS_WB = 22 * MiB;
constexpr size_t WB_L0_IN = WS_WB, WB_L0_GLU = WS_WB + 32 * MiB, WB_L0_OUT = WS_WB + 64 * MiB;
constexpr size_t WB_L1_IN = WS_WB, WB_L1_OUT = WS_WB + 66 * MiB;
constexpr size_t WS_BIG = 106 * MiB;
constexpr size_t WS_U = WS_BIG, WS_Z = WS_BIG + 144 * MiB, WS_Y = WS_BIG + 288 * MiB;
constexpr size_t WS_H1 = WS_BIG, WS_A = WS_BIG + 36 * MiB, WS_RKV = WS_BIG + 144 * MiB, WS_ZB = WS_BIG + 360 * MiB;
constexpr size_t WS_END = WS_BIG + 432 * MiB;
constexpr size_t A_STRIDE = (size_t)9216 * 2048 * 2;
constexpr size_t WS_YP = WS_A;
constexpr size_t ZB_LW = 0, ZB_LA = (size_t)9216 * 192 * 2;

struct Params { const float* in[37]; float* out; unsigned char* ws; };
typedef const __attribute__((address_space(4))) Params* PPtr;
#define GETP PPtr P = (PPtr)__builtin_amdgcn_kernarg_segment_ptr(); asm volatile("" : "+s"(P));

typedef float f32x2c __attribute__((ext_vector_type(2)));
typedef __bf16 bf16x2c __attribute__((ext_vector_type(2)));
__device__ __forceinline__ unsigned pk2(float lo, float hi) { const f32x2c v = {lo, hi}; const bf16x2c b = __builtin_convertvector(v, bf16x2c); return __builtin_bit_cast(unsigned, b); }
__device__ __forceinline__ unsigned f2bf(float f) { const __bf16 b = (__bf16)f; return (unsigned)__builtin_bit_cast(unsigned short, b); }
__device__ __forceinline__ unsigned f2bf_lo16(float f) { return f2bf(f); }
__device__ __forceinline__ float bf2f(unsigned h) { return __builtin_bit_cast(float, h << 16); }
__device__ __forceinline__ float blo(unsigned w) { return __builtin_bit_cast(float, w << 16); }
__device__ __forceinline__ float bhi(unsigned w) { return __builtin_bit_cast(float, w & 0xffff0000u); }
__device__ __forceinline__ float wave_sum(float v) {
#pragma unroll
    for (int o = 1; o < 64; o <<= 1) v += __shfl_xor(v, o);
    return v;
}
#define DPPF(v, ctrl) __builtin_bit_cast(float, __builtin_amdgcn_update_dpp(0, __builtin_bit_cast(int, (v)), (ctrl), 0xF, 0xF, true))
__device__ __forceinline__ float red8(float v) { v += DPPF(v, 0xB1); v += DPPF(v, 0x4E); v += DPPF(v, 0x141); return v; }
__device__ __forceinline__ float red16(float v) { v = red8(v); v += DPPF(v, 0x128); return v; }
__device__ __forceinline__ float sigmoidf_(float x) { return __builtin_amdgcn_rcpf(1.0f + __expf(-x)); }

#define XB_TMO      128
#define XB_XCNT(j)  (256  + 64 * (j))
#define XB_XSUB(j)  (1280 + 64 * (j))
#define XB_XGEN(j)  (2304 + 64 * (j))
#define XB_TOP      3328
#define XB_TOPGEN   3392
#define XCD_BAR_WORDS 3456
#define XB_SPIN_CAP (1u << 18)

__device__ __forceinline__ unsigned xb_ld(unsigned* p)              { return __hip_atomic_load(p, __ATOMIC_RELAXED, __HIP_MEMORY_SCOPE_AGENT); }
__device__ __forceinline__ unsigned xb_add(unsigned* p, unsigned v) { return __hip_atomic_fetch_add(p, v, __ATOMIC_RELAXED, __HIP_MEMORY_SCOPE_AGENT); }
__device__ __forceinline__ unsigned xb_xcc_id() { return (unsigned)__builtin_amdgcn_s_getreg((3 << 11) | 20) & 0xFu; }
#define XB_SPIN(cond, bar) do { unsigned _sp = 0; while (cond) { __builtin_amdgcn_s_sleep(1); \
    if ((++_sp & 255u) == 0u) { if (xb_ld(&(bar)[XB_TMO])) break; if (_sp > XB_SPIN_CAP) { atomicAdd(&(bar)[XB_TMO], 1u); break; } } } } while (0)

struct XcdBarrier {
    unsigned* bar; unsigned x;
    volatile LAS unsigned* st;
};

__device__ __forceinline__ XcdBarrier xcd_barrier_post(unsigned* bar, volatile LAS unsigned* st) {
    XcdBarrier b; b.bar = bar; b.x = xb_xcc_id(); b.st = st;
    if (threadIdx.x == 0) (void)xb_add(&bar[XB_XCNT(b.x)], 1u);
    return b;
}
__device__ __forceinline__ void xcd_barrier_complete(unsigned* bar, unsigned x, unsigned& nloc, unsigned& nx) {
    const unsigned G = gridDim.x * gridDim.y * gridDim.z;
    unsigned sum, cnt, mine, sp = 0u;
    for (;;) {
        sum = 0u; cnt = 0u; mine = 0u;
#pragma unroll
        for (unsigned j = 0; j < 16; ++j) { const unsigned c = xb_ld(&bar[XB_XCNT(j)]); sum += c; cnt += (c > 0u) ? 1u : 0u; mine = (j == x) ? c : mine; }
        if (sum == G) break;
        __builtin_amdgcn_s_sleep(1);
        if ((++sp & 255u) == 0u) { if (xb_ld(&bar[XB_TMO])) break; if (sp > XB_SPIN_CAP) { atomicAdd(&bar[XB_TMO], 1u); break; } }
    }
    nloc = mine > 0u ? mine : 1u; nx = cnt > 0u ? cnt : 1u;
}

__device__ __forceinline__ void xcd_barrier(const XcdBarrier& b) {
    asm volatile("s_waitcnt vmcnt(0)" ::: "memory");
    __syncthreads();
    if (threadIdx.x == 0) {
        unsigned* bar = b.bar;
        __builtin_amdgcn_s_waitcnt(0);
        unsigned nloc = b.st[0], nx = b.st[1];
        if (nloc == 0u) { xcd_barrier_complete(bar, b.x, nloc, nx); b.st[0] = nloc; b.st[1] = nx; }
        const unsigned old = xb_add(&bar[XB_XSUB(b.x)], 1u);
        const unsigned gen = old / nloc;
        if (old + 1u == (gen + 1u) * nloc) {
            __builtin_amdgcn_fence(__ATOMIC_RELEASE, "agent");
            asm volatile("s_waitcnt vmcnt(0)" ::: "memory");
            const unsigned og = xb_add(&bar[XB_TOP], 1u);
            const unsigned tg = og / nx;
            if (og + 1u == (tg + 1u) * nx) xb_add(&bar[XB_TOPGEN], 1u);
            else XB_SPIN(xb_ld(&bar[XB_TOPGEN]) == tg, bar);
            __builtin_amdgcn_fence(__ATOMIC_ACQUIRE, "agent");
            xb_add(&bar[XB_XGEN(b.x)], 1u);
            asm volatile("s_waitcnt vmcnt(0)" ::: "memory");
        } else {
            XB_SPIN(xb_ld(&bar[XB_XGEN(b.x)]) == gen, bar);
            __builtin_amdgcn_fence(__ATOMIC_ACQUIRE, "agent");
            asm volatile("s_waitcnt vmcnt(0)" ::: "memory");
        }
    }
    __syncthreads();
}

__device__ __forceinline__ void transpose_item(const float* W, int K, int N, bf16* WT, int row_off, LAS float* scr, int item, int lane) {
    const int nblk = N / 32, kb = item / nblk, nb = item % nblk, k0 = 64 * kb, n0 = 32 * nb;
    float tv[32];
#pragma unroll
    for (int i = 0; i < 32; ++i) { const int kk = 2 * i + (lane >> 5); tv[i] = W[(size_t)(k0 + kk) * N + n0 + (lane & 31)]; }
#pragma unroll
    for (int i = 0; i < 32; ++i) { const int kk = 2 * i + (lane >> 5); scr[kk * 33 + (lane & 31)] = tv[i]; }
    asm volatile("s_waitcnt lgkmcnt(0)" ::: "memory");
    const int c = lane & 7;
#pragma unroll
    for (int j = 0; j < 4; ++j) { const int n = (lane >> 3) + 8 * j; const LAS float* s = scr + (8 * c) * 33 + n;
        u32x4 o; o.x = pk2(s[0 * 33], s[1 * 33]); o.y = pk2(s[2 * 33], s[3 * 33]); o.z = pk2(s[4 * 33], s[5 * 33]); o.w = pk2(s[6 * 33], s[7 * 33]);
        *(u32x4*)(WT + (size_t)(row_off + n0 + n) * K + k0 + 8 * c) = o; }
    asm volatile("s_waitcnt lgkmcnt(0)" ::: "memory");
}

__device__ __forceinline__ void mod_task(PPtr P, float* MOD, LAS float* sil, int tk, int tid) {
    const int layer = tk / 384, rem = tk % 384, ks = rem / 12, nb = rem % 12;
    const float* ada_w = P->in[layer ? 20 : 5]; const float* ada_b = P->in[layer ? 21 : 6];
    const float* c = P->in[1]; const float* cc = P->in[3];
    const int k0 = ks * 64, n = nb * 512 + tid;
    __syncthreads();
    for (int idx = tid; idx < 64 * 9; idx += NT) { const int k = idx / 9, j = idx % 9; const float v = (j < 8) ? c[j * 2048 + k0 + k] : cc[k0 + k]; sil[idx] = v * sigmoidf_(v); }
    __syncthreads();
    float acc[9];
#pragma unroll
    for (int j = 0; j < 9; ++j) acc[j] = 0.f;
#pragma unroll 1
    for (int kb = 0; kb < 64; kb += 16) { float w[16];
#pragma unroll
        for (int k = 0; k < 16; ++k) w[k] = ada_w[(size_t)(k0 + kb + k) * 6144 + n];
#pragma unroll
        for (int k = 0; k < 16; ++k)
#pragma unroll
            for (int j = 0; j < 9; ++j) acc[j] += sil[(kb + k) * 9 + j] * w[k]; }
    const float bb = (ks == 0) ? ada_b[n] : 0.f;
#pragma unroll
    for (int j = 0; j < 9; ++j) atomicAdd(MOD + (size_t)(layer * 9 + j) * 6144 + n, acc[j] + bb);
}

__device__ __forceinline__ void normmod_row(const float* xrow, const float* g, const float* mod  , bf16* orow, int lane) {
    f32x4 v[8]; float s = 0.f;
#pragma unroll
    for (int j = 0; j < 8; ++j) { v[j] = ((const f32x4*)xrow)[lane + 64 * j]; s += (v[j].x * v[j].x + v[j].y * v[j].y) + (v[j].z * v[j].z + v[j].w * v[j].w); }
    const float rstd = 1.0f / sqrtf(wave_sum(s) * (1.0f / 2048.0f) + 1e-6f);
#pragma unroll
    for (int j = 0; j < 8; ++j) { const int c4 = lane + 64 * j; const f32x4 gg = ((const f32x4*)g)[c4], sh = ((const f32x4*)mod)[c4], sc = ((const f32x4*)(mod + 2048))[c4];
        const f32x4 y = v[j] * rstd * gg * (sc + 1.0f) + sh;
        u32x2 o; o.x = pk2(y.x, y.y); o.y = pk2(y.z, y.w); ((u32x2*)orow)[c4] = o; }
}

constexpr int S5_ROWB = 528;
constexpr int S5_WLDS = 32 * S5_ROWB;
__device__ __forceinline__ float gelu_tanh(float x) { const float u = 0.7978845608028654f * (x + 0.044715f * x * x * x); const float e = __expf(2.0f * u); return x * (1.0f - __builtin_amdgcn_rcpf(1.0f + e)); }

__device__ __forceinline__ void s5_phase(PPtr P, LAS unsigned char* lds, int wave, int lane) {
    const float* a_re = P->in[8]; const float* a_im = P->in[9]; const float* lstep = P->in[10];
    const float* b_re = P->in[11]; const float* b_im = P->in[12]; const float* c_re = P->in[13]; const float* c_im = P->in[14]; const float* dskip = P->in[15];
    const bf16* U = (const bf16*)(P->ws + WS_U); bf16* Y = (bf16*)(P->ws + WS_Y);
    LAS unsigned char* wl = lds + wave * S5_WLDS;
    const int d = wave >> 2;
    for (int round = blockIdx.x; round < 512; round += gridDim.x) {
        const int unit = round * 4 + (wave & 3), b = unit >> 8, g = unit & 255, dg = d * 256 + g;
        const float dt = expf(lstep[dg]);
        float abr, abi;
        { const float are = a_re[dg * 64 + lane], aim = a_im[dg * 64 + lane]; const float mag = expf(dt * are); abr = mag * cosf(dt * aim); abi = mag * sinf(dt * aim); }
        bf16x8 Bf[4];
#pragma unroll
        for (int nn = 0; nn < 2; ++nn) {
            const int n = (lane & 31) + 32 * nn; const float are = a_re[dg * 64 + n], aim = a_im[dg * 64 + n];
            const float mag = expf(dt * are), cr = mag * cosf(dt * aim), ci = mag * sinf(dt * aim), den = are * are + aim * aim, nr = cr - 1.0f, ni = ci;
            const float fre = (nr * are + ni * aim) / den, fim = (ni * are - nr * aim) / den;
            const float* br = b_re + ((size_t)dg * 64 + n) * 16 + 8 * (lane >> 5); const float* bi = b_im + ((size_t)dg * 64 + n) * 16 + 8 * (lane >> 5);
#pragma unroll
            for (int j = 0; j < 8; ++j) { const float xr = br[j], xi = bi[j]; Bf[nn][j] = (short)f2bf(fre * xr - fim * xi); Bf[2 + nn][j] = (short)f2bf(fre * xi + fim * xr); }
        }
        bf16x8 Cf[4];
#pragma unroll
        for (int ks = 0; ks < 4; ++ks) { const int k = 32 * ks + 8 * (lane >> 4); const int o = lane & 15;
            const float* cr = c_re + ((size_t)dg * 16 + o) * 64 + (k >> 1); const float* cim = c_im + ((size_t)dg * 16 + o) * 64 + (k >> 1);
#pragma unroll
            for (int j = 0; j < 8; ++j) Cf[ks][j] = (short)f2bf((j & 1) ? -cim[j >> 1] : cr[j >> 1]); }
        const f32x4 dska = *(const f32x4*)(dskip + g * 16 + (lane & 1) * 8), dskb = *(const f32x4*)(dskip + g * 16 + (lane & 1) * 8 + 4);
        float hr = 0.f, hi = 0.f;
#define S5CH(cs_) const bool isctx = (cs_) < 8; const int ci = isctx ? (cs_) : (cs_) - 8, nch = isctx ? 8 : 64; const int tc = d ? (nch - 1 - ci) : ci; \
        const size_t rowbase = isctx ? (size_t)b * 256 : (size_t)2048 + (size_t)b * 2048;
#define S5AF(dst, cs_) { S5CH(cs_) (void)ci; const int i_ = lane & 31; const int t_ = 32 * tc + (d ? 31 - i_ : i_); dst = *(const bf16x8*)(U + (rowbase + t_) * 4096 + g * 16 + 8 * (lane >> 5)); }
        bf16x8 Anext; { const int c0 = 0; S5AF(Anext, c0) }
        for (int cs = 0; cs < 72; ++cs) {
            S5CH(cs) const bool first = ci < (nch >> 1);
            const bf16x8 Af = Anext;
            if (cs + 1 < 72) { const int c1 = cs + 1; S5AF(Anext, c1) }
            const int oi = lane >> 1, oh = lane & 1; const int ot = 32 * tc + (d ? 31 - oi : oi);
            const size_t opos = (rowbase + ot) * 4096 + g * 16 + oh * 8;
            u32x4 pyv = {0u, 0u, 0u, 0u}, puv = {0u, 0u, 0u, 0u};
            if (!first) { pyv = *(const u32x4*)(Y + opos); puv = *(const u32x4*)(U + opos); }
            { f32x16 z16; for (int q = 0; q < 16; ++q) z16[q] = 0.f;
#pragma unroll
              for (int nh = 0; nh < 2; ++nh) {
                  const f32x16 rr = __builtin_amdgcn_mfma_f32_32x32x16_bf16(Af, Bf[nh], z16, 0, 0, 0), ri = __builtin_amdgcn_mfma_f32_32x32x16_bf16(Af, Bf[2 + nh], z16, 0, 0, 0);
#pragma unroll
                  for (int reg = 0; reg < 16; ++reg) { const int ii = (reg & 3) + 8 * (reg >> 2) + 4 * (lane >> 5);
                      *(LAS f32x2c*)(wl + ii * S5_ROWB + ((lane & 31) + 32 * nh) * 8) = (f32x2c){rr[reg], ri[reg]}; } } }
#pragma unroll 8
            for (int i = 0; i < 32; ++i) { const f32x2c bu = *(LAS f32x2c*)(wl + i * S5_ROWB + lane * 8);
                const float nhr = abr * hr - abi * hi + bu.x, nhi = abr * hi + abi * hr + bu.y; hr = nhr; hi = nhi;
                *(LAS unsigned*)(wl + i * S5_ROWB + lane * 4) = pk2(hr, hi); }
#pragma unroll
            for (int mt = 0; mt < 2; ++mt) { f32x4 yv = {0.f, 0.f, 0.f, 0.f};
#pragma unroll
                for (int ks = 0; ks < 4; ++ks) { const bf16x8 Hf = *(const LAS bf16x8*)(wl + (16 * mt + (lane & 15)) * S5_ROWB + (32 * ks + 8 * (lane >> 4)) * 2);
                    yv = __builtin_amdgcn_mfma_f32_16x16x32_bf16(Hf, Cf[ks], yv, 0, 0, 0); }
#pragma unroll
                for (int reg = 0; reg < 4; ++reg) *(LAS float*)(wl + (16 * mt + 4 * (lane >> 4) + reg) * S5_ROWB + 256 + (lane & 15) * 4) = yv[reg]; }
            asm volatile("" ::: "memory");
            { const f32x4 ya = *(LAS f32x4*)(wl + oi * S5_ROWB + 256 + oh * 32), yb = *(LAS f32x4*)(wl + oi * S5_ROWB + 256 + oh * 32 + 16);
              u32x4 o;
              if (first) { o = (u32x4){pk2(ya.x, ya.y), pk2(ya.z, ya.w), pk2(yb.x, yb.y), pk2(yb.z, yb.w)}; }
              else {
#define S5G(yv_, pw_, uw_, dk_, hi_) gelu_tanh((yv_) + ((hi_) ? bhi(pw_) : blo(pw_)) + (dk_) * ((hi_) ? bhi(uw_) : blo(uw_)))
                  o.x = pk2(S5G(ya.x, pyv.x, puv.x, dska.x, 0), S5G(ya.y, pyv.x, puv.x, dska.y, 1)); o.y = pk2(S5G(ya.z, pyv.y, puv.y, dska.z, 0), S5G(ya.w, pyv.y, puv.y, dska.w, 1));
                  o.z = pk2(S5G(yb.x, pyv.z, puv.z, dskb.x, 0), S5G(yb.y, pyv.z, puv.z, dskb.y, 1)); o.w = pk2(S5G(yb.z, pyv.w, puv.w, dskb.z, 0), S5G(yb.w, pyv.w, puv.w, dskb.w, 1));
#undef S5G
              }
              *(u32x4*)(Y + opos) = o; }
            asm volatile("" ::: "memory");
            if (ci == (nch >> 1) - 1) __syncthreads();
        }
        __syncthreads();
#undef S5CH
#undef S5AF
    }
}

typedef float f32x2 __attribute__((ext_vector_type(2)));
constexpr int RW_ARR = 16 * 64 * 4;
constexpr int RO_TT = 0, RO_WD = 8704, RO_PA = 21760, RO_Q = 62720, RO_AR = 63232, RO_BK = 77056, RO_BKT = 86272, RO_WL = 103168, RO_VB = 103936, RO_G = 112640, RO_ZT = 117248, RO_MM = 120064, RO_PW = 122880, RO_Y = 133120, RO_CST = 141824, RW_END = 143104;
constexpr int T_ROW = 88, BKT_SLOT = 64 * T_ROW, ZT_SLOT = 16 * T_ROW;
constexpr int W_ROW = 68, W_SLOT = 16 * W_ROW * 4;
constexpr int VB_ROW = 136, VB_SLOT = 16 * VB_ROW, Y_ROW = 68, Y_SLOT = 16 * Y_ROW * 4;
static_assert(RW_END <= LDS_BYTES - 64, "rwkv LDS map");
__device__ __forceinline__ void rwkv_phase(PPtr P, LAS unsigned char* lds, int hb, int tid) {
    const float* w0 = P->in[24]; const float* a0 = P->in[27]; const float* k_k = P->in[30]; const float* k_a = P->in[31]; const float* r_k = P->in[32];
    const float* ln_w = P->in[33]; const float* ln_b = P->in[34];
    const bf16* RB = (const bf16*)(P->ws + WS_RKV); const bf16* KB = RB + (size_t)9216 * 4096; const bf16* VB = KB + (size_t)9216 * 4096;
    bf16* ZB = (bf16*)(P->ws + WS_ZB); const bf16* LW = (const bf16*)(P->ws + WS_ZB + ZB_LW); const bf16* LA = (const bf16*)(P->ws + WS_ZB + ZB_LA);
    const bf16* W2T = (const bf16*)(P->ws + WS_W2T); const bf16* A2T = (const bf16*)(P->ws + WS_A2T);
    bf16* YP = (bf16*)(P->ws + WS_YP); float* QP = (float*)(P->ws + WS_QP);
    const int wid = __builtin_amdgcn_readfirstlane(tid >> 6), lane0 = tid & 63;
#define LANEVARS int lnv = lane0; asm volatile("" : "+v"(lnv)); const int lane = lnv, fr = lane & 15, fq = lane >> 4; (void)fr; (void)fq;
#define BAR_LDS() do { asm volatile("s_waitcnt lgkmcnt(0)" ::: "memory"); __builtin_amdgcn_s_barrier(); asm volatile("" ::: "memory"); } while (0)
#define STH(p, v) (*(LAS unsigned short*)(p) = (unsigned short)f2bf_lo16(v))
#define CHUNK(c_, tc_, rb_) const bool ic_##c_ = (c_) < 16; const int ci_##c_ = ic_##c_ ? (c_) : (c_) - 16, nch_##c_ = ic_##c_ ? 16 : 128; \
        const int tc_ = d ? (nch_##c_ - 1 - ci_##c_) : ci_##c_; const size_t rb_ = ic_##c_ ? (size_t)bl * 256 : (size_t)1024 + (size_t)bl * 2048;
#define CST(a_, nq_) (*(LAS f32x4*)((LAS float*)(lds + RO_CST) + (a_) * 64 + 4 * (nq_)))
    for (int pr = blockIdx.x; pr < 256; pr += gridDim.x) {
        const int bl = pr >> 6, h = pr & 63;
        __syncthreads();
        if (tid < 320) { const int a_ = tid >> 6, c_ = tid & 63; const float* src = a_ == 0 ? k_k : (a_ == 1 ? k_a : (a_ == 2 ? r_k : (a_ == 3 ? ln_w : ln_b))); ((LAS float*)(lds + RO_CST))[tid] = src[h * 64 + c_]; }
        for (int d = 0; d < 2; ++d) {
            __syncthreads();
            f32x4 St[4];
#pragma unroll
            for (int nt = 0; nt < 4; ++nt) St[nt] = (f32x4){0.f, 0.f, 0.f, 0.f};
            bf16x8 Bw[3], Ba[3]; float w0v = 0.f, a0v = 0.f;
            u32x4 PF[6];
#pragma unroll
            for (int j = 0; j < 6; ++j) PF[j] = (u32x4){0u, 0u, 0u, 0u};
#pragma unroll
            for (int ks = 0; ks < 3; ++ks) { Bw[ks] = (bf16x8){0, 0, 0, 0, 0, 0, 0, 0}; Ba[ks] = Bw[ks]; }
#define PFLO(v, j) ((j) & 1 ? (u32x2){(v).z, (v).w} : (u32x2){(v).x, (v).y})
#define PFSET(v, j, val) { const u32x2 t_ = (val); if ((j) & 1) { (v).z = t_.x; (v).w = t_.y; } else { (v).x = t_.x; (v).y = t_.y; } }
#define LPREF(c_) { CHUNK(c_, tc_, rb_) const size_t row_ = rb_ + 16 * tc_ + (d ? 15 - fr : fr); const bf16* lwr = LW + row_ * 192 + d * 96 + 8 * fq; const bf16* lar = LA + row_ * 192 + d * 96 + 8 * fq; \
                _Pragma("unroll") for (int ks = 0; ks < 3; ++ks) { PF[ks] = *(const u32x4*)(lwr + 32 * ks); PF[3 + ks] = *(const u32x4*)(lar + 32 * ks); } }
            if (wid < 4) { LANEVARS
                const size_t rowo = ((size_t)d * 4096 + h * 64 + 16 * wid + fr) * 96 + 8 * fq;
#pragma unroll
                for (int ks = 0; ks < 3; ++ks) { Bw[ks] = *(const bf16x8*)(W2T + rowo + 32 * ks); Ba[ks] = *(const bf16x8*)(A2T + rowo + 32 * ks); }
                const int hn1 = h * 64 + 16 * wid + fr; w0v = w0[d * 4096 + hn1]; a0v = a0[d * 4096 + hn1];
                { const int c0 = 0; LPREF(c0) } }
            f32x4 cKK = {0.f, 0.f, 0.f, 0.f}, cKA = cKK, cRK = cKK;
            if (wid == 5 || wid == 6) { LANEVARS cKK = CST(0, fr); cKA = CST(1, fr); cRK = CST(2, fr); }
            for (int it = -4; it <= 144; ++it) {
                LANEVARS
                if (wid < 4) {
                    if (it >= 0 && it <= 143) { const int c = it;
                        LAS unsigned char* oAR = lds + RO_AR + (c % 3) * 4608; LAS unsigned char* oBKT = lds + RO_BKT + (c % 3) * BKT_SLOT; LAS float* aWL = (LAS float*)(lds + RO_WL + (c % 3) * 256);
                        LAS unsigned char* oVB = lds + RO_VB + (c & 3) * VB_SLOT; LAS unsigned char* oZT = lds + RO_ZT + (c & 1) * ZT_SLOT; LAS unsigned char* oMM = lds + RO_MM + (c & 1) * ZT_SLOT;
                        LAS float* aY = (LAS float*)(lds + RO_Y + (c & 1) * Y_SLOT);
#define PERMK(base_, rowbytes_) ({ const u32x2 lo_ = *(const LAS u32x2*)((base_) + (rowbytes_) + 8 * fq), hi_ = *(const LAS u32x2*)((base_) + (rowbytes_) + 32 + 8 * fq); __builtin_bit_cast(bf16x8, (u32x4){lo_.x, lo_.y, hi_.x, hi_.y}); })
                        f32x4 XuT = {0.f, 0.f, 0.f, 0.f}, XrT = {0.f, 0.f, 0.f, 0.f};
#pragma unroll
                        for (int ks = 0; ks < 2; ++ks) {
                            const u32x4 bs = {pk2(St[2 * ks][0], St[2 * ks][1]), pk2(St[2 * ks][2], St[2 * ks][3]), pk2(St[2 * ks + 1][0], St[2 * ks + 1][1]), pk2(St[2 * ks + 1][2], St[2 * ks + 1][3])};
                            const bf16x8 A0 = PERMK(oAR, fr * 144 + 64 * ks), A1 = PERMK(oAR, (16 + fr) * 144 + 64 * ks);
                            XuT = __builtin_amdgcn_mfma_f32_16x16x32_bf16(A0, __builtin_bit_cast(bf16x8, bs), XuT, 0, 0, 0); XrT = __builtin_amdgcn_mfma_f32_16x16x32_bf16(A1, __builtin_bit_cast(bf16x8, bs), XrT, 0, 0, 0); }
                        unsigned vlo, vhi;
                        { const unsigned v0 = *(LAS unsigned short*)(oVB + (4 * fq + 0) * VB_ROW + (16 * wid + fr) * 2), v1 = *(LAS unsigned short*)(oVB + (4 * fq + 1) * VB_ROW + (16 * wid + fr) * 2);
                          const unsigned v2 = *(LAS unsigned short*)(oVB + (4 * fq + 2) * VB_ROW + (16 * wid + fr) * 2), v3 = *(LAS unsigned short*)(oVB + (4 * fq + 3) * VB_ROW + (16 * wid + fr) * 2);
                          vlo = v0 | (v1 << 16); vhi = v2 | (v3 << 16); }
                        f32x4 UT = {0.f, 0.f, 0.f, 0.f};
                        { const u32x4 bu = {pk2(XuT[0], XuT[1]), pk2(XuT[2], XuT[3]), vlo, vhi};
                          UT = __builtin_amdgcn_mfma_f32_16x16x32_bf16(PERMK(oZT, fr * T_ROW), __builtin_bit_cast(bf16x8, bu), UT, 0, 0, 0); }
                        const u32x4 buv = {pk2(UT[0], UT[1]), pk2(UT[2], UT[3]), vlo, vhi};
                        if (c >= 16) {
                            const f32x4 y = __builtin_amdgcn_mfma_f32_16x16x32_bf16(PERMK(oMM, fr * T_ROW), __builtin_bit_cast(bf16x8, buv), XrT, 0, 0, 0);
#pragma unroll
                            for (int reg = 0; reg < 4; ++reg) aY[(4 * fq + reg) * Y_ROW + 16 * wid + fr] = y[reg]; }
#pragma unroll
                        for (int nt = 0; nt < 4; ++nt) { const f32x4 r = __builtin_amdgcn_mfma_f32_16x16x32_bf16(PERMK(oBKT, (16 * nt + fr) * T_ROW), __builtin_bit_cast(bf16x8, buv), St[nt], 0, 0, 0);
                            St[nt] = r * *(LAS f32x4*)(aWL + 16 * nt + 4 * fq); }
#undef PERMK
                    }
                    if (it + 4 <= 143) { const int c = it + 4;
                        LAS float* aWd = (LAS float*)(lds + RO_WD + (c % 3) * W_SLOT); LAS float* aTt = (LAS float*)(lds + RO_TT + (c & 1) * W_SLOT);
                        f32x4 cw = {0.f, 0.f, 0.f, 0.f}, ca = {0.f, 0.f, 0.f, 0.f};
#pragma unroll
                        for (int ks = 0; ks < 3; ++ks) { cw = __builtin_amdgcn_mfma_f32_16x16x32_bf16(__builtin_bit_cast(bf16x8, PF[ks]), Bw[ks], cw, 0, 0, 0); ca = __builtin_amdgcn_mfma_f32_16x16x32_bf16(__builtin_bit_cast(bf16x8, PF[3 + ks]), Ba[ks], ca, 0, 0, 0); }
#pragma unroll
                        for (int reg = 0; reg < 4; ++reg) { const int ii = 4 * fq + reg; const int n = 16 * wid + fr;
                            const float sg = sigmoidf_(w0v + cw[reg]);
                            aWd[ii * W_ROW + n] = __expf(-0.60653065971263342f * sg); aTt[ii * W_ROW + n] = sigmoidf_(a0v + ca[reg]); }
                    }
                    if (it + 5 >= 0 && it + 5 <= 143) { const int c5 = it + 5; LPREF(c5) }
                    if (wid == 0 && it + 2 >= 0 && it + 2 <= 143) { const int c = it + 2; const int k = lane;
                        LAS float* aWd = (LAS float*)(lds + RO_WD + (c % 3) * W_SLOT); LAS float* pa = (LAS float*)(lds + RO_PA + (c & 1) * 20480);
                        LAS unsigned char* oAR = lds + RO_AR + (c % 3) * 4608; LAS float* aWL = (LAS float*)(lds + RO_WL + (c % 3) * 256);
                        float Wc = 1.0f;
#pragma unroll
                        for (int t = 0; t < 16; ++t) { const float Wp = Wc; Wc *= aWd[t * W_ROW + k];
                            STH(oAR + t * 144 + k * 2, pa[0 * 1024 + t * 64 + k] * Wp); }
                        aWL[k] = Wc; }
                    if (wid == 1 && it + 2 >= 0 && it + 2 <= 143) { const int c = it + 2; const int k = lane;
                        LAS float* aWd = (LAS float*)(lds + RO_WD + (c % 3) * W_SLOT); LAS float* pa = (LAS float*)(lds + RO_PA + (c & 1) * 20480);
                        LAS unsigned char* oAR = lds + RO_AR + (c % 3) * 4608; LAS unsigned char* oVB = lds + RO_VB + (c & 3) * VB_SLOT;
                        float Wc = 1.0f;
#pragma unroll
                        for (int t = 0; t < 16; ++t) { Wc *= aWd[t * W_ROW + k]; STH(oAR + (16 + t) * 144 + k * 2, pa[3 * 1024 + t * 64 + k] * Wc); STH(oVB + t * VB_ROW + k * 2, pa[4 * 1024 + t * 64 + k]); } }
                } else if (wid == 4) {
                    if (it - 1 >= 16 && it - 1 <= 143) { const int c = it - 1; CHUNK(c, tc_, rb_) (void)rb_;
                        LAS float* aY = (LAS float*)(lds + RO_Y + (c & 1) * Y_SLOT); LAS float* aQ = (LAS float*)(lds + RO_Q + (c & 7) * 64); LAS unsigned char* oVB = lds + RO_VB + (c & 3) * VB_SLOT;
#pragma unroll
                        for (int j = 0; j < 4; ++j) { const int pi = fq + 4 * j, nq = fr, hn4 = h * 64 + 4 * nq;
                            const size_t rl = (size_t)bl * 2048 + 16 * tc_ + (d ? 15 - pi : pi);
                            const f32x4 y4 = *(LAS f32x4*)(aY + pi * Y_ROW + 4 * nq); const float qown = aQ[pi];
                            if (d == 0) {
                                u32x2 o; o.x = pk2(y4.x, y4.y); o.y = pk2(y4.z, y4.w); *(u32x2*)(YP + rl * 4096 + hn4) = o;
                                if (nq == 0) QP[rl * 64 + h] = qown;
                            } else {
                                const u32x2 py_ = PFLO(PF[j >> 1], j), pz_ = PFLO(PF[2 + (j >> 1)], j); const float pq_ = __builtin_bit_cast(float, j == 0 ? PF[4].x : (j == 1 ? PF[4].y : (j == 2 ? PF[4].z : PF[4].w)));
                                const f32x4 ys = {y4.x + blo(py_.x), y4.y + bhi(py_.x), y4.z + blo(py_.y), y4.w + bhi(py_.y)};
                                float sm = (ys.x + ys.y) + (ys.z + ys.w); sm = red16(sm); const float mean = sm * (1.0f / 64.0f);
                                const f32x4 dv = ys - mean; float vs = (dv.x * dv.x + dv.y * dv.y) + (dv.z * dv.z + dv.w * dv.w); vs = red16(vs);
                                const float rstd = __builtin_amdgcn_rsqf(vs * (1.0f / 64.0f) + 64e-5f);
                                const float q = qown + pq_;
                                const u32x2 vb = *(LAS u32x2*)(oVB + pi * VB_ROW + nq * 8);
                                const f32x4 v4 = {blo(vb.x), bhi(vb.x), blo(vb.y), bhi(vb.y)};
                                const f32x4 val = dv * rstd * CST(3, nq) + CST(4, nq) + v4 * q;
                                const float z0 = blo(pz_.x), z1 = bhi(pz_.x), z2 = blo(pz_.y), z3 = bhi(pz_.y);
                                u32x2 o; o.x = pk2(val.x * z0 * sigmoidf_(z0), val.y * z1 * sigmoidf_(z1)); o.y = pk2(val.z * z2 * sigmoidf_(z2), val.w * z3 * sigmoidf_(z3));
                                *(u32x2*)(ZB + (1024 + rl) * 4096 + hn4) = o;
                            } }
                    }
                    if (d == 1 && it >= 16 && it <= 143) { const int c = it; CHUNK(c, tc_, rb_) (void)rb_;
                        u32x2 ty[4], tz[4]; unsigned tq[4];
#pragma unroll
                        for (int j = 0; j < 4; ++j) { const int pi = fq + 4 * j, nq = fr, hn4 = h * 64 + 4 * nq; const size_t rl = (size_t)bl * 2048 + 16 * tc_ + (15 - pi);
                            ty[j] = *(const u32x2*)(YP + rl * 4096 + hn4); tq[j] = __builtin_bit_cast(unsigned, QP[rl * 64 + h]); tz[j] = *(const u32x2*)(ZB + (1024 + rl) * 4096 + hn4); }
                        PF[0] = (u32x4){ty[0].x, ty[0].y, ty[1].x, ty[1].y}; PF[1] = (u32x4){ty[2].x, ty[2].y, ty[3].x, ty[3].y};
                        PF[2] = (u32x4){tz[0].x, tz[0].y, tz[1].x, tz[1].y}; PF[3] = (u32x4){tz[2].x, tz[2].y, tz[3].x, tz[3].y};
                        PF[4] = (u32x4){tq[0], tq[1], tq[2], tq[3]}; }
                    if (it + 1 >= 0 && it + 1 <= 143) { const int c = it + 1;
                        LAS unsigned char* oAR = lds + RO_AR + (c % 3) * 4608; LAS unsigned char* oBK = lds + RO_BK + (c & 1) * 4608; LAS unsigned char* oMM = lds + RO_MM + (c & 1) * ZT_SLOT;
#pragma unroll
                        for (int mi = 0; mi < 2; ++mi) { f32x4 g = {0.f, 0.f, 0.f, 0.f};
#pragma unroll
                            for (int ks = 0; ks < 2; ++ks) { const bf16x8 Af = *(const LAS bf16x8*)(oBK + (16 * mi + fr) * 144 + (32 * ks + 8 * fq) * 2), Bf = *(const LAS bf16x8*)(oAR + (16 + fr) * 144 + (32 * ks + 8 * fq) * 2);
                                g = __builtin_amdgcn_mfma_f32_16x16x32_bf16(Af, Bf, g, 0, 0, 0); }
#pragma unroll
                            for (int reg = 0; reg < 4; ++reg) { const int s_ = 4 * fq + reg; STH(oMM + fr * T_ROW + (16 * mi + s_) * 2, (s_ <= fr) ? g[reg] : 0.f); } } }
                } else if (wid == 5) {
                    if (it + 3 >= 0 && it + 3 <= 143) { const int c = it + 3;
                        LAS float* aTt = (LAS float*)(lds + RO_TT + (c & 1) * W_SLOT); LAS float* pa = (LAS float*)(lds + RO_PA + (c & 1) * 20480); LAS float* aQ = (LAS float*)(lds + RO_Q + (c & 7) * 64);
#pragma unroll
                        for (int j = 0; j < 3; ++j) { const int pi = fq + 4 * j, nq = fr;
                            const u32x2 pk_ = PFLO(PF[j >> 1], j), pr_ = PFLO(PF[2 + (j >> 1)], j), pv_ = PFLO(PF[4 + (j >> 1)], j);
                            const f32x4 k4 = {blo(pk_.x), bhi(pk_.x), blo(pk_.y), bhi(pk_.y)}, r4 = {blo(pr_.x), bhi(pr_.x), blo(pr_.y), bhi(pr_.y)}, v4 = {blo(pv_.x), bhi(pv_.x), blo(pv_.y), bhi(pv_.y)};
                            f32x4 kk = k4 * cKK; float ss = (kk.x * kk.x + kk.y * kk.y) + (kk.z * kk.z + kk.w * kk.w); ss = red16(ss);
                            const float inv = __builtin_amdgcn_rsqf(fmaxf(ss, 1e-24f)); kk = kk * inv;
                            const f32x4 ar = *(LAS f32x4*)(aTt + pi * W_ROW + 4 * nq);
                            const f32x4 kd = k4 * ((ar - 1.0f) * cKA + 1.0f);
                            *(LAS f32x4*)(pa + 0 * 1024 + pi * 64 + 4 * nq) = -kk; *(LAS f32x4*)(pa + 1 * 1024 + pi * 64 + 4 * nq) = kk * ar; *(LAS f32x4*)(pa + 2 * 1024 + pi * 64 + 4 * nq) = kd;
                            *(LAS f32x4*)(pa + 3 * 1024 + pi * 64 + 4 * nq) = r4; *(LAS f32x4*)(pa + 4 * 1024 + pi * 64 + 4 * nq) = v4;
                            const f32x4 q3 = kd * r4 * cRK; float qq = (q3.x + q3.y) + (q3.z + q3.w); qq = red16(qq);
                            if (nq == 0) aQ[pi] = qq; }
                    }
                    if (it + 4 >= 0 && it + 4 <= 143) { const int c4 = it + 4; CHUNK(c4, tc_, rb_)
#pragma unroll
                        for (int j = 0; j < 3; ++j) { const int pi = fq + 4 * j; const size_t off_ = (rb_ + 16 * tc_ + (d ? 15 - pi : pi)) * 4096 + h * 64 + 4 * fr;
                            PFSET(PF[j >> 1], j, *(const u32x2*)(KB + off_)) PFSET(PF[2 + (j >> 1)], j, *(const u32x2*)(RB + off_)) PFSET(PF[4 + (j >> 1)], j, *(const u32x2*)(VB + off_)) } }
                } else if (wid == 6) {
                    if (it + 3 >= 0 && it + 3 <= 143) { const int c = it + 3;
                        LAS float* aTt = (LAS float*)(lds + RO_TT + (c & 1) * W_SLOT); LAS float* pa = (LAS float*)(lds + RO_PA + (c & 1) * 20480); LAS float* aQ = (LAS float*)(lds + RO_Q + (c & 7) * 64);
#pragma unroll
                        for (int j = 3; j < 4; ++j) { const int pi = fq + 4 * j, nq = fr;
                            const u32x2 pk_ = PFLO(PF[j >> 1], j), pr_ = PFLO(PF[2 + (j >> 1)], j), pv_ = PFLO(PF[4 + (j >> 1)], j);
                            const f32x4 k4 = {blo(pk_.x), bhi(pk_.x), blo(pk_.y), bhi(pk_.y)}, r4 = {blo(pr_.x), bhi(pr_.x), blo(pr_.y), bhi(pr_.y)}, v4 = {blo(pv_.x), bhi(pv_.x), blo(pv_.y), bhi(pv_.y)};
                            f32x4 kk = k4 * cKK; float ss = (kk.x * kk.x + kk.y * kk.y) + (kk.z * kk.z + kk.w * kk.w); ss = red16(ss);
                            const float inv = __builtin_amdgcn_rsqf(fmaxf(ss, 1e-24f)); kk = kk * inv;
                            const f32x4 ar = *(LAS f32x4*)(aTt + pi * W_ROW + 4 * nq);
                            const f32x4 kd = k4 * ((ar - 1.0f) * cKA + 1.0f);
                            *(LAS f32x4*)(pa + 0 * 1024 + pi * 64 + 4 * nq) = -kk; *(LAS f32x4*)(pa + 1 * 1024 + pi * 64 + 4 * nq) = kk * ar; *(LAS f32x4*)(pa + 2 * 1024 + pi * 64 + 4 * nq) = kd;
                            *(LAS f32x4*)(pa + 3 * 1024 + pi * 64 + 4 * nq) = r4; *(LAS f32x4*)(pa + 4 * 1024 + pi * 64 + 4 * nq) = v4;
                            const f32x4 q3 = kd * r4 * cRK; float qq = (q3.x + q3.y) + (q3.z + q3.w); qq = red16(qq);
                            if (nq == 0) aQ[pi] = qq; }
                    }
                    if (it + 4 >= 0 && it + 4 <= 143) { const int c4 = it + 4; CHUNK(c4, tc_, rb_)
#pragma unroll
                        for (int j = 3; j < 4; ++j) { const int pi = fq + 4 * j; const size_t off_ = (rb_ + 16 * tc_ + (d ? 15 - pi : pi)) * 4096 + h * 64 + 4 * fr;
                            PFSET(PF[j >> 1], j, *(const u32x2*)(KB + off_)) PFSET(PF[2 + (j >> 1)], j, *(const u32x2*)(RB + off_)) PFSET(PF[4 + (j >> 1)], j, *(const u32x2*)(VB + off_)) } }
                    if (it + 2 >= 0 && it + 2 <= 143) { const int c = it + 2; const int k = lane;
                        LAS float* aWd = (LAS float*)(lds + RO_WD + (c % 3) * W_SLOT); LAS float* pa = (LAS float*)(lds + RO_PA + (c & 1) * 20480);
                        LAS unsigned char* oBK = lds + RO_BK + (c & 1) * 4608; LAS unsigned char* oBKT = lds + RO_BKT + (c % 3) * BKT_SLOT; LAS unsigned char* oAR = lds + RO_AR + (c % 3) * 4608; LAS unsigned char* oVB = lds + RO_VB + (c & 3) * VB_SLOT;
                        float Wc = 1.0f, pxb = 0.f, pxk = 0.f;
#pragma unroll
                        for (int t = 0; t < 16; ++t) { Wc *= aWd[t * W_ROW + k]; const float rW = __builtin_amdgcn_rcpf(Wc);
                            const float xb = pa[1 * 1024 + t * 64 + k] * rW, xk = pa[2 * 1024 + t * 64 + k] * rW;
                            STH(oBK + t * 144 + k * 2, xb); STH(oBK + (16 + t) * 144 + k * 2, xk);
                            if (t & 1) { *(LAS unsigned*)(oBKT + k * T_ROW + (t - 1) * 2) = pk2(pxb, xb); *(LAS unsigned*)(oBKT + k * T_ROW + (16 + t - 1) * 2) = pk2(pxk, xk); } pxb = xb; pxk = xk;
                            } }
                } else {
                    if (it + 1 >= 0 && it + 1 <= 143) { const int c = it + 1;
                        LAS unsigned char* oAR = lds + RO_AR + (c % 3) * 4608; LAS unsigned char* oBK = lds + RO_BK + (c & 1) * 4608; LAS float* aG = (LAS float*)(lds + RO_G);
                        LAS unsigned char* oZT = lds + RO_ZT + (c & 1) * ZT_SLOT;
#pragma unroll
                        for (int mi = 0; mi < 2; ++mi) { const int ni = 0; f32x4 g = {0.f, 0.f, 0.f, 0.f};
#pragma unroll
                            for (int ks = 0; ks < 2; ++ks) { const bf16x8 Af = *(const LAS bf16x8*)(oBK + (16 * mi + fr) * 144 + (32 * ks + 8 * fq) * 2), Bf = *(const LAS bf16x8*)(oAR + (16 * ni + fr) * 144 + (32 * ks + 8 * fq) * 2);
                                g = __builtin_amdgcn_mfma_f32_16x16x32_bf16(Af, Bf, g, 0, 0, 0); }
#pragma unroll
                            for (int reg = 0; reg < 4; ++reg) aG[(16 * mi + 4 * fq + reg) * 36 + 16 * ni + fr] = g[reg]; }
                        asm volatile("" ::: "memory");
                        { const int rp = lane & 31; float z[16], grow[16];
#pragma unroll
                          for (int t4 = 0; t4 < 4; ++t4) { const f32x4 gr = *(LAS f32x4*)(aG + rp * 36 + 4 * t4); grow[4 * t4] = gr.x; grow[4 * t4 + 1] = gr.y; grow[4 * t4 + 2] = gr.z; grow[4 * t4 + 3] = gr.w; }
#pragma unroll
                          for (int t = 0; t < 16; ++t) z[t] = (rp < 16) ? ((t == rp) ? 1.0f : 0.0f) : ((rp - 16 < t) ? grow[t] : 0.0f);
#pragma unroll
                          for (int s = 0; s < 15; ++s) {
#pragma unroll
                              for (int t = s + 1; t < 16; ++t) { const float gst = __builtin_bit_cast(float, __builtin_amdgcn_readlane(__builtin_bit_cast(int, grow[t]), s)); z[t] += z[s] * gst; } }
                          if (lane < 32) {
#pragma unroll
                              for (int t = 0; t < 16; ++t) STH(oZT + t * T_ROW + rp * 2, z[t]); } }
                    }
                }
                BAR_LDS();
            }
        }
    }
    __syncthreads();
#undef LANEVARS
#undef BAR_LDS
#undef STH
#undef CHUNK
#undef CST
#undef LPREF
#undef PFLO
#undef PFSET
}

__device__ __forceinline__ void mix_phase(PPtr P, int i0, int i1, int i2, int gtid, int gthreads) {
    const bf16* H = (const bf16*)(P->ws + WS_H1); const float* mu = P->in[22];
    bf16* A0 = (bf16*)(P->ws + WS_A); bf16* A1 = (bf16*)(P->ws + WS_A + A_STRIDE); bf16* A2 = (bf16*)(P->ws + WS_A + 2 * A_STRIDE);
    for (int idx = gtid; idx < 9216 * 256; idx += gthreads) {
        const int row = idx >> 8, c0 = (idx & 255) * 8;
        int nrow = -1;
        if (row < 1024) { const int t = row & 255; if (c0 < 1024) { if (t > 0) nrow = row - 1; } else { if (t < 255) nrow = row + 1; } }
        else { const int t = (row - 1024) & 2047, gx = t & 63, gy = t >> 6, qd = c0 >> 9;
            if (qd == 0) { if (gx > 0) nrow = row - 1; } else if (qd == 1) { if (gx < 63) nrow = row + 1; } else if (qd == 2) { if (gy > 0) nrow = row - 64; } else { if (gy < 31) nrow = row + 64; } }
        const u32x4 hv = *(const u32x4*)(H + (size_t)row * 2048 + c0);
        u32x4 sv = {0u, 0u, 0u, 0u}; if (nrow >= 0) sv = *(const u32x4*)(H + (size_t)nrow * 2048 + c0);
        const float hf[8] = {blo(hv.x), bhi(hv.x), blo(hv.y), bhi(hv.y), blo(hv.z), bhi(hv.z), blo(hv.w), bhi(hv.w)};
        const float sf[8] = {blo(sv.x), bhi(sv.x), blo(sv.y), bhi(sv.y), blo(sv.z), bhi(sv.z), blo(sv.w), bhi(sv.w)};
#pragma unroll
        for (int q = 0; q < 3; ++q) { const int mi = q == 0 ? i0 : (q == 1 ? i1 : i2); bf16* dst = q == 0 ? A0 : (q == 1 ? A1 : A2);
            const f32x4 m0 = *(const f32x4*)(mu + mi * 2048 + c0), m1 = *(const f32x4*)(mu + mi * 2048 + c0 + 4);
            const float mm[8] = {m0.x, m0.y, m0.z, m0.w, m1.x, m1.y, m1.z, m1.w};
            float o[8];
#pragma unroll
            for (int e = 0; e < 8; ++e) o[e] = hf[e] + (sf[e] - hf[e]) * mm[e];
            u32x4 w; w.x = pk2(o[0], o[1]); w.y = pk2(o[2], o[3]); w.z = pk2(o[4], o[5]); w.w = pk2(o[6], o[7]);
            *(u32x4*)(dst + (size_t)row * 2048 + c0) = w; }
    }
}

__global__ void __launch_bounds__(NT, 2) fwd_megakernel(Params Pk) {
    extern __shared__ __attribute__((aligned(16))) unsigned char lds_raw[];
    LAS unsigned char* lds = (LAS unsigned char*)lds_raw;
    cg::grid_group grid = cg::this_grid();
    const int G = gridDim.x, NGW = G * 8, gthreads = G * NT;
#ifdef PROBE_CAT
    unsigned long long pb_acc = 0, pb_t0 = 0;
#define PB_BEGIN(cat) if (PROBE_CAT == (cat)) pb_t0 = __builtin_amdgcn_s_memrealtime();
#define PB_END(cat) if (PROBE_CAT == (cat)) pb_acc += __builtin_amdgcn_s_memrealtime() - pb_t0;
#else
#define PB_BEGIN(cat)
#define PB_END(cat)
#endif
    { int t_ = threadIdx.x; if (t_ < 16) ((LAS unsigned*)(lds + LDS_BARST))[t_] = 0u; }
    __syncthreads();
    XcdBarrier xbar;
    { GETP xbar = xcd_barrier_post((unsigned*)(P->ws + WS_BAR), (volatile LAS unsigned*)(lds + LDS_BARST)); }
#define GSYNC_CG() do { PB_BEGIN(4) grid.sync(); PB_END(4) } while (0)
#define GSYNC() do { PB_BEGIN(4) xcd_barrier(xbar); PB_END(4) } while (0)
#define TID_VARS GETP unsigned char* ws = P->ws; float* MOD = (float*)(ws + WS_MOD); (void)MOD; int tid = threadIdx.x; asm volatile("" : "+v"(tid)); const int lane = tid & 63, wave = __builtin_amdgcn_readfirstlane(tid >> 6); const int gw = blockIdx.x * 8 + wave, gtid = blockIdx.x * NT + tid; LAS float* scr = (LAS float*)(lds + wave * 16384); (void)lane; (void)gw; (void)gtid; (void)scr;

    { TID_VARS
      for (int tk = blockIdx.x; tk < 768; tk += G) mod_task(P, MOD, (LAS float*)(lds + 8 * 16384), tk, tid);
      constexpr int I_IN = 32 * 256, I_GLU = 64 * 128, I_OUT = 64 * 64;
      for (int it = gw; it < I_IN + I_GLU + I_OUT; it += NGW) { int r = it;
          if (r < I_IN) { transpose_item(P->in[7], 2048, 8192, (bf16*)(ws + WB_L0_IN), 0, scr, r, lane); continue; } r -= I_IN;
          if (r < I_GLU) { transpose_item(P->in[16], 4096, 4096, (bf16*)(ws + WB_L0_GLU), 0, scr, r, lane); continue; } r -= I_GLU;
          transpose_item(P->in[18], 4096, 2048, (bf16*)(ws + WB_L0_OUT), 0, scr, r, lane); } }
    GSYNC(); if (gridDim.x == 0u) GSYNC_CG();
    { TID_VARS bf16* H0 = (bf16*)P->out;
      for (int m = gw; m < 18432; m += NGW) {
          if (m < 2048) normmod_row(P->in[2] + (size_t)m * 2048, P->in[4], MOD + 8 * 6144, H0 + (size_t)m * 2048, lane);
          else { const int r = m - 2048; normmod_row(P->in[0] + (size_t)r * 2048, P->in[4], MOD + (r >> 11) * 6144, H0 + (size_t)m * 2048, lane); } } }
    GSYNC();
    { GETP unsigned char* ws = P->ws; float* MOD = (float*)(ws + WS_MOD); (void)MOD; pg8::Gemm g{(const bf16*)P->out, (const bf16*)(ws + WB_L0_IN), 18432, 8192, 2048, 0, 1, 1 << 30}; pg8::StaticOrder S; S.init(18432, 8192, G, (int)blockIdx.x);
      pg8::EpiSplitBf16 E{(bf16*)(ws + WS_U), 4096, 4096, (size_t)18432 * 4096};
      PB_BEGIN(1) pg8::gemm_phase<pg8::EpiSplitBf16, pg8::StaticOrder, true, true>(lds, g, S, E); PB_END(1) }
    GSYNC();
    { PB_BEGIN(2) TID_VARS s5_phase(P, lds, wave, lane); PB_END(2) }
    GSYNC();
    { GETP unsigned char* ws = P->ws; float* MOD = (float*)(ws + WS_MOD); (void)MOD; pg8::Gemm g{(const bf16*)(ws + WS_Y), (const bf16*)(ws + WB_L0_GLU), 18432, 4096, 4096, 0, 1, 1 << 30}; pg8::StaticOrder S; S.init(18432, 4096, G, (int)blockIdx.x);
      pg8::EpiGlu E{(const bf16*)(ws + WS_Y), (bf16*)(ws + WS_Z), 4096, P->in[17]};
      PB_BEGIN(1) pg8::gemm_phase<pg8::EpiGlu, pg8::StaticOrder, true, true>(lds, g, S, E); PB_END(1) }
    GSYNC();
    { GETP unsigned char* ws = P->ws; float* MOD = (float*)(ws + WS_MOD); (void)MOD; pg8::Gemm g{(const bf16*)(ws + WS_Z), (const bf16*)(ws + WB_L0_OUT), 18432, 2048, 4096, 0, 1, 1 << 30}; pg8::StaticOrder S; S.init(18432, 2048, G, (int)blockIdx.x);
      pg8::EpiResid E{P->in[0], P->out, P->in[2], (float*)(ws + WS_XC), MOD, 2048, 0};
      PB_BEGIN(1) pg8::gemm_phase<pg8::EpiResid, pg8::StaticOrder, true, true>(lds, g, S, E); PB_END(1) }
    GSYNC();
    { TID_VARS constexpr int I_IN = 32 * 128, I_LO = 32 * 3, I_OUT = 64 * 64; bf16* WIN = (bf16*)(ws + WB_L1_IN);
      for (int it = gw; it < 4 * I_IN + 4 * I_LO + I_OUT; it += NGW) { int r = it;
          if (r < 4 * I_IN) { const int q = r / I_IN; transpose_item(P->in[23] + (size_t)q * 2048 * 4096, 2048, 4096, WIN, q * 4096, scr, r % I_IN, lane); continue; } r -= 4 * I_IN;
          if (r < 2 * I_LO) { const int q = r / I_LO; transpose_item(P->in[25] + (size_t)q * 2048 * 96, 2048, 96, WIN, 16384 + q * 96, scr, r % I_LO, lane); continue; } r -= 2 * I_LO;
          if (r < 2 * I_LO) { const int q = r / I_LO; transpose_item(P->in[28] + (size_t)q * 2048 * 96, 2048, 96, WIN, 16640 + q * 96, scr, r % I_LO, lane); continue; } r -= 2 * I_LO;
          transpose_item(P->in[35], 4096, 2048, (bf16*)(ws + WB_L1_OUT), 0, scr, r, lane); }
      for (int idx = gtid; idx < 2 * 64 * 2048 / 8; idx += gthreads) { const int e = idx * 8, pr = e / 2048, c = e % 2048; const int row = (pr < 64) ? 16576 + pr : 16832 + (pr - 64);
          *(u32x4*)(WIN + (size_t)row * 2048 + c) = (u32x4){0u, 0u, 0u, 0u}; }
      bf16* W2T = (bf16*)(ws + WS_W2T); bf16* A2T = (bf16*)(ws + WS_A2T);
      for (int idx = gtid; idx < 2 * 96 * 4096; idx += gthreads) { const int n = idx & 4095, m = (idx >> 12) % 96, dd = idx / (96 * 4096);
          W2T[((size_t)dd * 4096 + n) * 96 + m] = (bf16)f2bf(P->in[26][idx]); A2T[((size_t)dd * 4096 + n) * 96 + m] = (bf16)f2bf(P->in[29][idx]); } }
    for (int hb = 0; hb < 2; ++hb) {
        { TID_VARS bf16* H1 = (bf16*)(ws + WS_H1); const float* MOD1 = MOD + 9 * 6144;
          for (int m = gw; m < 9216; m += NGW) {
              if (m < 1024) normmod_row((const float*)(ws + WS_XC) + (size_t)(hb * 1024 + m) * 2048, P->in[19], MOD1 + 8 * 6144, H1 + (size_t)m * 2048, lane);
              else { const int r = hb * 8192 + (m - 1024); normmod_row(P->out + (size_t)r * 2048, P->in[19], MOD1 + (r >> 11) * 6144, H1 + (size_t)m * 2048, lane); } } }
        GSYNC();
        { TID_VARS mix_phase(P, 0, 1, 2, gtid, gthreads); }
        GSYNC();
        { GETP unsigned char* ws = P->ws; float* MOD = (float*)(ws + WS_MOD); (void)MOD; pg8::Gemm g{(const bf16*)(ws + WS_A), (const bf16*)(ws + WB_L1_IN), 9216, 12288, 2048, A_STRIDE, 16, 48}; pg8::StaticOrder S; S.init(9216, 12288, G, (int)blockIdx.x);
          pg8::EpiSplitBf16 E{(bf16*)(ws + WS_RKV), 4096, 4096, (size_t)9216 * 4096};
          PB_BEGIN(1) pg8::gemm_phase<pg8::EpiSplitBf16, pg8::StaticOrder, true, true>(lds, g, S, E); PB_END(1) }
        GSYNC();
        { TID_VARS mix_phase(P, 3, 4, 5, gtid, gthreads); }
        GSYNC();
        { GETP unsigned char* ws = P->ws; float* MOD = (float*)(ws + WS_MOD); (void)MOD; pg8::Gemm g{(const bf16*)(ws + WS_A), (const bf16*)(ws + WB_L1_IN) + (size_t)12288 * 2048, 9216, 4608, 2048, A_STRIDE, 16, 16}; pg8::StaticOrder S; S.init(9216, 4608, G, (int)blockIdx.x);
          pg8::EpiZLora E{(bf16*)(ws + WS_ZB), (bf16*)(ws + WS_ZB + ZB_LW), (bf16*)(ws + WS_ZB + ZB_LA)};
          PB_BEGIN(1) pg8::gemm_phase<pg8::EpiZLora, pg8::StaticOrder, true, true>(lds, g, S, E); PB_END(1) }
        GSYNC();
        { PB_BEGIN(3) TID_VARS rwkv_phase(P, lds, hb, tid); PB_END(3) }
        GSYNC();
        { GETP unsigned char* ws = P->ws; float* MOD = (float*)(ws + WS_MOD); (void)MOD; pg8::Gemm g{(const bf16*)(ws + WS_ZB) + (size_t)1024 * 4096, (const bf16*)(ws + WB_L1_OUT), 8192, 2048, 4096, 0, 1, 1 << 30}; pg8::StaticOrder S; S.init(8192, 2048, G, (int)blockIdx.x);
          pg8::EpiResid E{P->out, P->out, nullptr, nullptr, MOD + 9 * 6144, 0, hb * 8192};
          PB_BEGIN(1) pg8::gemm_phase<pg8::EpiResid, pg8::StaticOrder, true, true>(lds, g, S, E); PB_END(1) }
        GSYNC();
    }
    { TID_VARS const float* fg = P->in[36];
      for (int m = gw; m < 16384; m += NGW) { float* xr = P->out + (size_t)m * 2048;
          f32x4 v[8]; float s = 0.f;
#pragma unroll
          for (int j = 0; j < 8; ++j) { v[j] = ((const f32x4*)xr)[lane + 64 * j]; s += (v[j].x * v[j].x + v[j].y * v[j].y) + (v[j].z * v[j].z + v[j].w * v[j].w); }
          const float rstd = 1.0f / sqrtf(wave_sum(s) * (1.0f / 2048.0f) + 1e-6f);
#pragma unroll
          for (int j = 0; j < 8; ++j) ((f32x4*)xr)[lane + 64 * j] = v[j] * rstd * ((const f32x4*)fg)[lane + 64 * j]; } }
#ifdef PROBE_CAT
    { const unsigned long long t1 = __builtin_amdgcn_s_memrealtime(); while (__builtin_amdgcn_s_memrealtime() - t1 < pb_acc) __builtin_amdgcn_s_sleep(8); }
#endif
}

extern "C" void kernel_launch(void* const* d_in, const int* in_sizes, int n_in, void* d_out, int out_size, void* d_ws, size_t ws_size, hipStream_t stream) {
    static int grid = 0;
    if (grid == 0) {
        if (n_in != 37 || ws_size < WS_END) { fprintf(stderr, "kernel_launch: need 37 inputs and >= %zu bytes of workspace; got n_in %d, ws %zu; nothing launched\n", (size_t)WS_END, n_in, ws_size); grid = -1; return; }
        int dev = 0, cus = 0, per_cu = 0;
        if (hipGetDevice(&dev) != hipSuccess || hipDeviceGetAttribute(&cus, hipDeviceAttributeMultiprocessorCount, dev) != hipSuccess) { grid = -1; return; }
        if (hipFuncSetAttribute((const void*)fwd_megakernel, hipFuncAttributeMaxDynamicSharedMemorySize, LDS_BYTES) != hipSuccess) { fprintf(stderr, "kernel_launch: hipFuncSetAttribute failed\n"); grid = -1; return; }
        if (hipOccupancyMaxActiveBlocksPerMultiprocessor(&per_cu, (const void*)fwd_megakernel, NT, LDS_BYTES) != hipSuccess || per_cu < 1) { fprintf(stderr, "kernel_launch: occupancy query says %d\n", per_cu); per_cu = 1; }
        (void)hipGetLastError();
        grid = cus * 1;
    }
    if (grid < 0) return;
    (void)hipMemsetAsync((char*)d_ws + WS_MOD, 0, ZERO_BYTES, stream);
    Params p{};
    for (int i = 0; i < 37; ++i) p.in[i] = (const float*)d_in[i];
    p.out = (float*)d_out; p.ws = (unsigned char*)d_ws;
    void* args[] = {&p};
    hipError_t e = hipLaunchCooperativeKernel((const void*)fwd_megakernel, dim3(grid), dim3(NT), args, LDS_BYTES, stream);
    if (e != hipSuccess) fprintf(stderr, "cooperative launch failed: %s (grid %d)\n", hipGetErrorString(e), grid);
}
```

```cpp
#include <hip/hip_runtime.h>
#include <hip/hip_cooperative_groups.h>
#include <cstdio>
#include <cstdint>
namespace cg = cooperative_groups;
namespace pg8 {
#define PG8_LAS __attribute__((address_space(3)))
typedef unsigned short bf16_t;
typedef short bf16x8 __attribute__((ext_vector_type(8)));
typedef float f32x4 __attribute__((ext_vector_type(4)));
typedef unsigned u32x4 __attribute__((ext_vector_type(4)));
constexpr int BM = 256, BK = 64, HALF = 128, HTB = HALF * BK * 2  , STAGE_BYTES = 8 * HTB, NXCD = 8, WGM = 8;

__host__ __device__ __forceinline__ int lds_byte(int r, int c) { const int st = (r >> 4) * 2 + (c >> 5), rr = r & 15, cc = c & 31, ob = rr * 64 + cc * 2; return st * 1024 + (ob ^ (((ob >> 9) & 1) << 5)); }
__host__ __device__ __forceinline__ void stage_rc(int b, int& R, int& C) { const int st = b / 1024, sb = b % 1024, swz = sb ^ (((sb >> 9) & 1) << 5); R = (st >> 1) * 16 + swz / 64; C = (st & 1) * 32 + (swz % 64) / 2; }
__host__ __device__ __forceinline__ int perm32(int rho) { const int n = rho >> 4, i = rho & 15; return 8 * (i >> 2) + 4 * n + (i & 3); }

struct Unit { int pm, pn; };
struct Gemm { const bf16_t* A; const bf16_t* Bt; int M, N, K; size_t a_stride; int a_div, a_n0; };
#define PG8_AIDX(g, pn) ((size_t)((pn) < (g).a_n0 ? (pn) / (g).a_div : (g).a_n0 / (g).a_div + ((pn) - (g).a_n0)) * (g).a_stride)

struct StaticOrder {
    int nM, nN, nwg, G, c;
    __host__ __device__ void init(int M, int N, int G_, int c_) { nM = M / BM; nN = N / BM; nwg = nM * nN; G = G_; c = c_; }
    __host__ __device__ bool next(int i, Unit& u) const {
        const long L = (long)i * G + c; if (L >= nwg) return false;
        int wgid = (int)L; { const int q = nwg / NXCD, r = nwg % NXCD, xcd = wgid % NXCD, off = wgid / NXCD; wgid = (xcd < r ? xcd * (q + 1) : r * (q + 1) + (xcd - r) * q) + off; }
        const int nig = WGM * nN, gid = wgid / nig, fm = gid * WGM, gsz = (nM - fm) < WGM ? (nM - fm) : WGM;
        u.pm = fm + ((wgid % nig) % gsz); u.pn = (wgid % nig) / gsz; return true;
    }
    __device__ __forceinline__ void a_ready(const Unit&) const {}
    __device__ __forceinline__ void done(const Unit&) const {}
};
typedef float f32x2g __attribute__((ext_vector_type(2))); typedef __bf16 bf16x2g __attribute__((ext_vector_type(2)));
__device__ __forceinline__ unsigned cvt_pk_bf16(float lo, float hi) { const f32x2g v = {lo, hi}; const bf16x2g b = __builtin_convertvector(v, bf16x2g); return __builtin_bit_cast(unsigned, b); }
__device__ __forceinline__ float bflo(unsigned w) { return __builtin_bit_cast(float, w << 16); }
__device__ __forceinline__ float bfhi(unsigned w) { return __builtin_bit_cast(float, w & 0xffff0000u); }
__device__ __forceinline__ float sigm(float x) { return __builtin_amdgcn_rcpf(1.0f + __expf(-x)); }
__device__ __forceinline__ float tanh_f(float x) { const float e = __expf(2.0f * x); return 1.0f - 2.0f * __builtin_amdgcn_rcpf(1.0f + e); }

struct EpiSplitBf16 {
    static constexpr bool PERM = true, AFTER_DRAIN = false;
    bf16_t* O; int ldc; int split_cols; size_t split_stride;
    __device__ __forceinline__ void operator()(const f32x4 (&acc)[2][2][4][2], const Unit& u, int wr, int wc, int fr, int fq) const {
        const int row0 = u.pm * BM + wr * 64 + fr; int colt = u.pn * BM; bf16_t* base = O;
        { const int t = colt / split_cols; base += (size_t)t * split_stride; colt -= t * split_cols; }
        const int col0 = colt + wc * 32 + 8 * fq;
#pragma unroll
        for (int ai = 0; ai < 2; ++ai)
#pragma unroll
            for (int m = 0; m < 4; ++m) { bf16_t* rowp = base + (size_t)(row0 + ai * HALF + m * 16) * ldc + col0;
#pragma unroll
                for (int bj = 0; bj < 2; ++bj) { const f32x4 v0 = acc[ai][bj][m][0], v1 = acc[ai][bj][m][1];
                    u32x4 w; w.x = cvt_pk_bf16(v0[0], v0[1]); w.y = cvt_pk_bf16(v0[2], v0[3]); w.z = cvt_pk_bf16(v1[0], v1[1]); w.w = cvt_pk_bf16(v1[2], v1[3]);
                    *(u32x4*)(rowp + bj * HALF) = w; } }
    }
};

struct EpiGlu {
    static constexpr bool PERM = true, AFTER_DRAIN = false;
    const bf16_t* Y; bf16_t* Z; int ldc; const float* bias;
    __device__ __forceinline__ void operator()(const f32x4 (&acc)[2][2][4][2], const Unit& u, int wr, int wc, int fr, int fq) const {
        const int row0 = u.pm * BM + wr * 64 + fr; const int col0 = u.pn * BM + wc * 32 + 8 * fq;
#pragma unroll
        for (int bj = 0; bj < 2; ++bj) {
            const f32x4 b0 = *(const f32x4*)(bias + col0 + bj * HALF), b1 = *(const f32x4*)(bias + col0 + bj * HALF + 4);
#pragma unroll
            for (int ai = 0; ai < 2; ++ai)
#pragma unroll
                for (int m = 0; m < 4; ++m) {
                    const size_t off = (size_t)(row0 + ai * HALF + m * 16) * ldc + col0 + bj * HALF;
                    const u32x4 yy = *(const u32x4*)(Y + off); const u32x4 zz = *(const u32x4*)(Z + off);
                    const f32x4 t0 = acc[ai][bj][m][0] + b0, t1 = acc[ai][bj][m][1] + b1;
                    float o[8];
#define GLU1(k, yv, zv, tv) { const float y_ = (yv), z_ = (zv); o[k] = (y_ * z_) * __builtin_amdgcn_rcpf((1.0f + __expf(-(tv))) * (1.0f + __expf(-z_))); }
                    GLU1(0, bflo(yy.x), bflo(zz.x), t0[0]) GLU1(1, bfhi(yy.x), bfhi(zz.x), t0[1])
                    GLU1(2, bflo(yy.y), bflo(zz.y), t0[2]) GLU1(3, bfhi(yy.y), bfhi(zz.y), t0[3])
                    GLU1(4, bflo(yy.z), bflo(zz.z), t1[0]) GLU1(5, bfhi(yy.z), bfhi(zz.z), t1[1])
                    GLU1(6, bflo(yy.w), bflo(zz.w), t1[2]) GLU1(7, bfhi(yy.w), bfhi(zz.w), t1[3])
#undef GLU1
                    u32x4 w; w.x = cvt_pk_bf16(o[0], o[1]); w.y = cvt_pk_bf16(o[2], o[3]); w.z = cvt_pk_bf16(o[4], o[5]); w.w = cvt_pk_bf16(o[6], o[7]);
                    *(u32x4*)(Z + off) = w; }
        }
    }
};

struct EpiResid {
    static constexpr bool PERM = false, AFTER_DRAIN = false;
    const float* XIN; float* OUT; const float* CTXIN; float* XC; const float* MOD; int ctx_rows; int lat_row0;
    __device__ __forceinline__ void operator()(const f32x4 (&acc)[2][2][4][2], const Unit& u, int wr, int wc, int fr, int fq) const {
        const int row0 = u.pm * BM + wr * 64 + fr, col0 = u.pn * BM + wc * 32 + 4 * fq;
        const bool isctx = (u.pm * BM) < ctx_rows;
#pragma unroll
        for (int ai = 0; ai < 2; ++ai)
#pragma unroll
            for (int m = 0; m < 4; ++m) {
                const int row = row0 + ai * HALF + m * 16;
                const int rr = isctx ? row : (row - ctx_rows + lat_row0); const int gj = isctx ? 8 : (rr >> 11);
                const float* src = (isctx ? CTXIN : XIN) + (size_t)rr * 2048; float* dst = (isctx ? XC : OUT) + (size_t)rr * 2048; const float* gate = MOD + gj * 6144 + 4096;
#pragma unroll
                for (int bj = 0; bj < 2; ++bj)
#pragma unroll
                    for (int n = 0; n < 2; ++n) { const int c = col0 + bj * HALF + n * 16;
                        const f32x4 g4 = *(const f32x4*)(gate + c); const f32x4 x4 = *(const f32x4*)(src + c);
                        *(f32x4*)(dst + c) = x4 + g4 * acc[ai][bj][m][n]; }
            }
    }
};

struct EpiZLora {
    static constexpr bool PERM = true, AFTER_DRAIN = false;
    bf16_t* Zb; bf16_t* LW; bf16_t* LA;
    __device__ __forceinline__ void operator()(const f32x4 (&acc)[2][2][4][2], const Unit& u, int wr, int wc, int fr, int fq) const {
        const int row0 = u.pm * BM + wr * 64 + fr;
        if (u.pn < 16) {
            if (u.pm < 4) return;
            const int col0 = u.pn * BM + wc * 32 + 8 * fq;
#pragma unroll
            for (int ai = 0; ai < 2; ++ai)
#pragma unroll
                for (int m = 0; m < 4; ++m) { bf16_t* rowp = Zb + (size_t)(row0 + ai * HALF + m * 16) * 4096 + col0;
#pragma unroll
                    for (int bj = 0; bj < 2; ++bj) { const f32x4 v0 = acc[ai][bj][m][0], v1 = acc[ai][bj][m][1];
                        u32x4 w; w.x = cvt_pk_bf16(v0[0], v0[1]); w.y = cvt_pk_bf16(v0[2], v0[3]); w.z = cvt_pk_bf16(v1[0], v1[1]); w.w = cvt_pk_bf16(v1[2], v1[3]);
                        *(u32x4*)(rowp + bj * HALF) = w; } }
        } else {
            const bool isw = (u.pn == 16); bf16_t* base = isw ? LW : LA;
#pragma unroll
            for (int bj = 0; bj < 2; ++bj) {
                const int col = bj * HALF + wc * 32 + 8 * fq;
                if (col < 192) {
#pragma unroll
                    for (int ai = 0; ai < 2; ++ai)
#pragma unroll
                        for (int m = 0; m < 4; ++m) { f32x4 v0 = acc[ai][bj][m][0], v1 = acc[ai][bj][m][1];
                            if (isw) { v0[0] = tanh_f(v0[0]); v0[1] = tanh_f(v0[1]); v0[2] = tanh_f(v0[2]); v0[3] = tanh_f(v0[3]); v1[0] = tanh_f(v1[0]); v1[1] = tanh_f(v1[1]); v1[2] = tanh_f(v1[2]); v1[3] = tanh_f(v1[3]); }
                            u32x4 w; w.x = cvt_pk_bf16(v0[0], v0[1]); w.y = cvt_pk_bf16(v0[2], v0[3]); w.z = cvt_pk_bf16(v1[0], v1[1]); w.w = cvt_pk_bf16(v1[2], v1[3]);
                            *(u32x4*)(base + (size_t)(row0 + ai * HALF + m * 16) * 192 + col) = w; }
                }
            }
        }
    }
};
template <class Epi, class Sched, bool ALIGN_EPI = false, bool SP2 = false>
__device__ __forceinline__ void gemm_phase(PG8_LAS unsigned char* lds, const Gemm g, const Sched& S, const Epi& E) {
    int tid_l = threadIdx.x; asm volatile("" : "+v"(tid_l));
    const int tid = tid_l, wid = __builtin_amdgcn_readfirstlane(tid >> 6), lane = tid & 63, wr = wid >> 2, wc = wid & 3, fr = lane & 15, fq = lane >> 4;
    const int K = g.K, nt = K / BK;
    unsigned voffA[2], voffB[2];
#pragma unroll
    for (int i = 0; i < 2; ++i) { int R, C; stage_rc(tid * 16 + i * 8192, R, C); const int Rb = Epi::PERM ? ((R & ~31) + perm32(R & 31)) : R;
        voffA[i] = (unsigned)(R * K + C) * 2u; voffB[i] = (unsigned)(Rb * K + C) * 2u; }
    const size_t kstep = (size_t)(BK * 2);
    const size_t hstep = (size_t)HALF * K * 2;
    const size_t tstep = 2 * hstep;
    const unsigned ldsw = (unsigned)wid * 1024u;
    const int aoff = lds_byte(wr * 64 + fr, fq * 8), boff = lds_byte(wc * 32 + fr, fq * 8);
#define PG8_SA(b, h) (((b) * 2 + (h)) * HTB)
#define PG8_SB(b, h) ((4 + (b) * 2 + (h)) * HTB)
#define PG8_STAGE(bufoff, gbase, voff) do { _Pragma("unroll") for (int _i = 0; _i < 2; ++_i) \
        __builtin_amdgcn_global_load_lds((const unsigned*)((const char*)(gbase) + (voff)[_i]), (PG8_LAS unsigned*)(lds + (bufoff) + ldsw + _i * 8192), 16, 0, 0); } while (0)
#define PG8_LDA(dst, b, h) do { _Pragma("unroll") for (int m = 0; m < 4; ++m) _Pragma("unroll") for (int k = 0; k < 2; ++k) dst[m][k] = *(const PG8_LAS bf16x8*)(lds + PG8_SA(b, h) + aoff + m * 2048 + k * 1024); } while (0)
#define PG8_LDB(dst, b, h) do { _Pragma("unroll") for (int n = 0; n < 2; ++n) _Pragma("unroll") for (int k = 0; k < 2; ++k) dst[n][k] = *(const PG8_LAS bf16x8*)(lds + PG8_SB(b, h) + boff + n * 2048 + k * 1024); } while (0)
#define PG8_MMA(ai, bj, At, Bt) do { __builtin_amdgcn_s_setprio(1); _Pragma("unroll") for (int m = 0; m < 4; ++m) _Pragma("unroll") for (int n = 0; n < 2; ++n) _Pragma("unroll") for (int k = 0; k < 2; ++k) \
        acc[ai][bj][m][n] = __builtin_amdgcn_mfma_f32_16x16x32_bf16(Bt[n][k], At[m][k], acc[ai][bj][m][n], 0, 0, 0); __builtin_amdgcn_s_setprio(0); } while (0)
#define PG8_WAIT_V(n) asm volatile("s_waitcnt vmcnt(" #n ")" ::: "memory")
#define PG8_WAIT_L(n) asm volatile("s_waitcnt lgkmcnt(" #n ")" ::: "memory")
#define PG8_BAR __builtin_amdgcn_s_barrier()
#define PG8_SCHED __builtin_amdgcn_sched_barrier(0)
    Unit cur, nxt; int ui = 0;
    if (!S.next(0, cur)) return;
    f32x4 acc[2][2][4][2];
#pragma unroll
    for (int a = 0; a < 2; ++a)
#pragma unroll
        for (int b = 0; b < 2; ++b)
#pragma unroll
            for (int m = 0; m < 4; ++m)
#pragma unroll
                for (int n = 0; n < 2; ++n) acc[a][b][m][n] = (f32x4){0.f, 0.f, 0.f, 0.f};
    bf16x8 At[4][2], B0[2][2], B1[2][2];
    const char* cA = (const char*)g.A + PG8_AIDX(g, cur.pn) + (size_t)cur.pm * tstep; const char* cB = (const char*)g.Bt + (size_t)cur.pn * tstep;
    S.a_ready(cur);
    if constexpr (SP2) {
        PG8_STAGE(PG8_SB(0, 0), cB, voffB); PG8_STAGE(PG8_SB(0, 1), cB + hstep, voffB); PG8_STAGE(PG8_SA(0, 0), cA, voffA); PG8_STAGE(PG8_SA(0, 1), cA + hstep, voffA);
        if (wr == 1) PG8_BAR;
        PG8_WAIT_V(2); PG8_BAR;
        PG8_STAGE(PG8_SB(1, 0), cB + kstep, voffB); PG8_STAGE(PG8_SA(1, 0), cA + kstep, voffA); PG8_STAGE(PG8_SB(1, 1), cB + hstep + kstep, voffB);
        PG8_WAIT_V(6); PG8_BAR;
    } else {
        PG8_STAGE(PG8_SB(0, 0), cB, voffB); PG8_STAGE(PG8_SA(0, 0), cA, voffA); PG8_STAGE(PG8_SB(0, 1), cB + hstep, voffB); PG8_STAGE(PG8_SA(0, 1), cA + hstep, voffA);
        if (wr == 1) PG8_BAR;
        PG8_WAIT_V(4); PG8_BAR;
        PG8_STAGE(PG8_SB(1, 0), cB + kstep, voffB); PG8_STAGE(PG8_SA(1, 0), cA + kstep, voffA); PG8_STAGE(PG8_SB(1, 1), cB + hstep + kstep, voffB);
        PG8_WAIT_V(6); PG8_BAR;
    }
    for (;;) {
        const bool has_next = S.next(ui + 1, nxt);
        const char* nA = has_next ? (const char*)g.A + PG8_AIDX(g, nxt.pn) + (size_t)nxt.pm * tstep : cA; const char* nB = has_next ? (const char*)g.Bt + (size_t)nxt.pn * tstep : cB;
        for (int t = 0; t < nt; t += 2) {
            const bool last = (t == nt - 2);
            const char* a1 = cA + (size_t)(t + 1) * kstep;
            const char* a2 = last ? nA : cA + (size_t)(t + 2) * kstep; const char* b2 = last ? nB : cB + (size_t)(t + 2) * kstep;
            const char* a3 = a2 + kstep; const char* b3 = b2 + kstep;
            if (last && has_next) S.a_ready(nxt);
            if constexpr (SP2) {
            PG8_LDB(B0, 0, 0); PG8_LDB(B1, 0, 1); PG8_SCHED; PG8_LDA(At, 0, 0); PG8_STAGE(PG8_SA(1, 1), a1 + hstep, voffA);
            PG8_WAIT_V(8); PG8_WAIT_L(0); PG8_BAR; PG8_MMA(0, 0, At, B0); PG8_MMA(0, 1, At, B1); PG8_BAR; PG8_SCHED;
            PG8_LDA(At, 0, 1); PG8_STAGE(PG8_SB(0, 0), b2, voffB); PG8_STAGE(PG8_SB(0, 1), b2 + hstep, voffB); PG8_STAGE(PG8_SA(0, 0), a2, voffA);
            PG8_WAIT_V(8); PG8_WAIT_L(0); PG8_BAR; PG8_MMA(1, 0, At, B0); PG8_MMA(1, 1, At, B1); PG8_BAR; PG8_SCHED;
            PG8_LDB(B0, 1, 0); PG8_LDB(B1, 1, 1); PG8_SCHED; PG8_LDA(At, 1, 0); PG8_STAGE(PG8_SA(0, 1), a2 + hstep, voffA);
            PG8_WAIT_V(8); PG8_WAIT_L(0); PG8_BAR; PG8_MMA(0, 0, At, B0); PG8_MMA(0, 1, At, B1); PG8_BAR; PG8_SCHED;
            PG8_LDA(At, 1, 1); PG8_STAGE(PG8_SB(1, 0), b3, voffB); PG8_STAGE(PG8_SB(1, 1), b3 + hstep, voffB); PG8_STAGE(PG8_SA(1, 0), a3, voffA);
            PG8_WAIT_V(8); PG8_WAIT_L(0); PG8_BAR; PG8_MMA(1, 0, At, B0); PG8_MMA(1, 1, At, B1); PG8_BAR; PG8_SCHED;
            } else {
            PG8_LDB(B0, 0, 0); PG8_SCHED; PG8_LDA(At, 0, 0); PG8_STAGE(PG8_SA(1, 1), a1 + hstep, voffA);
            PG8_WAIT_L(8); PG8_BAR; PG8_WAIT_L(0); PG8_MMA(0, 0, At, B0); PG8_BAR; PG8_SCHED;
            PG8_LDB(B1, 0, 1); PG8_STAGE(PG8_SB(0, 0), b2, voffB);
            PG8_BAR; PG8_WAIT_L(0); PG8_MMA(0, 1, At, B1); PG8_BAR;
            PG8_LDA(At, 0, 1); PG8_STAGE(PG8_SA(0, 0), a2, voffA);
            PG8_BAR; PG8_WAIT_L(0); PG8_MMA(1, 0, At, B0); PG8_BAR; PG8_SCHED;
            PG8_STAGE(PG8_SB(0, 1), b2 + hstep, voffB);
            PG8_WAIT_V(6); PG8_BAR; PG8_MMA(1, 1, At, B1); PG8_BAR;
            PG8_LDB(B0, 1, 0); PG8_SCHED; PG8_LDA(At, 1, 0); PG8_STAGE(PG8_SA(0, 1), a2 + hstep, voffA);
            PG8_WAIT_L(8); PG8_BAR; PG8_WAIT_L(0); PG8_MMA(0, 0, At, B0); PG8_BAR; PG8_SCHED;
            PG8_LDB(B1, 1, 1); PG8_STAGE(PG8_SB(1, 0), b3, voffB);
            PG8_BAR; PG8_WAIT_L(0); PG8_MMA(0, 1, At, B1); PG8_BAR;
            PG8_LDA(At, 1, 1); PG8_STAGE(PG8_SA(1, 0), a3, voffA);
            PG8_BAR; PG8_WAIT_L(0); PG8_MMA(1, 0, At, B0); PG8_BAR; PG8_SCHED;
            PG8_STAGE(PG8_SB(1, 1), b3 + hstep, voffB);
            PG8_WAIT_V(6); PG8_BAR; PG8_MMA(1, 1, At, B1); PG8_BAR;
            }
        }
        if constexpr (ALIGN_EPI) { if (wr == 0) PG8_BAR; }
        if constexpr (!Epi::AFTER_DRAIN) { E(acc, cur, wr, wc, fr, fq); S.done(cur); }
        if (!has_next) break;
#pragma unroll
        for (int a = 0; a < 2; ++a)
#pragma unroll
            for (int b = 0; b < 2; ++b)
#pragma unroll
                for (int m = 0; m < 4; ++m)
#pragma unroll
                    for (int n = 0; n < 2; ++n) acc[a][b][m][n] = (f32x4){0.f, 0.f, 0.f, 0.f};
        cur = nxt; cA = nA; cB = nB; ++ui;
        if constexpr (ALIGN_EPI) { if (wr == 1) PG8_BAR; }
    }
    PG8_WAIT_V(0);
    if constexpr (!ALIGN_EPI) { if (wr == 0) PG8_BAR; }
    PG8_BAR;
    if constexpr (Epi::AFTER_DRAIN) { E.fused(acc, cur, wr, wc, fr, fq, lds, wid, lane); S.done(cur); }
#undef PG8_SA
#undef PG8_SB
#undef PG8_STAGE
#undef PG8_LDA
#undef PG8_LDB
#undef PG8_MMA
#undef PG8_WAIT_V
#undef PG8_WAIT_L
#undef PG8_BAR
#undef PG8_SCHED
}
}

#define LAS __attribute__((address_space(3)))
typedef unsigned short bf16;
typedef short bf16x8 __attribute__((ext_vector_type(8)));
typedef float f32x4 __attribute__((ext_vector_type(4)));
typedef float f32x16 __attribute__((ext_vector_type(16)));
typedef unsigned u32x4 __attribute__((ext_vector_type(4)));
typedef unsigned u32x2 __attribute__((ext_vector_type(2)));

constexpr int NT = 512;
constexpr int LDS_BYTES = 147456;
constexpr size_t MiB = 1u << 20;
constexpr size_t WS_MOD = 0;
constexpr size_t MOD_BYTES = 2 * 9 * 6144 * 4;
constexpr size_t WS_BAR = 448 * 1024;
constexpr size_t ZERO_BYTES = WS_BAR + 3456 * 4;
constexpr int LDS_BARST = LDS_BYTES - 64;
constexpr size_t WS_QP = 1 * MiB;
constexpr size_t WS_W2T = 3 * MiB;
constexpr size_t WS_A2T = WS_W2T + 2 * 4096 * 96 * 2;
constexpr size_t WS_XC = 6 * MiB;
constexpr size_t WS_WB = 22 * MiB;
constexpr size_t WB_L0_IN = WS_WB, WB_L0_GLU = WS_WB + 32 * MiB, WB_L0_OUT = WS_WB + 64 * MiB;
constexpr size_t WB_L1_IN = WS_WB, WB_L1_OUT = WS_WB + 66 * MiB;
constexpr size_t WS_BIG = 106 * MiB;
constexpr size_t WS_U = WS_BIG, WS_Z = WS_BIG + 144 * MiB, WS_Y = WS_BIG + 288 * MiB;
constexpr size_t WS_H1 = WS_BIG, WS_A = WS_BIG + 36 * MiB, WS_RKV = WS_BIG + 144 * MiB, WS_ZB = WS_BIG + 360 * MiB;
constexpr size_t WS_END = WS_BIG + 432 * MiB;
constexpr size_t A_STRIDE = (size_t)9216 * 2048 * 2;
constexpr size_t WS_YP = WS_A;
constexpr size_t ZB_LW = 0, ZB_LA = (size_t)9216 * 192 * 2;

struct Params { const float* in[37]; float* out; unsigned char* ws; };
typedef const __attribute__((address_space(4))) Params* PPtr;
#define GETP PPtr P = (PPtr)__builtin_amdgcn_kernarg_segment_ptr(); asm volatile("" : "+s"(P));

typedef float f32x2c __attribute__((ext_vector_type(2)));
typedef __bf16 bf16x2c __attribute__((ext_vector_type(2)));
__device__ __forceinline__ unsigned pk2(float lo, float hi) { const f32x2c v = {lo, hi}; const bf16x2c b = __builtin_convertvector(v, bf16x2c); return __builtin_bit_cast(unsigned, b); }
__device__ __forceinline__ unsigned f2bf(float f) { const __bf16 b = (__bf16)f; return (unsigned)__builtin_bit_cast(unsigned short, b); }
__device__ __forceinline__ unsigned f2bf_lo16(float f) { return f2bf(f); }
__device__ __forceinline__ float bf2f(unsigned h) { return __builtin_bit_cast(float, h << 16); }
__device__ __forceinline__ float blo(unsigned w) { return __builtin_bit_cast(float, w << 16); }
__device__ __forceinline__ float bhi(unsigned w) { return __builtin_bit_cast(float, w & 0xffff0000u); }
__device__ __forceinline__ float wave_sum(float v) {
#pragma unroll
    for (int o = 1; o < 64; o <<= 1) v += __shfl_xor(v, o);
    return v;
}
#define DPPF(v, ctrl) __builtin_bit_cast(float, __builtin_amdgcn_update_dpp(0, __builtin_bit_cast(int, (v)), (ctrl), 0xF, 0xF, true))
__device__ __forceinline__ float red8(float v) { v += DPPF(v, 0xB1); v += DPPF(v, 0x4E); v += DPPF(v, 0x141); return v; }
__device__ __forceinline__ float red16(float v) { v = red8(v); v += DPPF(v, 0x128); return v; }
__device__ __forceinline__ float sigmoidf_(float x) { return __builtin_amdgcn_rcpf(1.0f + __expf(-x)); }

#define XB_TMO      128
#define XB_XCNT(j)  (256  + 64 * (j))
#define XB_XSUB(j)  (1280 + 64 * (j))
#define XB_XGEN(j)  (2304 + 64 * (j))
#define XB_TOP      3328
#define XB_TOPGEN   3392
#define XCD_BAR_WORDS 3456
#define XB_SPIN_CAP (1u << 18)

__device__ __forceinline__ unsigned xb_ld(unsigned* p)              { return __hip_atomic_load(p, __ATOMIC_RELAXED, __HIP_MEMORY_SCOPE_AGENT); }
__device__ __forceinline__ unsigned xb_add(unsigned* p, unsigned v) { return __hip_atomic_fetch_add(p, v, __ATOMIC_RELAXED, __HIP_MEMORY_SCOPE_AGENT); }
__device__ __forceinline__ unsigned xb_xcc_id() { return (unsigned)__builtin_amdgcn_s_getreg((3 << 11) | 20) & 0xFu; }
#define XB_SPIN(cond, bar) do { unsigned _sp = 0; while (cond) { __builtin_amdgcn_s_sleep(1); \
    if ((++_sp & 255u) == 0u) { if (xb_ld(&(bar)[XB_TMO])) break; if (_sp > XB_SPIN_CAP) { atomicAdd(&(bar)[XB_TMO], 1u); break; } } } } while (0)

struct XcdBarrier {
    unsigned* bar; unsigned x;
    volatile LAS unsigned* st;
};

__device__ __forceinline__ XcdBarrier xcd_barrier_post(unsigned* bar, volatile LAS unsigned* st) {
    XcdBarrier b; b.bar = bar; b.x = xb_xcc_id(); b.st = st;
    if (threadIdx.x == 0) (void)xb_add(&bar[XB_XCNT(b.x)], 1u);
    return b;
}
__device__ __forceinline__ void xcd_barrier_complete(unsigned* bar, unsigned x, unsigned& nloc, unsigned& nx) {
    const unsigned G = gridDim.x * gridDim.y * gridDim.z;
    unsigned sum, cnt, mine, sp = 0u;
    for (;;) {
        sum = 0u; cnt = 0u; mine = 0u;
#pragma unroll
        for (unsigned j = 0; j < 16; ++j) { const unsigned c = xb_ld(&bar[XB_XCNT(j)]); sum += c; cnt += (c > 0u) ? 1u : 0u; mine = (j == x) ? c : mine; }
        if (sum == G) break;
        __builtin_amdgcn_s_sleep(1);
        if ((++sp & 255u) == 0u) { if (xb_ld(&bar[XB_TMO])) break; if (sp > XB_SPIN_CAP) { atomicAdd(&bar[XB_TMO], 1u); break; } }
    }
    nloc = mine > 0u ? mine : 1u; nx = cnt > 0u ? cnt : 1u;
}

__device__ __forceinline__ void xcd_barrier(const XcdBarrier& b) {
    asm volatile("s_waitcnt vmcnt(0)" ::: "memory");
    __syncthreads();
    if (threadIdx.x == 0) {
        unsigned* bar = b.bar;
        __builtin_amdgcn_s_waitcnt(0);
        unsigned nloc = b.st[0], nx = b.st[1];
        if (nloc == 0u) { xcd_barrier_complete(bar, b.x, nloc, nx); b.st[0] = nloc; b.st[1] = nx; }
        const unsigned old = xb_add(&bar[XB_XSUB(b.x)], 1u);
        const unsigned gen = old / nloc;
        if (old + 1u == (gen + 1u) * nloc) {
            __builtin_amdgcn_fence(__ATOMIC_RELEASE, "agent");
            asm volatile("s_waitcnt vmcnt(0)" ::: "memory");
            const unsigned og = xb_add(&bar[XB_TOP], 1u);
            const unsigned tg = og / nx;
            if (og + 1u == (tg + 1u) * nx) xb_add(&bar[XB_TOPGEN], 1u);
            else XB_SPIN(xb_ld(&bar[XB_TOPGEN]) == tg, bar);
            __builtin_amdgcn_fence(__ATOMIC_ACQUIRE, "agent");
            xb_add(&bar[XB_XGEN(b.x)], 1u);
            asm volatile("s_waitcnt vmcnt(0)" ::: "memory");
        } else {
            XB_SPIN(xb_ld(&bar[XB_XGEN(b.x)]) == gen, bar);
            __builtin_amdgcn_fence(__ATOMIC_ACQUIRE, "agent");
            asm volatile("s_waitcnt vmcnt(0)" ::: "memory");
        }
    }
    __syncthreads();
}

__device__ __forceinline__ void transpose_item(const float* W, int K, int N, bf16* WT, int row_off, LAS float* scr, int item, int lane) {
    const int nblk = N / 32, kb = item / nblk, nb = item % nblk, k0 = 64 * kb, n0 = 32 * nb;
    float tv[32];
#pragma unroll
    for (int i = 0; i < 32; ++i) { const int kk = 2 * i + (lane >> 5); tv[i] = W[(size_t)(k0 + kk) * N + n0 + (lane & 31)]; }
#pragma unroll
    for (int i = 0; i < 32; ++i) { const int kk = 2 * i + (lane >> 5); scr[kk * 33 + (lane & 31)] = tv[i]; }
    asm volatile("s_waitcnt lgkmcnt(0)" ::: "memory");
    const int c = lane & 7;
#pragma unroll
    for (int j = 0; j < 4; ++j) { const int n = (lane >> 3) + 8 * j; const LAS float* s = scr + (8 * c) * 33 + n;
        u32x4 o; o.x = pk2(s[0 * 33], s[1 * 33]); o.y = pk2(s[2 * 33], s[3 * 33]); o.z = pk2(s[4 * 33], s[5 * 33]); o.w = pk2(s[6 * 33], s[7 * 33]);
        *(u32x4*)(WT + (size_t)(row_off + n0 + n) * K + k0 + 8 * c) = o; }
    asm volatile("s_waitcnt lgkmcnt(0)" ::: "memory");
}

__device__ __forceinline__ void mod_task(PPtr P, float* MOD, LAS float* sil, int tk, int tid) {
    const int layer = tk / 384, rem = tk % 384, ks = rem / 12, nb = rem % 12;
    const float* ada_w = P->in[layer ? 20 : 5]; const float* ada_b = P->in[layer ? 21 : 6];
    const float* c = P->in[1]; const float* cc = P->in[3];
    const int k0 = ks * 64, n = nb * 512 + tid;
    __syncthreads();
    for (int idx = tid; idx < 64 * 9; idx += NT) { const int k = idx / 9, j = idx % 9; const float v = (j < 8) ? c[j * 2048 + k0 + k] : cc[k0 + k]; sil[idx] = v * sigmoidf_(v); }
    __syncthreads();
    float acc[9];
#pragma unroll
    for (int j = 0; j < 9; ++j) acc[j] = 0.f;
#pragma unroll 1
    for (int kb = 0; kb < 64; kb += 16) { float w[16];
#pragma unroll
        for (int k = 0; k < 16; ++k) w[k] = ada_w[(size_t)(k0 + kb + k) * 6144 + n];
#pragma unroll
        for (int k = 0; k < 16; ++k)
#pragma unroll
            for (int j = 0; j < 9; ++j) acc[j] += sil[(kb + k) * 9 + j] * w[k]; }
    const float bb = (ks == 0) ? ada_b[n] : 0.f;
#pragma unroll
    for (int j = 0; j < 9; ++j) atomicAdd(MOD + (size_t)(layer * 9 + j) * 6144 + n, acc[j] + bb);
}

__device__ __forceinline__ void normmod_row(const float* xrow, const float* g, const float* mod  , bf16* orow, int lane) {
    f32x4 v[8]; float s = 0.f;
#pragma unroll
    for (int j = 0; j < 8; ++j) { v[j] = ((const f32x4*)xrow)[lane + 64 * j]; s += (v[j].x * v[j].x + v[j].y * v[j].y) + (v[j].z * v[j].z + v[j].w * v[j].w); }
    const float rstd = 1.0f / sqrtf(wave_sum(s) * (1.0f / 2048.0f) + 1e-6f);
#pragma unroll
    for (int j = 0; j < 8; ++j) { const int c4 = lane + 64 * j; const f32x4 gg = ((const f32x4*)g)[c4], sh = ((const f32x4*)mod)[c4], sc = ((const f32x4*)(mod + 2048))[c4];
        const f32x4 y = v[j] * rstd * gg * (sc + 1.0f) + sh;
        u32x2 o; o.x = pk2(y.x, y.y); o.y = pk2(y.z, y.w); ((u32x2*)orow)[c4] = o; }
}

constexpr int S5_ROWB = 528;
constexpr int S5_WLDS = 32 * S5_ROWB;
__device__ __forceinline__ float gelu_tanh(float x) { const float u = 0.7978845608028654f * (x + 0.044715f * x * x * x); const float e = __expf(2.0f * u); return x * (1.0f - __builtin_amdgcn_rcpf(1.0f + e)); }

__device__ __forceinline__ void s5_phase(PPtr P, LAS unsigned char* lds, int wave, int lane) {
    const float* a_re = P->in[8]; const float* a_im = P->in[9]; const float* lstep = P->in[10];
    const float* b_re = P->in[11]; const float* b_im = P->in[12]; const float* c_re = P->in[13]; const float* c_im = P->in[14]; const float* dskip = P->in[15];
    const bf16* U = (const bf16*)(P->ws + WS_U); bf16* Y = (bf16*)(P->ws + WS_Y);
    LAS unsigned char* wl = lds + wave * S5_WLDS;
    const int d = wave >> 2;
    for (int round = blockIdx.x; round < 512; round += gridDim.x) {
        const int unit = round * 4 + (wave & 3), b = unit >> 8, g = unit & 255, dg = d * 256 + g;
        const float dt = expf(lstep[dg]);
        float abr, abi;
        { const float are = a_re[dg * 64 + lane], aim = a_im[dg * 64 + lane]; const float mag = expf(dt * are); abr = mag * cosf(dt * aim); abi = mag * sinf(dt * aim); }
        bf16x8 Bf[4];
#pragma unroll
        for (int nn = 0; nn < 2; ++nn) {
            const int n = (lane & 31) + 32 * nn; const float are = a_re[dg * 64 + n], aim = a_im[dg * 64 + n];
            const float mag = expf(dt * are), cr = mag * cosf(dt * aim), ci = mag * sinf(dt * aim), den = are * are + aim * aim, nr = cr - 1.0f, ni = ci;
            const float fre = (nr * are + ni * aim) / den, fim = (ni * are - nr * aim) / den;
            const float* br = b_re + ((size_t)dg * 64 + n) * 16 + 8 * (lane >> 5); const float* bi = b_im + ((size_t)dg * 64 + n) * 16 + 8 * (lane >> 5);
#pragma unroll
            for (int j = 0; j < 8; ++j) { const float xr = br[j], xi = bi[j]; Bf[nn][j] = (short)f2bf(fre * xr - fim * xi); Bf[2 + nn][j] = (short)f2bf(fre * xi + fim * xr); }
        }
        bf16x8 Cf[4];
#pragma unroll
        for (int ks = 0; ks < 4; ++ks) { const int k = 32 * ks + 8 * (lane >> 4); const int o = lane & 15;
            const float* cr = c_re + ((size_t)dg * 16 + o) * 64 + (k >> 1); const float* cim = c_im + ((size_t)dg * 16 + o) * 64 + (k >> 1);
#pragma unroll
            for (int j = 0; j < 8; ++j) Cf[ks][j] = (short)f2bf((j & 1) ? -cim[j >> 1] : cr[j >> 1]); }
        const f32x4 dska = *(const f32x4*)(dskip + g * 16 + (lane & 1) * 8), dskb = *(const f32x4*)(dskip + g * 16 + (lane & 1) * 8 + 4);
        float hr = 0.f, hi = 0.f;
#define S5CH(cs_) const bool isctx = (cs_) < 8; const int ci = isctx ? (cs_) : (cs_) - 8, nch = isctx ? 8 : 64; const int tc = d ? (nch - 1 - ci) : ci; \
        const size_t rowbase = isctx ? (size_t)b * 256 : (size_t)2048 + (size_t)b * 2048;
#define S5AF(dst, cs_) { S5CH(cs_) (void)ci; const int i_ = lane & 31; const int t_ = 32 * tc + (d ? 31 - i_ : i_); dst = *(const bf16x8*)(U + (rowbase + t_) * 4096 + g * 16 + 8 * (lane >> 5)); }
        bf16x8 Anext; { const int c0 = 0; S5AF(Anext, c0) }
        for (int cs = 0; cs < 72; ++cs) {
            S5CH(cs) const bool first = ci < (nch >> 1);
            const bf16x8 Af = Anext;
            if (cs + 1 < 72) { const int c1 = cs + 1; S5AF(Anext, c1) }
            const int oi = lane >> 1, oh = lane & 1; const int ot = 32 * tc + (d ? 31 - oi : oi);
            const size_t opos = (rowbase + ot) * 4096 + g * 16 + oh * 8;
            u32x4 pyv = {0u, 0u, 0u, 0u}, puv = {0u, 0u, 0u, 0u};
            if (!first) { pyv = *(const u32x4*)(Y + opos); puv = *(const u32x4*)(U + opos); }
            { f32x16 z16; for (int q = 0; q < 16; ++q) z16[q] = 0.f;
#pragma unroll
              for (int nh = 0; nh < 2; ++nh) {
                  const f32x16 rr = __builtin_amdgcn_mfma_f32_32x32x16_bf16(Af, Bf[nh], z16, 0, 0, 0), ri = __builtin_amdgcn_mfma_f32_32x32x16_bf16(Af, Bf[2 + nh], z16, 0, 0, 0);
#pragma unroll
                  for (int reg = 0; reg < 16; ++reg) { const int ii = (reg & 3) + 8 * (reg >> 2) + 4 * (lane >> 5);
                      *(LAS f32x2c*)(wl + ii * S5_ROWB + ((lane & 31) + 32 * nh) * 8) = (f32x2c){rr[reg], ri[reg]}; } } }
#pragma unroll 8
            for (int i = 0; i < 32; ++i) { const f32x2c bu = *(LAS f32x2c*)(wl + i * S5_ROWB + lane * 8);
                const float nhr = abr * hr - abi * hi + bu.x, nhi = abr * hi + abi * hr + bu.y; hr = nhr; hi = nhi;
                *(LAS unsigned*)(wl + i * S5_ROWB + lane * 4) = pk2(hr, hi); }
#pragma unroll
            for (int mt = 0; mt < 2; ++mt) { f32x4 yv = {0.f, 0.f, 0.f, 0.f};
#pragma unroll
                for (int ks = 0; ks < 4; ++ks) { const bf16x8 Hf = *(const LAS bf16x8*)(wl + (16 * mt + (lane & 15)) * S5_ROWB + (32 * ks + 8 * (lane >> 4)) * 2);
                    yv = __builtin_amdgcn_mfma_f32_16x16x32_bf16(Hf, Cf[ks], yv, 0, 0, 0); }
#pragma unroll
                for (int reg = 0; reg < 4; ++reg) *(LAS float*)(wl + (16 * mt + 4 * (lane >> 4) + reg) * S5_ROWB + 256 + (lane & 15) * 4) = yv[reg]; }
            asm volatile("" ::: "memory");
            { const f32x4 ya = *(LAS f32x4*)(wl + oi * S5_ROWB + 256 + oh * 32), yb = *(LAS f32x4*)(wl + oi * S5_ROWB + 256 + oh * 32 + 16);
              u32x4 o;
              if (first) { o = (u32x4){pk2(ya.x, ya.y), pk2(ya.z, ya.w), pk2(yb.x, yb.y), pk2(yb.z, yb.w)}; }
              else {
#define S5G(yv_, pw_, uw_, dk_, hi_) gelu_tanh((yv_) + ((hi_) ? bhi(pw_) : blo(pw_)) + (dk_) * ((hi_) ? bhi(uw_) : blo(uw_)))
                  o.x = pk2(S5G(ya.x, pyv.x, puv.x, dska.x, 0), S5G(ya.y, pyv.x, puv.x, dska.y, 1)); o.y = pk2(S5G(ya.z, pyv.y, puv.y, dska.z, 0), S5G(ya.w, pyv.y, puv.y, dska.w, 1));
                  o.z = pk2(S5G(yb.x, pyv.z, puv.z, dskb.x, 0), S5G(yb.y, pyv.z, puv.z, dskb.y, 1)); o.w = pk2(S5G(yb.z, pyv.w, puv.w, dskb.z, 0), S5G(yb.w, pyv.w, puv.w, dskb.w, 1));
#undef S5G
              }
              *(u32x4*)(Y + opos) = o; }
            asm volatile("" ::: "memory");
            if (ci == (nch >> 1) - 1) __syncthreads();
        }
        __syncthreads();
#undef S5CH
#undef S5AF
    }
}

typedef float f32x2 __attribute__((ext_vector_type(2)));
constexpr int RW_ARR = 16 * 64 * 4;
constexpr int RO_TT = 0, RO_WD = 8704, RO_PA = 21760, RO_Q = 62720, RO_AR = 63232, RO_BK = 77056, RO_BKT = 86272, RO_WL = 103168, RO_VB = 103936, RO_G = 112640, RO_ZT = 117248, RO_MM = 120064, RO_PW = 122880, RO_Y = 133120, RO_CST = 141824, RW_END = 143104;
constexpr int T_ROW = 88, BKT_SLOT = 64 * T_ROW, ZT_SLOT = 16 * T_ROW;
constexpr int W_ROW = 68, W_SLOT = 16 * W_ROW * 4;
constexpr int VB_ROW = 136, VB_SLOT = 16 * VB_ROW, Y_ROW = 68, Y_SLOT = 16 * Y_ROW * 4;
static_assert(RW_END <= LDS_BYTES - 64, "rwkv LDS map");
__device__ __forceinline__ void rwkv_phase(PPtr P, LAS unsigned char* lds, int hb, int tid) {
    const float* w0 = P->in[24]; const float* a0 = P->in[27]; const float* k_k = P->in[30]; const float* k_a = P->in[31]; const float* r_k = P->in[32];
    const float* ln_w = P->in[33]; const float* ln_b = P->in[34];
    const bf16* RB = (const bf16*)(P->ws + WS_RKV); const bf16* KB = RB + (size_t)9216 * 4096; const bf16* VB = KB + (size_t)9216 * 4096;
    bf16* ZB = (bf16*)(P->ws + WS_ZB); const bf16* LW = (const bf16*)(P->ws + WS_ZB + ZB_LW); const bf16* LA = (const bf16*)(P->ws + WS_ZB + ZB_LA);
    const bf16* W2T = (const bf16*)(P->ws + WS_W2T); const bf16* A2T = (const bf16*)(P->ws + WS_A2T);
    bf16* YP = (bf16*)(P->ws + WS_YP); float* QP = (float*)(P->ws + WS_QP);
    const int wid = __builtin_amdgcn_readfirstlane(tid >> 6), lane0 = tid & 63;
#define LANEVARS int lnv = lane0; asm volatile("" : "+v"(lnv)); const int lane = lnv, fr = lane & 15, fq = lane >> 4; (void)fr; (void)fq;
#define BAR_LDS() do { asm volatile("s_waitcnt lgkmcnt(0)" ::: "memory"); __builtin_amdgcn_s_barrier(); asm volatile("" ::: "memory"); } while (0)
#define STH(p, v) (*(LAS unsigned short*)(p) = (unsigned short)f2bf_lo16(v))
#define CHUNK(c_, tc_, rb_) const bool ic_##c_ = (c_) < 16; const int ci_##c_ = ic_##c_ ? (c_) : (c_) - 16, nch_##c_ = ic_##c_ ? 16 : 128; \
        const int tc_ = d ? (nch_##c_ - 1 - ci_##c_) : ci_##c_; const size_t rb_ = ic_##c_ ? (size_t)bl * 256 : (size_t)1024 + (size_t)bl * 2048;
#define CST(a_, nq_) (*(LAS f32x4*)((LAS float*)(lds + RO_CST) + (a_) * 64 + 4 * (nq_)))
    for (int pr = blockIdx.x; pr < 256; pr += gridDim.x) {
        const int bl = pr >> 6, h = pr & 63;
        __syncthreads();
        if (tid < 320) { const int a_ = tid >> 6, c_ = tid & 63; const float* src = a_ == 0 ? k_k : (a_ == 1 ? k_a : (a_ == 2 ? r_k : (a_ == 3 ? ln_w : ln_b))); ((LAS float*)(lds + RO_CST))[tid] = src[h * 64 + c_]; }
        for (int d = 0; d < 2; ++d) {
            __syncthreads();
            f32x4 St[4];
#pragma unroll
            for (int nt = 0; nt < 4; ++nt) St[nt] = (f32x4){0.f, 0.f, 0.f, 0.f};
            bf16x8 Bw[3], Ba[3]; float w0v = 0.f, a0v = 0.f;
            u32x4 PF[6];
#pragma unroll
            for (int j = 0; j < 6; ++j) PF[j] = (u32x4){0u, 0u, 0u, 0u};
#pragma unroll
            for (int ks = 0; ks < 3; ++ks) { Bw[ks] = (bf16x8){0, 0, 0, 0, 0, 0, 0, 0}; Ba[ks] = Bw[ks]; }
#define PFLO(v, j) ((j) & 1 ? (u32x2){(v).z, (v).w} : (u32x2){(v).x, (v).y})
#define PFSET(v, j, val) { const u32x2 t_ = (val); if ((j) & 1) { (v).z = t_.x; (v).w = t_.y; } else { (v).x = t_.x; (v).y = t_.y; } }
#define LPREF(c_) { CHUNK(c_, tc_, rb_) const size_t row_ = rb_ + 16 * tc_ + (d ? 15 - fr : fr); const bf16* lwr = LW + row_ * 192 + d * 96 + 8 * fq; const bf16* lar = LA + row_ * 192 + d * 96 + 8 * fq; \
                _Pragma("unroll") for (int ks = 0; ks < 3; ++ks) { PF[ks] = *(const u32x4*)(lwr + 32 * ks); PF[3 + ks] = *(const u32x4*)(lar + 32 * ks); } }
            if (wid < 4) { LANEVARS
                const size_t rowo = ((size_t)d * 4096 + h * 64 + 16 * wid + fr) * 96 + 8 * fq;
#pragma unroll
                for (int ks = 0; ks < 3; ++ks) { Bw[ks] = *(const bf16x8*)(W2T + rowo + 32 * ks); Ba[ks] = *(const bf16x8*)(A2T + rowo + 32 * ks); }
                const int hn1 = h * 64 + 16 * wid + fr; w0v = w0[d * 4096 + hn1]; a0v = a0[d * 4096 + hn1];
                { const int c0 = 0; LPREF(c0) } }
            f32x4 cKK = {0.f, 0.f, 0.f, 0.f}, cKA = cKK, cRK = cKK;
            if (wid == 5 || wid == 6) { LANEVARS cKK = CST(0, fr); cKA = CST(1, fr); cRK = CST(2, fr); }
            if (wid == 4) { LANEVARS cKK = CST(3, fr); cKA = CST(4, fr); }
            for (int it = -4; it <= 144; ++it) {
                LANEVARS
                if (wid < 4) {
                    if (it >= 0 && it <= 143) { const int c = it;
                        LAS unsigned char* oAR = lds + RO_AR + (c % 3) * 4608; LAS unsigned char* oBKT = lds + RO_BKT + (c % 3) * BKT_SLOT; LAS float* aWL = (LAS float*)(lds + RO_WL + (c % 3) * 256);
                        LAS unsigned char* oVB = lds + RO_VB + (c & 3) * VB_SLOT; LAS unsigned char* oZT = lds + RO_ZT + (c & 1) * ZT_SLOT; LAS unsigned char* oMM = lds + RO_MM + (c & 1) * ZT_SLOT;
                        LAS float* aY = (LAS float*)(lds + RO_Y + (c & 1) * Y_SLOT);
#define PERMK(base_, rowbytes_) ({ const u32x2 lo_ = *(const LAS u32x2*)((base_) + (rowbytes_) + 8 * fq), hi_ = *(const LAS u32x2*)((base_) + (rowbytes_) + 32 + 8 * fq); __builtin_bit_cast(bf16x8, (u32x4){lo_.x, lo_.y, hi_.x, hi_.y}); })
                        f32x4 XuT = {0.f, 0.f, 0.f, 0.f}, XrT = {0.f, 0.f, 0.f, 0.f};
#pragma unroll
                        for (int ks = 0; ks < 2; ++ks) {
                            const u32x4 bs = {pk2(St[2 * ks][0], St[2 * ks][1]), pk2(St[2 * ks][2], St[2 * ks][3]), pk2(St[2 * ks + 1][0], St[2 * ks + 1][1]), pk2(St[2 * ks + 1][2], St[2 * ks + 1][3])};
                            const bf16x8 A0 = PERMK(oAR, fr * 144 + 64 * ks), A1 = PERMK(oAR, (16 + fr) * 144 + 64 * ks);
                            XuT = __builtin_amdgcn_mfma_f32_16x16x32_bf16(A0, __builtin_bit_cast(bf16x8, bs), XuT, 0, 0, 0); XrT = __builtin_amdgcn_mfma_f32_16x16x32_bf16(A1, __builtin_bit_cast(bf16x8, bs), XrT, 0, 0, 0); }
                        unsigned vlo, vhi;
                        { const unsigned v0 = *(LAS unsigned short*)(oVB + (4 * fq + 0) * VB_ROW + (16 * wid + fr) * 2), v1 = *(LAS unsigned short*)(oVB + (4 * fq + 1) * VB_ROW + (16 * wid + fr) * 2);
                          const unsigned v2 = *(LAS unsigned short*)(oVB + (4 * fq + 2) * VB_ROW + (16 * wid + fr) * 2), v3 = *(LAS unsigned short*)(oVB + (4 * fq + 3) * VB_ROW + (16 * wid + fr) * 2);
                          vlo = v0 | (v1 << 16); vhi = v2 | (v3 << 16); }
                        f32x4 UT = {0.f, 0.f, 0.f, 0.f};
                        { const u32x4 bu = {pk2(XuT[0], XuT[1]), pk2(XuT[2], XuT[3]), vlo, vhi};
                          UT = __builtin_amdgcn_mfma_f32_16x16x32_bf16(PERMK(oZT, fr * T_ROW), __builtin_bit_cast(bf16x8, bu), UT, 0, 0, 0); }
                        const u32x4 buv = {pk2(UT[0], UT[1]), pk2(UT[2], UT[3]), vlo, vhi};
                        if (c >= 16) {
                            const f32x4 y = __builtin_amdgcn_mfma_f32_16x16x32_bf16(PERMK(oMM, fr * T_ROW), __builtin_bit_cast(bf16x8, buv), XrT, 0, 0, 0);
#pragma unroll
                            for (int reg = 0; reg < 4; ++reg) aY[(4 * fq + reg) * Y_ROW + 16 * wid + fr] = y[reg]; }
#pragma unroll
                        for (int nt = 0; nt < 4; ++nt) { const f32x4 r = __builtin_amdgcn_mfma_f32_16x16x32_bf16(PERMK(oBKT, (16 * nt + fr) * T_ROW), __builtin_bit_cast(bf16x8, buv), St[nt], 0, 0, 0);
                            St[nt] = r * *(LAS f32x4*)(aWL + 16 * nt + 4 * fq); }
#undef PERMK
                    }
                    if (it + 4 <= 143) { const int c = it + 4;
                        LAS float* aWd = (LAS float*)(lds + RO_WD + (c % 3) * W_SLOT); LAS float* aTt = (LAS float*)(lds + RO_TT + (c & 1) * W_SLOT);
                        f32x4 cw = {0.f, 0.f, 0.f, 0.f}, ca = {0.f, 0.f, 0.f, 0.f};
#pragma unroll
                        for (int ks = 0; ks < 3; ++ks) { cw = __builtin_amdgcn_mfma_f32_16x16x32_bf16(__builtin_bit_cast(bf16x8, PF[ks]), Bw[ks], cw, 0, 0, 0); ca = __builtin_amdgcn_mfma_f32_16x16x32_bf16(__builtin_bit_cast(bf16x8, PF[3 + ks]), Ba[ks], ca, 0, 0, 0); }
#pragma unroll
                        for (int reg = 0; reg < 4; ++reg) { const int ii = 4 * fq + reg; const int n = 16 * wid + fr;
                            const float sg = sigmoidf_(w0v + cw[reg]);
                            aWd[ii * W_ROW + n] = __expf(-0.60653065971263342f * sg); aTt[ii * W_ROW + n] = sigmoidf_(a0v + ca[reg]); }
                    }
                    if (it + 5 >= 0 && it + 5 <= 143) { const int c5 = it + 5; LPREF(c5) }
                    if (wid == 0 && it + 2 >= 0 && it + 2 <= 143) { const int c = it + 2; const int k = lane;
                        LAS float* aWd = (LAS float*)(lds + RO_WD + (c % 3) * W_SLOT); LAS float* pa = (LAS float*)(lds + RO_PA + (c & 1) * 20480);
                        LAS unsigned char* oAR = lds + RO_AR + (c % 3) * 4608; LAS float* aWL = (LAS float*)(lds + RO_WL + (c % 3) * 256);
                        float Wc = 1.0f;
#pragma unroll
                        for (int t = 0; t < 16; ++t) { const float Wp = Wc; Wc *= aWd[t * W_ROW + k];
                            STH(oAR + t * 144 + k * 2, pa[0 * 1024 + t * 64 + k] * Wp); }
                        aWL[k] = Wc; }
                    if (wid == 1 && it + 2 >= 0 && it + 2 <= 143) { const int c = it + 2; const int k = lane;
                        LAS float* aWd = (LAS float*)(lds + RO_WD + (c % 3) * W_SLOT); LAS float* pa = (LAS float*)(lds + RO_PA + (c & 1) * 20480);
                        LAS unsigned char* oAR = lds + RO_AR + (c % 3) * 4608; LAS unsigned char* oVB = lds + RO_VB + (c & 3) * VB_SLOT;
                        float Wc = 1.0f;
#pragma unroll
                        for (int t = 0; t < 16; ++t) { Wc *= aWd[t * W_ROW + k]; STH(oAR + (16 + t) * 144 + k * 2, pa[3 * 1024 + t * 64 + k] * Wc); STH(oVB + t * VB_ROW + k * 2, pa[4 * 1024 + t * 64 + k]); } }
                } else if (wid == 4) {
                    if (it - 1 >= 16 && it - 1 <= 143) { const int c = it - 1; CHUNK(c, tc_, rb_) (void)rb_;
                        LAS float* aY = (LAS float*)(lds + RO_Y + (c & 1) * Y_SLOT); LAS float* aQ = (LAS float*)(lds + RO_Q + (c & 7) * 64); LAS unsigned char* oVB = lds + RO_VB + (c & 3) * VB_SLOT;
#pragma unroll
                        for (int j = 0; j < 4; ++j) { const int pi = fq + 4 * j, nq = fr, hn4 = h * 64 + 4 * nq;
                            const size_t rl = (size_t)bl * 2048 + 16 * tc_ + (d ? 15 - pi : pi);
                            const f32x4 y4 = *(LAS f32x4*)(aY + pi * Y_ROW + 4 * nq); const float qown = aQ[pi];
                            if (d == 0) {
                                u32x2 o; o.x = pk2(y4.x, y4.y); o.y = pk2(y4.z, y4.w); *(u32x2*)(YP + rl * 4096 + hn4) = o;
                                if (nq == 0) QP[rl * 64 + h] = qown;
                            } else {
                                const u32x2 py_ = PFLO(PF[j >> 1], j), pz_ = PFLO(PF[2 + (j >> 1)], j); const float pq_ = __builtin_bit_cast(float, j == 0 ? PF[4].x : (j == 1 ? PF[4].y : (j == 2 ? PF[4].z : PF[4].w)));
                                const f32x4 ys = {y4.x + blo(py_.x), y4.y + bhi(py_.x), y4.z + blo(py_.y), y4.w + bhi(py_.y)};
                                float sm = (ys.x + ys.y) + (ys.z + ys.w); sm = red16(sm); const float mean = sm * (1.0f / 64.0f);
                                const f32x4 dv = ys - mean; float vs = (dv.x * dv.x + dv.y * dv.y) + (dv.z * dv.z + dv.w * dv.w); vs = red16(vs);
                                const float rstd = __builtin_amdgcn_rsqf(vs * (1.0f / 64.0f) + 64e-5f);
                                const float q = qown + pq_;
                                const u32x2 vb = *(LAS u32x2*)(oVB + pi * VB_ROW + nq * 8);
                                const f32x4 v4 = {blo(vb.x), bhi(vb.x), blo(vb.y), bhi(vb.y)};
                                const f32x4 val = dv * rstd * cKK + cKA + v4 * q;
                                const float z0 = blo(pz_.x), z1 = bhi(pz_.x), z2 = blo(pz_.y), z3 = bhi(pz_.y);
                                u32x2 o; o.x = pk2(val.x * z0 * sigmoidf_(z0), val.y * z1 * sigmoidf_(z1)); o.y = pk2(val.z * z2 * sigmoidf_(z2), val.w * z3 * sigmoidf_(z3));
                                *(u32x2*)(ZB + (1024 + rl) * 4096 + hn4) = o;
                            } }
                    }
                    if (d == 1 && it >= 16 && it <= 143) { const int c = it; CHUNK(c, tc_, rb_) (void)rb_;
                        u32x2 ty[4], tz[4]; unsigned tq[4];
#pragma unroll
                        for (int j = 0; j < 4; ++j) { const int pi = fq + 4 * j, nq = fr, hn4 = h * 64 + 4 * nq; const size_t rl = (size_t)bl * 2048 + 16 * tc_ + (15 - pi);
                            ty[j] = *(const u32x2*)(YP + rl * 4096 + hn4); tq[j] = __builtin_bit_cast(unsigned, QP[rl * 64 + h]); tz[j] = *(const u32x2*)(ZB + (1024 + rl) * 4096 + hn4); }
                        PF[0] = (u32x4){ty[0].x, ty[0].y, ty[1].x, ty[1].y}; PF[1] = (u32x4){ty[2].x, ty[2].y, ty[3].x, ty[3].y};
                        PF[2] = (u32x4){tz[0].x, tz[0].y, tz[1].x, tz[1].y}; PF[3] = (u32x4){tz[2].x, tz[2].y, tz[3].x, tz[3].y};
                        PF[4] = (u32x4){tq[0], tq[1], tq[2], tq[3]}; }
                    if (it + 1 >= 0 && it + 1 <= 143) { const int c = it + 1;
                        LAS unsigned char* oAR = lds + RO_AR + (c % 3) * 4608; LAS unsigned char* oBK = lds + RO_BK + (c & 1) * 4608; LAS unsigned char* oMM = lds + RO_MM + (c & 1) * ZT_SLOT;
#pragma unroll
                        for (int mi = 0; mi < 2; ++mi) { f32x4 g = {0.f, 0.f, 0.f, 0.f};
#pragma unroll
                            for (int ks = 0; ks < 2; ++ks) { const bf16x8 Af = *(const LAS bf16x8*)(oBK + (16 * mi + fr) * 144 + (32 * ks + 8 * fq) * 2), Bf = *(const LAS bf16x8*)(oAR + (16 + fr) * 144 + (32 * ks + 8 * fq) * 2);
                                g = __builtin_amdgcn_mfma_f32_16x16x32_bf16(Af, Bf, g, 0, 0, 0); }
#pragma unroll
                            for (int reg = 0; reg < 4; ++reg) { const int s_ = 4 * fq + reg; STH(oMM + fr * T_ROW + (16 * mi + s_) * 2, (s_ <= fr) ? g[reg] : 0.f); } } }
                } else if (wid == 5) {
                    if (it + 3 >= 0 && it + 3 <= 143) { const int c = it + 3;
                        LAS float* aTt = (LAS float*)(lds + RO_TT + (c & 1) * W_SLOT); LAS float* pa = (LAS float*)(lds + RO_PA + (c & 1) * 20480); LAS float* aQ = (LAS float*)(lds + RO_Q + (c & 7) * 64);
#pragma unroll
                        for (int j = 0; j < 3; ++j) { const int pi = fq + 4 * j, nq = fr;
                            const u32x2 pk_ = PFLO(PF[j >> 1], j), pr_ = PFLO(PF[2 + (j >> 1)], j), pv_ = PFLO(PF[4 + (j >> 1)], j);
                            const f32x4 k4 = {blo(pk_.x), bhi(pk_.x), blo(pk_.y), bhi(pk_.y)}, r4 = {blo(pr_.x), bhi(pr_.x), blo(pr_.y), bhi(pr_.y)}, v4 = {blo(pv_.x), bhi(pv_.x), blo(pv_.y), bhi(pv_.y)};
                            f32x4 kk = k4 * cKK; float ss = (kk.x * kk.x + kk.y * kk.y) + (kk.z * kk.z + kk.w * kk.w); ss = red16(ss);
                            const float inv = __builtin_amdgcn_rsqf(fmaxf(ss, 1e-24f)); kk = kk * inv;
                            const f32x4 ar = *(LAS f32x4*)(aTt + pi * W_ROW + 4 * nq);
                            const f32x4 kd = k4 * ((ar - 1.0f) * cKA + 1.0f);
                            *(LAS f32x4*)(pa + 0 * 1024 + pi * 64 + 4 * nq) = -kk; *(LAS f32x4*)(pa + 1 * 1024 + pi * 64 + 4 * nq) = kk * ar; *(LAS f32x4*)(pa + 2 * 1024 + pi * 64 + 4 * nq) = kd;
                            *(LAS f32x4*)(pa + 3 * 1024 + pi * 64 + 4 * nq) = r4; *(LAS f32x4*)(pa + 4 * 1024 + pi * 64 + 4 * nq) = v4;
                            const f32x4 q3 = kd * r4 * cRK; float qq = (q3.x + q3.y) + (q3.z + q3.w); qq = red16(qq);
                            if (nq == 0) aQ[pi] = qq; }
                    }
                    if (it + 4 >= 0 && it + 4 <= 143) { const int c4 = it + 4; CHUNK(c4, tc_, rb_)
#pragma unroll
                        for (int j = 0; j < 3; ++j) { const int pi = fq + 4 * j; const size_t off_ = (rb_ + 16 * tc_ + (d ? 15 - pi : pi)) * 4096 + h * 64 + 4 * fr;
                            PFSET(PF[j >> 1], j, *(const u32x2*)(KB + off_)) PFSET(PF[2 + (j >> 1)], j, *(const u32x2*)(RB + off_)) PFSET(PF[4 + (j >> 1)], j, *(const u32x2*)(VB + off_)) } }
                } else if (wid == 6) {
                    if (it + 3 >= 0 && it + 3 <= 143) { const int c = it + 3;
                        LAS float* aTt = (LAS float*)(lds + RO_TT + (c & 1) * W_SLOT); LAS float* pa = (LAS float*)(lds + RO_PA + (c & 1) * 20480); LAS float* aQ = (LAS float*)(lds + RO_Q + (c & 7) * 64);
#pragma unroll
                        for (int j = 3; j < 4; ++j) { const int pi = fq + 4 * j, nq = fr;
                            const u32x2 pk_ = PFLO(PF[j >> 1], j), pr_ = PFLO(PF[2 + (j >> 1)], j), pv_ = PFLO(PF[4 + (j >> 1)], j);
                            const f32x4 k4 = {blo(pk_.x), bhi(pk_.x), blo(pk_.y), bhi(pk_.y)}, r4 = {blo(pr_.x), bhi(pr_.x), blo(pr_.y), bhi(pr_.y)}, v4 = {blo(pv_.x), bhi(pv_.x), blo(pv_.y), bhi(pv_.y)};
                            f32x4 kk = k4 * cKK; float ss = (kk.x * kk.x + kk.y * kk.y) + (kk.z * kk.z + kk.w * kk.w); ss = red16(ss);
                            const float inv = __builtin_amdgcn_rsqf(fmaxf(ss, 1e-24f)); kk = kk * inv;
                            const f32x4 ar = *(LAS f32x4*)(aTt + pi * W_ROW + 4 * nq);
                            const f32x4 kd = k4 * ((ar - 1.0f) * cKA + 1.0f);
                            *(LAS f32x4*)(pa + 0 * 1024 + pi * 64 + 4 * nq) = -kk; *(LAS f32x4*)(pa + 1 * 1024 + pi * 64 + 4 * nq) = kk * ar; *(LAS f32x4*)(pa + 2 * 1024 + pi * 64 + 4 * nq) = kd;
                            *(LAS f32x4*)(pa + 3 * 1024 + pi * 64 + 4 * nq) = r4; *(LAS f32x4*)(pa + 4 * 1024 + pi * 64 + 4 * nq) = v4;
                            const f32x4 q3 = kd * r4 * cRK; float qq = (q3.x + q3.y) + (q3.z + q3.w); qq = red16(qq);
                            if (nq == 0) aQ[pi] = qq; }
                    }
                    if (it + 4 >= 0 && it + 4 <= 143) { const int c4 = it + 4; CHUNK(c4, tc_, rb_)
#pragma unroll
                        for (int j = 3; j < 4; ++j) { const int pi = fq + 4 * j; const size_t off_ = (rb_ + 16 * tc_ + (d ? 15 - pi : pi)) * 4096 + h * 64 + 4 * fr;
                            PFSET(PF[j >> 1], j, *(const u32x2*)(KB + off_)) PFSET(PF[2 + (j >> 1)], j, *(const u32x2*)(RB + off_)) PFSET(PF[4 + (j >> 1)], j, *(const u32x2*)(VB + off_)) } }
                    if (it + 2 >= 0 && it + 2 <= 143) { const int c = it + 2; const int k = lane;
                        LAS float* aWd = (LAS float*)(lds + RO_WD + (c % 3) * W_SLOT); LAS float* pa = (LAS float*)(lds + RO_PA + (c & 1) * 20480);
                        LAS unsigned char* oBK = lds + RO_BK + (c & 1) * 4608; LAS unsigned char* oBKT = lds + RO_BKT + (c % 3) * BKT_SLOT; LAS unsigned char* oAR = lds + RO_AR + (c % 3) * 4608; LAS unsigned char* oVB = lds + RO_VB + (c & 3) * VB_SLOT;
                        float Wc = 1.0f, pxb = 0.f, pxk = 0.f;
#pragma unroll
                        for (int t = 0; t < 16; ++t) { Wc *= aWd[t * W_ROW + k]; const float rW = __builtin_amdgcn_rcpf(Wc);
                            const float xb = pa[1 * 1024 + t * 64 + k] * rW, xk = pa[2 * 1024 + t * 64 + k] * rW;
                            STH(oBK + t * 144 + k * 2, xb); STH(oBK + (16 + t) * 144 + k * 2, xk);
                            if (t & 1) { *(LAS unsigned*)(oBKT + k * T_ROW + (t - 1) * 2) = pk2(pxb, xb); *(LAS unsigned*)(oBKT + k * T_ROW + (16 + t - 1) * 2) = pk2(pxk, xk); } pxb = xb; pxk = xk;
                            } }
                } else {
                    if (it + 1 >= 0 && it + 1 <= 143) { const int c = it + 1;
                        LAS unsigned char* oAR = lds + RO_AR + (c % 3) * 4608; LAS unsigned char* oBK = lds + RO_BK + (c & 1) * 4608; LAS float* aG = (LAS float*)(lds + RO_G);
                        LAS unsigned char* oZT = lds + RO_ZT + (c & 1) * ZT_SLOT;
#pragma unroll
                        for (int mi = 0; mi < 2; ++mi) { const int ni = 0; f32x4 g = {0.f, 0.f, 0.f, 0.f};
#pragma unroll
                            for (int ks = 0; ks < 2; ++ks) { const bf16x8 Af = *(const LAS bf16x8*)(oBK + (16 * mi + fr) * 144 + (32 * ks + 8 * fq) * 2), Bf = *(const LAS bf16x8*)(oAR + (16 * ni + fr) * 144 + (32 * ks + 8 * fq) * 2);
                                g = __builtin_amdgcn_mfma_f32_16x16x32_bf16(Af, Bf, g, 0, 0, 0); }
#pragma unroll
                            for (int reg = 0; reg < 4; ++reg) aG[(16 * mi + 4 * fq + reg) * 36 + 16 * ni + fr] = g[reg]; }
                        asm volatile("" ::: "memory");
                        { const int rp = lane & 31; float z[16], grow[16];
#pragma unroll
                          for (int t4 = 0; t4 < 4; ++t4) { const f32x4 gr = *(LAS f32x4*)(aG + rp * 36 + 4 * t4); grow[4 * t4] = gr.x; grow[4 * t4 + 1] = gr.y; grow[4 * t4 + 2] = gr.z; grow[4 * t4 + 3] = gr.w; }
#pragma unroll
                          for (int t = 0; t < 16; ++t) z[t] = (rp < 16) ? ((t == rp) ? 1.0f : 0.0f) : ((rp - 16 < t) ? grow[t] : 0.0f);
#pragma unroll
                          for (int s = 0; s < 15; ++s) {
#pragma unroll
                              for (int t = s + 1; t < 16; ++t) { const float gst = __builtin_bit_cast(float, __builtin_amdgcn_readlane(__builtin_bit_cast(int, grow[t]), s)); z[t] += z[s] * gst; } }
                          if (lane < 32) {
#pragma unroll
                              for (int t = 0; t < 16; ++t) STH(oZT + t * T_ROW + rp * 2, z[t]); } }
                    }
                }
                BAR_LDS();
            }
        }
    }
    __syncthreads();
#undef LANEVARS
#undef BAR_LDS
#undef STH
#undef CHUNK
#undef CST
#undef LPREF
#undef PFLO
#undef PFSET
}

__device__ __forceinline__ void mix_phase(PPtr P, int i0, int i1, int i2, int gtid, int gthreads) {
    const bf16* H = (const bf16*)(P->ws + WS_H1); const float* mu = P->in[22];
    bf16* A0 = (bf16*)(P->ws + WS_A); bf16* A1 = (bf16*)(P->ws + WS_A + A_STRIDE); bf16* A2 = (bf16*)(P->ws + WS_A + 2 * A_STRIDE);
    for (int idx = gtid; idx < 9216 * 256; idx += gthreads) {
        const int row = idx >> 8, c0 = (idx & 255) * 8;
        int nrow = -1;
        if (row < 1024) { const int t = row & 255; if (c0 < 1024) { if (t > 0) nrow = row - 1; } else { if (t < 255) nrow = row + 1; } }
        else { const int t = (row - 1024) & 2047, gx = t & 63, gy = t >> 6, qd = c0 >> 9;
            if (qd == 0) { if (gx > 0) nrow = row - 1; } else if (qd == 1) { if (gx < 63) nrow = row + 1; } else if (qd == 2) { if (gy > 0) nrow = row - 64; } else { if (gy < 31) nrow = row + 64; } }
        const u32x4 hv = *(const u32x4*)(H + (size_t)row * 2048 + c0);
        u32x4 sv = {0u, 0u, 0u, 0u}; if (nrow >= 0) sv = *(const u32x4*)(H + (size_t)nrow * 2048 + c0);
        const float hf[8] = {blo(hv.x), bhi(hv.x), blo(hv.y), bhi(hv.y), blo(hv.z), bhi(hv.z), blo(hv.w), bhi(hv.w)};
        const float sf[8] = {blo(sv.x), bhi(sv.x), blo(sv.y), bhi(sv.y), blo(sv.z), bhi(sv.z), blo(sv.w), bhi(sv.w)};
#pragma unroll
        for (int q = 0; q < 3; ++q) { const int mi = q == 0 ? i0 : (q == 1 ? i1 : i2); bf16* dst = q == 0 ? A0 : (q == 1 ? A1 : A2);
            const f32x4 m0 = *(const f32x4*)(mu + mi * 2048 + c0), m1 = *(const f32x4*)(mu + mi * 2048 + c0 + 4);
            const float mm[8] = {m0.x, m0.y, m0.z, m0.w, m1.x, m1.y, m1.z, m1.w};
            float o[8];
#pragma unroll
            for (int e = 0; e < 8; ++e) o[e] = hf[e] + (sf[e] - hf[e]) * mm[e];
            u32x4 w; w.x = pk2(o[0], o[1]); w.y = pk2(o[2], o[3]); w.z = pk2(o[4], o[5]); w.w = pk2(o[6], o[7]);
            *(u32x4*)(dst + (size_t)row * 2048 + c0) = w; }
    }
}

__global__ void __launch_bounds__(NT, 2) fwd_megakernel(Params Pk) {
    extern __shared__ __attribute__((aligned(16))) unsigned char lds_raw[];
    LAS unsigned char* lds = (LAS unsigned char*)lds_raw;
    cg::grid_group grid = cg::this_grid();
    const int G = gridDim.x, NGW = G * 8, gthreads = G * NT;
#ifdef PROBE_CAT
    unsigned long long pb_acc = 0, pb_t0 = 0;
#define PB_BEGIN(cat) if (PROBE_CAT == (cat)) pb_t0 = __builtin_amdgcn_s_memrealtime();
#define PB_END(cat) if (PROBE_CAT == (cat)) pb_acc += __builtin_amdgcn_s_memrealtime() - pb_t0;
#else
#define PB_BEGIN(cat)
#define PB_END(cat)
#endif
    { int t_ = threadIdx.x; if (t_ < 16) ((LAS unsigned*)(lds + LDS_BARST))[t_] = 0u; }
    __syncthreads();
    XcdBarrier xbar;
    { GETP xbar = xcd_barrier_post((unsigned*)(P->ws + WS_BAR), (volatile LAS unsigned*)(lds + LDS_BARST)); }
#define GSYNC_CG() do { PB_BEGIN(4) grid.sync(); PB_END(4) } while (0)
#define GSYNC() do { PB_BEGIN(4) xcd_barrier(xbar); PB_END(4) } while (0)
#define TID_VARS GETP unsigned char* ws = P->ws; float* MOD = (float*)(ws + WS_MOD); (void)MOD; int tid = threadIdx.x; asm volatile("" : "+v"(tid)); const int lane = tid & 63, wave = __builtin_amdgcn_readfirstlane(tid >> 6); const int gw = blockIdx.x * 8 + wave, gtid = blockIdx.x * NT + tid; LAS float* scr = (LAS float*)(lds + wave * 16384); (void)lane; (void)gw; (void)gtid; (void)scr;

    { TID_VARS
      for (int tk = blockIdx.x; tk < 768; tk += G) mod_task(P, MOD, (LAS float*)(lds + 8 * 16384), tk, tid);
      constexpr int I_IN = 32 * 256, I_GLU = 64 * 128, I_OUT = 64 * 64;
      for (int it = gw; it < I_IN + I_GLU + I_OUT; it += NGW) { int r = it;
          if (r < I_IN) { transpose_item(P->in[7], 2048, 8192, (bf16*)(ws + WB_L0_IN), 0, scr, r, lane); continue; } r -= I_IN;
          if (r < I_GLU) { transpose_item(P->in[16], 4096, 4096, (bf16*)(ws + WB_L0_GLU), 0, scr, r, lane); continue; } r -= I_GLU;
          transpose_item(P->in[18], 4096, 2048, (bf16*)(ws + WB_L0_OUT), 0, scr, r, lane); } }
    GSYNC(); if (gridDim.x == 0u) GSYNC_CG();
    { TID_VARS bf16* H0 = (bf16*)P->out;
      for (int m = gw; m < 18432; m += NGW) {
          if (m < 2048) normmod_row(P->in[2] + (size_t)m * 2048, P->in[4], MOD + 8 * 6144, H0 + (size_t)m * 2048, lane);
          else { const int r = m - 2048; normmod_row(P->in[0] + (size_t)r * 2048, P->in[4], MOD + (r >> 11) * 6144, H0 + (size_t)m * 2048, lane); } } }
    GSYNC();
    { GETP unsigned char* ws = P->ws; float* MOD = (float*)(ws + WS_MOD); (void)MOD; pg8::Gemm g{(const bf16*)P->out, (const bf16*)(ws + WB_L0_IN), 18432, 8192, 2048, 0, 1, 1 << 30}; pg8::StaticOrder S; S.init(18432, 8192, G, (int)blockIdx.x);
      pg8::EpiSplitBf16 E{(bf16*)(ws + WS_U), 4096, 4096, (size_t)18432 * 4096};
      PB_BEGIN(1) pg8::gemm_phase<pg8::EpiSplitBf16, pg8::StaticOrder, true, true>(lds, g, S, E); PB_END(1) }
    GSYNC();
    { PB_BEGIN(2) TID_VARS s5_phase(P, lds, wave, lane); PB_END(2) }
    GSYNC();
    { GETP unsigned char* ws = P->ws; float* MOD = (float*)(ws + WS_MOD); (void)MOD; pg8::Gemm g{(const bf16*)(ws + WS_Y), (const bf16*)(ws + WB_L0_GLU), 18432, 4096, 4096, 0, 1, 1 << 30}; pg8::StaticOrder S; S.init(18432, 4096, G, (int)blockIdx.x);
      pg8::EpiGlu E{(const bf16*)(ws + WS_Y), (bf16*)(ws + WS_Z), 4096, P->in[17]};
      PB_BEGIN(1) pg8::gemm_phase<pg8::EpiGlu, pg8::StaticOrder, true, true>(lds, g, S, E); PB_END(1) }
    GSYNC();
    { GETP unsigned char* ws = P->ws; float* MOD = (float*)(ws + WS_MOD); (void)MOD; pg8::Gemm g{(const bf16*)(ws + WS_Z), (const bf16*)(ws + WB_L0_OUT), 18432, 2048, 4096, 0, 1, 1 << 30}; pg8::StaticOrder S; S.init(18432, 2048, G, (int)blockIdx.x);
      pg8::EpiResid E{P->in[0], P->out, P->in[2], (float*)(ws + WS_XC), MOD, 2048, 0};
      PB_BEGIN(1) pg8::gemm_phase<pg8::EpiResid, pg8::StaticOrder, true, true>(lds, g, S, E); PB_END(1) }
    GSYNC();
    { TID_VARS constexpr int I_IN = 32 * 128, I_LO = 32 * 3, I_OUT = 64 * 64; bf16* WIN = (bf16*)(ws + WB_L1_IN);
      for (int it = gw; it < 4 * I_IN + 4 * I_LO + I_OUT; it += NGW) { int r = it;
          if (r < 4 * I_IN) { const int q = r / I_IN; transpose_item(P->in[23] + (size_t)q * 2048 * 4096, 2048, 4096, WIN, q * 4096, scr, r % I_IN, lane); continue; } r -= 4 * I_IN;
          if (r < 2 * I_LO) { const int q = r / I_LO; transpose_item(P->in[25] + (size_t)q * 2048 * 96, 2048, 96, WIN, 16384 + q * 96, scr, r % I_LO, lane); continue; } r -= 2 * I_LO;
          if (r < 2 * I_LO) { const int q = r / I_LO; transpose_item(P->in[28] + (size_t)q * 2048 * 96, 2048, 96, WIN, 16640 + q * 96, scr, r % I_LO, lane); continue; } r -= 2 * I_LO;
          transpose_item(P->in[35], 4096, 2048, (bf16*)(ws + WB_L1_OUT), 0, scr, r, lane); }
      for (int idx = gtid; idx < 2 * 64 * 2048 / 8; idx += gthreads) { const int e = idx * 8, pr = e / 2048, c = e % 2048; const int row = (pr < 64) ? 16576 + pr : 16832 + (pr - 64);
          *(u32x4*)(WIN + (size_t)row * 2048 + c) = (u32x4){0u, 0u, 0u, 0u}; }
      bf16* W2T = (bf16*)(ws + WS_W2T); bf16* A2T = (bf16*)(ws + WS_A2T);
      for (int idx = gtid; idx < 2 * 96 * 4096; idx += gthreads) { const int n = idx & 4095, m = (idx >> 12) % 96, dd = idx / (96 * 4096);
          W2T[((size_t)dd * 4096 + n) * 96 + m] = (bf16)f2bf(P->in[26][idx]); A2T[((size_t)dd * 4096 + n) * 96 + m] = (bf16)f2bf(P->in[29][idx]); } }
    for (int hb = 0; hb < 2; ++hb) {
        { TID_VARS bf16* H1 = (bf16*)(ws + WS_H1); const float* MOD1 = MOD + 9 * 6144;
          for (int m = gw; m < 9216; m += NGW) {
              if (m < 1024) normmod_row((const float*)(ws + WS_XC) + (size_t)(hb * 1024 + m) * 2048, P->in[19], MOD1 + 8 * 6144, H1 + (size_t)m * 2048, lane);
              else { const int r = hb * 8192 + (m - 1024); normmod_row(P->out + (size_t)r * 2048, P->in[19], MOD1 + (r >> 11) * 6144, H1 + (size_t)m * 2048, lane); } } }
        GSYNC();
        { TID_VARS mix_phase(P, 0, 1, 2, gtid, gthreads); }
        GSYNC();
        { GETP unsigned char* ws = P->ws; float* MOD = (float*)(ws + WS_MOD); (void)MOD; pg8::Gemm g{(const bf16*)(ws + WS_A), (const bf16*)(ws + WB_L1_IN), 9216, 12288, 2048, A_STRIDE, 16, 48}; pg8::StaticOrder S; S.init(9216, 12288, G, (int)blockIdx.x);
          pg8::EpiSplitBf16 E{(bf16*)(ws + WS_RKV), 4096, 4096, (size_t)9216 * 4096};
          PB_BEGIN(1) pg8::gemm_phase<pg8::EpiSplitBf16, pg8::StaticOrder, true, true>(lds, g, S, E); PB_END(1) }
        GSYNC();
        { TID_VARS mix_phase(P, 3, 4, 5, gtid, gthreads); }
        GSYNC();
        { GETP unsigned char* ws = P->ws; float* MOD = (float*)(ws + WS_MOD); (void)MOD; pg8::Gemm g{(const bf16*)(ws + WS_A), (const bf16*)(ws + WB_L1_IN) + (size_t)12288 * 2048, 9216, 4608, 2048, A_STRIDE, 16, 16}; pg8::StaticOrder S; S.init(9216, 4608, G, (int)blockIdx.x);
          pg8::EpiZLora E{(bf16*)(ws + WS_ZB), (bf16*)(ws + WS_ZB + ZB_LW), (bf16*)(ws + WS_ZB + ZB_LA)};
          PB_BEGIN(1) pg8::gemm_phase<pg8::EpiZLora, pg8::StaticOrder, true, true>(lds, g, S, E); PB_END(1) }
        GSYNC();
        { PB_BEGIN(3) TID_VARS rwkv_phase(P, lds, hb, tid); PB_END(3) }
        GSYNC();
        { GETP unsigned char* ws = P->ws; float* MOD = (float*)(ws + WS_MOD); (void)MOD; pg8::Gemm g{(const bf16*)(ws + WS_ZB) + (size_t)1024 * 4096, (const bf16*)(ws + WB_L1_OUT), 8192, 2048, 4096, 0, 1, 1 << 30}; pg8::StaticOrder S; S.init(8192, 2048, G, (int)blockIdx.x);
          pg8::EpiResid E{P->out, P->out, nullptr, nullptr, MOD + 9 * 6144, 0, hb * 8192};
          PB_BEGIN(1) pg8::gemm_phase<pg8::EpiResid, pg8::StaticOrder, true, true>(lds, g, S, E); PB_END(1) }
        GSYNC();
    }
    { TID_VARS const float* fg = P->in[36];
      for (int m = gw; m < 16384; m += NGW) { float* xr = P->out + (size_t)m * 2048;
          f32x4 v[8]; float s = 0.f;
#pragma unroll
          for (int j = 0; j < 8; ++j) { v[j] = ((const f32x4*)xr)[lane + 64 * j]; s += (v[j].x * v[j].x + v[j].y * v[j].y) + (v[j].z * v[j].z + v[j].w * v[j].w); }
          const float rstd = 1.0f / sqrtf(wave_sum(s) * (1.0f / 2048.0f) + 1e-6f);
#pragma unroll
          for (int j = 0; j < 8; ++j) ((f32x4*)xr)[lane + 64 * j] = v[j] * rstd * ((const f32x4*)fg)[lane + 64 * j]; } }
#ifdef PROBE_CAT
    { const unsigned long long t1 = __builtin_amdgcn_s_memrealtime(); while (__builtin_amdgcn_s_memrealtime() - t1 < pb_acc) __builtin_amdgcn_s_sleep(8); }
#endif
}

extern "C" void kernel_launch(void* const* d_in, const int* in_sizes, int n_in, void* d_out, int out_size, void* d_ws, size_t ws_size, hipStream_t stream) {
    static int grid = 0;
    if (grid == 0) {
        if (n_in != 37 || ws_size < WS_END) { fprintf(stderr, "kernel_launch: need 37 inputs and >= %zu bytes of workspace; got n_in %d, ws %zu; nothing launched\n", (size_t)WS_END, n_in, ws_size); grid = -1; return; }
        int dev = 0, cus = 0, per_cu = 0;
        if (hipGetDevice(&dev) != hipSuccess || hipDeviceGetAttribute(&cus, hipDeviceAttributeMultiprocessorCount, dev) != hipSuccess) { grid = -1; return; }
        if (hipFuncSetAttribute((const void*)fwd_megakernel, hipFuncAttributeMaxDynamicSharedMemorySize, LDS_BYTES) != hipSuccess) { fprintf(stderr, "kernel_launch: hipFuncSetAttribute failed\n"); grid = -1; return; }
        if (hipOccupancyMaxActiveBlocksPerMultiprocessor(&per_cu, (const void*)fwd_megakernel, NT, LDS_BYTES) != hipSuccess || per_cu < 1) { fprintf(stderr, "kernel_launch: occupancy query says %d\n", per_cu); per_cu = 1; }
        (void)hipGetLastError();
        grid = cus * 1;
    }
    if (grid < 0) return;
    (void)hipMemsetAsync((char*)d_ws + WS_MOD, 0, ZERO_BYTES, stream);
    Params p{};
    for (int i = 0; i < 37; ++i) p.in[i] = (const float*)d_in[i];
    p.out = (float*)d_out; p.ws = (unsigned char*)d_ws;
    void* args[] = {&p};
    hipError_t e = hipLaunchCooperativeKernel((const void*)fwd_megakernel, dim3(grid), dim3(NT), args, LDS_BYTES, stream);
    if (e != hipSuccess) fprintf(stderr, "cooperative launch failed: %s (grid %d)\n", hipGetErrorString(e), grid);
}
```

```cpp
#include <hip/hip_runtime.h>
#include <hip/hip_cooperative_groups.h>
#include <cstdio>
#include <cstdint>
namespace cg = cooperative_groups;
namespace pg8 {
#define PG8_LAS __attribute__((address_space(3)))
typedef unsigned short bf16_t;
typedef short bf16x8 __attribute__((ext_vector_type(8)));
typedef float f32x4 __attribute__((ext_vector_type(4)));
typedef unsigned u32x4 __attribute__((ext_vector_type(4)));
constexpr int BM = 256, BK = 64, HALF = 128, HTB = HALF * BK * 2  , STAGE_BYTES = 8 * HTB, NXCD = 8, WGM = 8;

__host__ __device__ __forceinline__ int lds_byte(int r, int c) { const int st = (r >> 4) * 2 + (c >> 5), rr = r & 15, cc = c & 31, ob = rr * 64 + cc * 2; return st * 1024 + (ob ^ (((ob >> 9) & 1) << 5)); }
__host__ __device__ __forceinline__ void stage_rc(int b, int& R, int& C) { const int st = b / 1024, sb = b % 1024, swz = sb ^ (((sb >> 9) & 1) << 5); R = (st >> 1) * 16 + swz / 64; C = (st & 1) * 32 + (swz % 64) / 2; }
__host__ __device__ __forceinline__ int perm32(int rho) { const int n = rho >> 4, i = rho & 15; return 8 * (i >> 2) + 4 * n + (i & 3); }

struct Unit { int pm, pn; };
struct Gemm { const bf16_t* A; const bf16_t* Bt; int M, N, K; size_t a_stride; int a_div, a_n0; };
#define PG8_AIDX(g, pn) ((size_t)((pn) < (g).a_n0 ? (pn) / (g).a_div : (g).a_n0 / (g).a_div + ((pn) - (g).a_n0)) * (g).a_stride)

struct StaticOrder {
    int nM, nN, nwg, G, c;
    __host__ __device__ void init(int M, int N, int G_, int c_) { nM = M / BM; nN = N / BM; nwg = nM * nN; G = G_; c = c_; }
    __host__ __device__ bool next(int i, Unit& u) const {
        const long L = (long)i * G + c; if (L >= nwg) return false;
        int wgid = (int)L; { const int q = nwg / NXCD, r = nwg % NXCD, xcd = wgid % NXCD, off = wgid / NXCD; wgid = (xcd < r ? xcd * (q + 1) : r * (q + 1) + (xcd - r) * q) + off; }
        const int nig = WGM * nN, gid = wgid / nig, fm = gid * WGM, gsz = (nM - fm) < WGM ? (nM - fm) : WGM;
        u.pm = fm + ((wgid % nig) % gsz); u.pn = (wgid % nig) / gsz; return true;
    }
    __device__ __forceinline__ void a_ready(const Unit&) const {}
    __device__ __forceinline__ void done(const Unit&) const {}
};
typedef float f32x2g __attribute__((ext_vector_type(2))); typedef __bf16 bf16x2g __attribute__((ext_vector_type(2)));
__device__ __forceinline__ unsigned cvt_pk_bf16(float lo, float hi) { const f32x2g v = {lo, hi}; const bf16x2g b = __builtin_convertvector(v, bf16x2g); return __builtin_bit_cast(unsigned, b); }
__device__ __forceinline__ float bflo(unsigned w) { return __builtin_bit_cast(float, w << 16); }
__device__ __forceinline__ float bfhi(unsigned w) { return __builtin_bit_cast(float, w & 0xffff0000u); }
__device__ __forceinline__ float sigm(float x) { return __builtin_amdgcn_rcpf(1.0f + __expf(-x)); }
__device__ __forceinline__ float tanh_f(float x) { const float e = __expf(2.0f * x); return 1.0f - 2.0f * __builtin_amdgcn_rcpf(1.0f + e); }

struct EpiSplitBf16 {
    static constexpr bool PERM = true, AFTER_DRAIN = false;
    bf16_t* O; int ldc; int split_cols; size_t split_stride;
    __device__ __forceinline__ void operator()(const f32x4 (&acc)[2][2][4][2], const Unit& u, int wr, int wc, int fr, int fq) const {
        const int row0 = u.pm * BM + wr * 64 + fr; int colt = u.pn * BM; bf16_t* base = O;
        { const int t = colt / split_cols; base += (size_t)t * split_stride; colt -= t * split_cols; }
        const int col0 = colt + wc * 32 + 8 * fq;
#pragma unroll
        for (int ai = 0; ai < 2; ++ai)
#pragma unroll
            for (int m = 0; m < 4; ++m) { bf16_t* rowp = base + (size_t)(row0 + ai * HALF + m * 16) * ldc + col0;
#pragma unroll
                for (int bj = 0; bj < 2; ++bj) { const f32x4 v0 = acc[ai][bj][m][0], v1 = acc[ai][bj][m][1];
                    u32x4 w; w.x = cvt_pk_bf16(v0[0], v0[1]); w.y = cvt_pk_bf16(v0[2], v0[3]); w.z = cvt_pk_bf16(v1[0], v1[1]); w.w = cvt_pk_bf16(v1[2], v1[3]);
                    *(u32x4*)(rowp + bj * HALF) = w; } }
    }
};

struct EpiGlu {
    static constexpr bool PERM = true, AFTER_DRAIN = false;
    const bf16_t* Y; bf16_t* Z; int ldc; const float* bias;
    __device__ __forceinline__ void operator()(const f32x4 (&acc)[2][2][4][2], const Unit& u, int wr, int wc, int fr, int fq) const {
        const int row0 = u.pm * BM + wr * 64 + fr; const int col0 = u.pn * BM + wc * 32 + 8 * fq;
#pragma unroll
        for (int bj = 0; bj < 2; ++bj) {
            const f32x4 b0 = *(const f32x4*)(bias + col0 + bj * HALF), b1 = *(const f32x4*)(bias + col0 + bj * HALF + 4);
#pragma unroll
            for (int ai = 0; ai < 2; ++ai)
#pragma unroll
                for (int m = 0; m < 4; ++m) {
                    const size_t off = (size_t)(row0 + ai * HALF + m * 16) * ldc + col0 + bj * HALF;
                    const u32x4 yy = *(const u32x4*)(Y + off); const u32x4 zz = *(const u32x4*)(Z + off);
                    const f32x4 t0 = acc[ai][bj][m][0] + b0, t1 = acc[ai][bj][m][1] + b1;
                    float o[8];
#define GLU1(k, yv, zv, tv) { const float y_ = (yv), z_ = (zv); o[k] = (y_ * z_) * __builtin_amdgcn_rcpf((1.0f + __expf(-(tv))) * (1.0f + __expf(-z_))); }
                    GLU1(0, bflo(yy.x), bflo(zz.x), t0[0]) GLU1(1, bfhi(yy.x), bfhi(zz.x), t0[1])
                    GLU1(2, bflo(yy.y), bflo(zz.y), t0[2]) GLU1(3, bfhi(yy.y), bfhi(zz.y), t0[3])
                    GLU1(4, bflo(yy.z), bflo(zz.z), t1[0]) GLU1(5, bfhi(yy.z), bfhi(zz.z), t1[1])
                    GLU1(6, bflo(yy.w), bflo(zz.w), t1[2]) GLU1(7, bfhi(yy.w), bfhi(zz.w), t1[3])
#undef GLU1
                    u32x4 w; w.x = cvt_pk_bf16(o[0], o[1]); w.y = cvt_pk_bf16(o[2], o[3]); w.z = cvt_pk_bf16(o[4], o[5]); w.w = cvt_pk_bf16(o[6], o[7]);
                    *(u32x4*)(Z + off) = w; }
        }
    }
};

struct EpiResid {
    static constexpr bool PERM = false, AFTER_DRAIN = false;
    const float* XIN; float* OUT; const float* CTXIN; float* XC; const float* MOD; int ctx_rows; int lat_row0;
    __device__ __forceinline__ void operator()(const f32x4 (&acc)[2][2][4][2], const Unit& u, int wr, int wc, int fr, int fq) const {
        const int row0 = u.pm * BM + wr * 64 + fr, col0 = u.pn * BM + wc * 32 + 4 * fq;
        const bool isctx = (u.pm * BM) < ctx_rows;
#pragma unroll
        for (int ai = 0; ai < 2; ++ai)
#pragma unroll
            for (int m = 0; m < 4; ++m) {
                const int row = row0 + ai * HALF + m * 16;
                const int rr = isctx ? row : (row - ctx_rows + lat_row0); const int gj = isctx ? 8 : (rr >> 11);
                const float* src = (isctx ? CTXIN : XIN) + (size_t)rr * 2048; float* dst = (isctx ? XC : OUT) + (size_t)rr * 2048; const float* gate = MOD + gj * 6144 + 4096;
#pragma unroll
                for (int bj = 0; bj < 2; ++bj)
#pragma unroll
                    for (int n = 0; n < 2; ++n) { const int c = col0 + bj * HALF + n * 16;
                        const f32x4 g4 = *(const f32x4*)(gate + c); const f32x4 x4 = *(const f32x4*)(src + c);
                        *(f32x4*)(dst + c) = x4 + g4 * acc[ai][bj][m][n]; }
            }
    }
};

struct EpiZLora {
    static constexpr bool PERM = true, AFTER_DRAIN = false;
    bf16_t* Zb; bf16_t* LW; bf16_t* LA;
    __device__ __forceinline__ void operator()(const f32x4 (&acc)[2][2][4][2], const Unit& u, int wr, int wc, int fr, int fq) const {
        const int row0 = u.pm * BM + wr * 64 + fr;
        if (u.pn < 16) {
            if (u.pm < 4) return;
            const int col0 = u.pn * BM + wc * 32 + 8 * fq;
#pragma unroll
            for (int ai = 0; ai < 2; ++ai)
#pragma unroll
                for (int m = 0; m < 4; ++m) { bf16_t* rowp = Zb + (size_t)(row0 + ai * HALF + m * 16) * 4096 + col0;
#pragma unroll
                    for (int bj = 0; bj < 2; ++bj) { const f32x4 v0 = acc[ai][bj][m][0], v1 = acc[ai][bj][m][1];
                        u32x4 w; w.x = cvt_pk_bf16(v0[0], v0[1]); w.y = cvt_pk_bf16(v0[2], v0[3]); w.z = cvt_pk_bf16(v1[0], v1[1]); w.w = cvt_pk_bf16(v1[2], v1[3]);
                        *(u32x4*)(rowp + bj * HALF) = w; } }
        } else {
            const bool isw = (u.pn == 16); bf16_t* base = isw ? LW : LA;
#pragma unroll
            for (int bj = 0; bj < 2; ++bj) {
                const int col = bj * HALF + wc * 32 + 8 * fq;
                if (col < 192) {
#pragma unroll
                    for (int ai = 0; ai < 2; ++ai)
#pragma unroll
                        for (int m = 0; m < 4; ++m) { f32x4 v0 = acc[ai][bj][m][0], v1 = acc[ai][bj][m][1];
                            if (isw) { v0[0] = tanh_f(v0[0]); v0[1] = tanh_f(v0[1]); v0[2] = tanh_f(v0[2]); v0[3] = tanh_f(v0[3]); v1[0] = tanh_f(v1[0]); v1[1] = tanh_f(v1[1]); v1[2] = tanh_f(v1[2]); v1[3] = tanh_f(v1[3]); }
                            u32x4 w; w.x = cvt_pk_bf16(v0[0], v0[1]); w.y = cvt_pk_bf16(v0[2], v0[3]); w.z = cvt_pk_bf16(v1[0], v1[1]); w.w = cvt_pk_bf16(v1[2], v1[3]);
                            *(u32x4*)(base + (size_t)(row0 + ai * HALF + m * 16) * 192 + col) = w; }
                }
            }
        }
    }
};
template <class Epi, class Sched, bool ALIGN_EPI = false, bool SP2 = false>
__device__ __forceinline__ void gemm_phase(PG8_LAS unsigned char* lds, const Gemm g, const Sched& S, const Epi& E) {
    int tid_l = threadIdx.x; asm volatile("" : "+v"(tid_l));
    const int tid = tid_l, wid = __builtin_amdgcn_readfirstlane(tid >> 6), lane = tid & 63, wr = wid >> 2, wc = wid & 3, fr = lane & 15, fq = lane >> 4;
    const int K = g.K, nt = K / BK;
    unsigned voffA[2], voffB[2];
#pragma unroll
    for (int i = 0; i < 2; ++i) { int R, C; stage_rc(tid * 16 + i * 8192, R, C); const int Rb = Epi::PERM ? ((R & ~31) + perm32(R & 31)) : R;
        voffA[i] = (unsigned)(R * K + C) * 2u; voffB[i] = (unsigned)(Rb * K + C) * 2u; }
    const size_t kstep = (size_t)(BK * 2);
    const size_t hstep = (size_t)HALF * K * 2;
    const size_t tstep = 2 * hstep;
    const unsigned ldsw = (unsigned)wid * 1024u;
    const int aoff = lds_byte(wr * 64 + fr, fq * 8), boff = lds_byte(wc * 32 + fr, fq * 8);
#define PG8_SA(b, h) (((b) * 2 + (h)) * HTB)
#define PG8_SB(b, h) ((4 + (b) * 2 + (h)) * HTB)
#define PG8_STAGE(bufoff, gbase, voff) do { _Pragma("unroll") for (int _i = 0; _i < 2; ++_i) \
        __builtin_amdgcn_global_load_lds((const unsigned*)((const char*)(gbase) + (voff)[_i]), (PG8_LAS unsigned*)(lds + (bufoff) + ldsw + _i * 8192), 16, 0, 0); } while (0)
#define PG8_LDA(dst, b, h) do { _Pragma("unroll") for (int m = 0; m < 4; ++m) _Pragma("unroll") for (int k = 0; k < 2; ++k) dst[m][k] = *(const PG8_LAS bf16x8*)(lds + PG8_SA(b, h) + aoff + m * 2048 + k * 1024); } while (0)
#define PG8_LDB(dst, b, h) do { _Pragma("unroll") for (int n = 0; n < 2; ++n) _Pragma("unroll") for (int k = 0; k < 2; ++k) dst[n][k] = *(const PG8_LAS bf16x8*)(lds + PG8_SB(b, h) + boff + n * 2048 + k * 1024); } while (0)
#define PG8_MMA(ai, bj, At, Bt) do { __builtin_amdgcn_s_setprio(1); _Pragma("unroll") for (int m = 0; m < 4; ++m) _Pragma("unroll") for (int n = 0; n < 2; ++n) _Pragma("unroll") for (int k = 0; k < 2; ++k) \
        acc[ai][bj][m][n] = __builtin_amdgcn_mfma_f32_16x16x32_bf16(Bt[n][k], At[m][k], acc[ai][bj][m][n], 0, 0, 0); __builtin_amdgcn_s_setprio(0); } while (0)
#define PG8_WAIT_V(n) asm volatile("s_waitcnt vmcnt(" #n ")" ::: "memory")
#define PG8_WAIT_L(n) asm volatile("s_waitcnt lgkmcnt(" #n ")" ::: "memory")
#define PG8_BAR __builtin_amdgcn_s_barrier()
#define PG8_SCHED __builtin_amdgcn_sched_barrier(0)
    Unit cur, nxt; int ui = 0;
    if (!S.next(0, cur)) return;
    f32x4 acc[2][2][4][2];
#pragma unroll
    for (int a = 0; a < 2; ++a)
#pragma unroll
        for (int b = 0; b < 2; ++b)
#pragma unroll
            for (int m = 0; m < 4; ++m)
#pragma unroll
                for (int n = 0; n < 2; ++n) acc[a][b][m][n] = (f32x4){0.f, 0.f, 0.f, 0.f};
    bf16x8 At[4][2], B0[2][2], B1[2][2];
    const char* cA = (const char*)g.A + PG8_AIDX(g, cur.pn) + (size_t)cur.pm * tstep; const char* cB = (const char*)g.Bt + (size_t)cur.pn * tstep;
    S.a_ready(cur);
    if constexpr (SP2) {
        PG8_STAGE(PG8_SB(0, 0), cB, voffB); PG8_STAGE(PG8_SB(0, 1), cB + hstep, voffB); PG8_STAGE(PG8_SA(0, 0), cA, voffA); PG8_STAGE(PG8_SA(0, 1), cA + hstep, voffA);
        if (wr == 1) PG8_BAR;
        PG8_WAIT_V(2); PG8_BAR;
        PG8_STAGE(PG8_SB(1, 0), cB + kstep, voffB); PG8_STAGE(PG8_SA(1, 0), cA + kstep, voffA); PG8_STAGE(PG8_SB(1, 1), cB + hstep + kstep, voffB);
        PG8_WAIT_V(6); PG8_BAR;
    } else {
        PG8_STAGE(PG8_SB(0, 0), cB, voffB); PG8_STAGE(PG8_SA(0, 0), cA, voffA); PG8_STAGE(PG8_SB(0, 1), cB + hstep, voffB); PG8_STAGE(PG8_SA(0, 1), cA + hstep, voffA);
        if (wr == 1) PG8_BAR;
        PG8_WAIT_V(4); PG8_BAR;
        PG8_STAGE(PG8_SB(1, 0), cB + kstep, voffB); PG8_STAGE(PG8_SA(1, 0), cA + kstep, voffA); PG8_STAGE(PG8_SB(1, 1), cB + hstep + kstep, voffB);
        PG8_WAIT_V(6); PG8_BAR;
    }
    for (;;) {
        const bool has_next = S.next(ui + 1, nxt);
        const char* nA = has_next ? (const char*)g.A + PG8_AIDX(g, nxt.pn) + (size_t)nxt.pm * tstep : cA; const char* nB = has_next ? (const char*)g.Bt + (size_t)nxt.pn * tstep : cB;
        for (int t = 0; t < nt; t += 2) {
            const bool last = (t == nt - 2);
            const char* a1 = cA + (size_t)(t + 1) * kstep;
            const char* a2 = last ? nA : cA + (size_t)(t + 2) * kstep; const char* b2 = last ? nB : cB + (size_t)(t + 2) * kstep;
            const char* a3 = a2 + kstep; const char* b3 = b2 + kstep;
            if (last && has_next) S.a_ready(nxt);
            if constexpr (SP2) {
            PG8_LDB(B0, 0, 0); PG8_LDB(B1, 0, 1); PG8_SCHED; PG8_LDA(At, 0, 0); PG8_STAGE(PG8_SA(1, 1), a1 + hstep, voffA);
            PG8_WAIT_V(8); PG8_WAIT_L(0); PG8_BAR; PG8_MMA(0, 0, At, B0); PG8_MMA(0, 1, At, B1); PG8_BAR; PG8_SCHED;
            PG8_LDA(At, 0, 1); PG8_STAGE(PG8_SB(0, 0), b2, voffB); PG8_STAGE(PG8_SB(0, 1), b2 + hstep, voffB); PG8_STAGE(PG8_SA(0, 0), a2, voffA);
            PG8_WAIT_V(8); PG8_WAIT_L(0); PG8_BAR; PG8_MMA(1, 0, At, B0); PG8_MMA(1, 1, At, B1); PG8_BAR; PG8_SCHED;
            PG8_LDB(B0, 1, 0); PG8_LDB(B1, 1, 1); PG8_SCHED; PG8_LDA(At, 1, 0); PG8_STAGE(PG8_SA(0, 1), a2 + hstep, voffA);
            PG8_WAIT_V(8); PG8_WAIT_L(0); PG8_BAR; PG8_MMA(0, 0, At, B0); PG8_MMA(0, 1, At, B1); PG8_BAR; PG8_SCHED;
            PG8_LDA(At, 1, 1); PG8_STAGE(PG8_SB(1, 0), b3, voffB); PG8_STAGE(PG8_SB(1, 1), b3 + hstep, voffB); PG8_STAGE(PG8_SA(1, 0), a3, voffA);
            PG8_WAIT_V(8); PG8_WAIT_L(0); PG8_BAR; PG8_MMA(1, 0, At, B0); PG8_MMA(1, 1, At, B1); PG8_BAR; PG8_SCHED;
            } else {
            PG8_LDB(B0, 0, 0); PG8_SCHED; PG8_LDA(At, 0, 0); PG8_STAGE(PG8_SA(1, 1), a1 + hstep, voffA);
            PG8_WAIT_L(8); PG8_BAR; PG8_WAIT_L(0); PG8_MMA(0, 0, At, B0); PG8_BAR; PG8_SCHED;
            PG8_LDB(B1, 0, 1); PG8_STAGE(PG8_SB(0, 0), b2, voffB);
            PG8_BAR; PG8_WAIT_L(0); PG8_MMA(0, 1, At, B1); PG8_BAR;
            PG8_LDA(At, 0, 1); PG8_STAGE(PG8_SA(0, 0), a2, voffA);
            PG8_BAR; PG8_WAIT_L(0); PG8_MMA(1, 0, At, B0); PG8_BAR; PG8_SCHED;
            PG8_STAGE(PG8_SB(0, 1), b2 + hstep, voffB);
            PG8_WAIT_V(6); PG8_BAR; PG8_MMA(1, 1, At, B1); PG8_BAR;
            PG8_LDB(B0, 1, 0); PG8_SCHED; PG8_LDA(At, 1, 0); PG8_STAGE(PG8_SA(0, 1), a2 + hstep, voffA);
            PG8_WAIT_L(8); PG8_BAR; PG8_WAIT_L(0); PG8_MMA(0, 0, At, B0); PG8_BAR; PG8_SCHED;
            PG8_LDB(B1, 1, 1); PG8_STAGE(PG8_SB(1, 0), b3, voffB);
            PG8_BAR; PG8_WAIT_L(0); PG8_MMA(0, 1, At, B1); PG8_BAR;
            PG8_LDA(At, 1, 1); PG8_STAGE(PG8_SA(1, 0), a3, voffA);
            PG8_BAR; PG8_WAIT_L(0); PG8_MMA(1, 0, At, B0); PG8_BAR; PG8_SCHED;
            PG8_STAGE(PG8_SB(1, 1), b3 + hstep, voffB);
            PG8_WAIT_V(6); PG8_BAR; PG8_MMA(1, 1, At, B1); PG8_BAR;
            }
        }
        if constexpr (ALIGN_EPI) { if (wr == 0) PG8_BAR; }
        if constexpr (!Epi::AFTER_DRAIN) { E(acc, cur, wr, wc, fr, fq); S.done(cur); }
        if (!has_next) break;
#pragma unroll
        for (int a = 0; a < 2; ++a)
#pragma unroll
            for (int b = 0; b < 2; ++b)
#pragma unroll
                for (int m = 0; m < 4; ++m)
#pragma unroll
                    for (int n = 0; n < 2; ++n) acc[a][b][m][n] = (f32x4){0.f, 0.f, 0.f, 0.f};
        cur = nxt; cA = nA; cB = nB; ++ui;
        if constexpr (ALIGN_EPI) { if (wr == 1) PG8_BAR; }
    }
    PG8_WAIT_V(0);
    if constexpr (!ALIGN_EPI) { if (wr == 0) PG8_BAR; }
    PG8_BAR;
    if constexpr (Epi::AFTER_DRAIN) { E.fused(acc, cur, wr, wc, fr, fq, lds, wid, lane); S.done(cur); }
#undef PG8_SA
#undef PG8_SB
#undef PG8_STAGE
#undef PG8_LDA
#undef PG8_LDB
#undef PG8_MMA
#undef PG8_WAIT_V
#undef PG8_WAIT_L
#undef PG8_BAR
#undef PG8_SCHED
}
}

#define LAS __attribute__((address_space(3)))
typedef unsigned short bf16;
typedef short bf16x8 __attribute__((ext_vector_type(8)));
typedef float f32x4 __attribute__((ext_vector_type(4)));
typedef float f32x16 __attribute__((ext_vector_type(16)));
typedef unsigned u32x4 __attribute__((ext_vector_type(4)));
typedef unsigned u32x2 __attribute__((ext_vector_type(2)));

constexpr int NT = 512;
constexpr int LDS_BYTES = 147456;
constexpr size_t MiB = 1u << 20;
constexpr size_t WS_MOD = 0;
constexpr size_t MOD_BYTES = 2 * 9 * 6144 * 4;
constexpr size_t WS_BAR = 448 * 1024;
constexpr size_t ZERO_BYTES = WS_BAR + 3456 * 4;
constexpr int LDS_BARST = LDS_BYTES - 64;
constexpr size_t WS_QP = 1 * MiB;
constexpr size_t WS_W2T = 3 * MiB;
constexpr size_t WS_A2T = WS_W2T + 2 * 4096 * 96 * 2;
constexpr size_t WS_XC = 6 * MiB;
constexpr size_t WS_WB = 22 * MiB;
constexpr size_t WB_L0_IN = WS_WB, WB_L0_GLU = WS_WB + 32 * MiB, WB_L0_OUT = WS_WB + 64 * MiB;
constexpr size_t WB_L1_IN = WS_WB, WB_L1_OUT = WS_WB + 66 * MiB;
constexpr size_t WS_BIG = 106 * MiB;
constexpr size_t WS_U = WS_BIG, WS_Z = WS_BIG + 144 * MiB, WS_Y = WS_BIG + 288 * MiB;
constexpr size_t WS_H1 = WS_BIG, WS_A = WS_BIG + 36 * MiB, WS_RKV = WS_BIG + 144 * MiB, WS_ZB = WS_BIG + 360 * MiB;
constexpr size_t WS_END = WS_BIG + 432 * MiB;
constexpr size_t A_STRIDE = (size_t)9216 * 2048 * 2;
constexpr size_t WS_YP = WS_A;
constexpr size_t ZB_LW = 0, ZB_LA = (size_t)9216 * 192 * 2;

struct Params { const float* in[37]; float* out; unsigned char* ws; };
typedef const __attribute__((address_space(4))) Params* PPtr;
#define GETP PPtr P = (PPtr)__builtin_amdgcn_kernarg_segment_ptr(); asm volatile("" : "+s"(P));

typedef float f32x2c __attribute__((ext_vector_type(2)));
typedef __bf16 bf16x2c __attribute__((ext_vector_type(2)));
__device__ __forceinline__ unsigned pk2(float lo, float hi) { const f32x2c v = {lo, hi}; const bf16x2c b = __builtin_convertvector(v, bf16x2c); return __builtin_bit_cast(unsigned, b); }
__device__ __forceinline__ unsigned f2bf(float f) { const __bf16 b = (__bf16)f; return (unsigned)__builtin_bit_cast(unsigned short, b); }
__device__ __forceinline__ unsigned f2bf_lo16(float f) { return f2bf(f); }
__device__ __forceinline__ float bf2f(unsigned h) { return __builtin_bit_cast(float, h << 16); }
__device__ __forceinline__ float blo(unsigned w) { return __builtin_bit_cast(float, w << 16); }
__device__ __forceinline__ float bhi(unsigned w) { return __builtin_bit_cast(float, w & 0xffff0000u); }
__device__ __forceinline__ float wave_sum(float v) {
#pragma unroll
    for (int o = 1; o < 64; o <<= 1) v += __shfl_xor(v, o);
    return v;
}
#define DPPF(v, ctrl) __builtin_bit_cast(float, __builtin_amdgcn_update_dpp(0, __builtin_bit_cast(int, (v)), (ctrl), 0xF, 0xF, true))
__device__ __forceinline__ float red8(float v) { v += DPPF(v, 0xB1); v += DPPF(v, 0x4E); v += DPPF(v, 0x141); return v; }
__device__ __forceinline__ float red16(float v) { v = red8(v); v += DPPF(v, 0x128); return v; }
__device__ __forceinline__ float sigmoidf_(float x) { return __builtin_amdgcn_rcpf(1.0f + __expf(-x)); }

#define XB_TMO      128
#define XB_XCNT(j)  (256  + 64 * (j))
#define XB_XSUB(j)  (1280 + 64 * (j))
#define XB_XGEN(j)  (2304 + 64 * (j))
#define XB_TOP      3328
#define XB_TOPGEN   3392
#define XCD_BAR_WORDS 3456
#define XB_SPIN_CAP (1u << 18)

__device__ __forceinline__ unsigned xb_ld(unsigned* p)              { return __hip_atomic_load(p, __ATOMIC_RELAXED, __HIP_MEMORY_SCOPE_AGENT); }
__device__ __forceinline__ unsigned xb_add(unsigned* p, unsigned v) { return __hip_atomic_fetch_add(p, v, __ATOMIC_RELAXED, __HIP_MEMORY_SCOPE_AGENT); }
__device__ __forceinline__ unsigned xb_xcc_id() { return (unsigned)__builtin_amdgcn_s_getreg((3 << 11) | 20) & 0xFu; }
#define XB_SPIN(cond, bar) do { unsigned _sp = 0; while (cond) { __builtin_amdgcn_s_sleep(1); \
    if ((++_sp & 255u) == 0u) { if (xb_ld(&(bar)[XB_TMO])) break; if (_sp > XB_SPIN_CAP) { atomicAdd(&(bar)[XB_TMO], 1u); break; } } } } while (0)

struct XcdBarrier {
    unsigned* bar; unsigned x;
    volatile LAS unsigned* st;
};

__device__ __forceinline__ XcdBarrier xcd_barrier_post(unsigned* bar, volatile LAS unsigned* st) {
    XcdBarrier b; b.bar = bar; b.x = xb_xcc_id(); b.st = st;
    if (threadIdx.x == 0) (void)xb_add(&bar[XB_XCNT(b.x)], 1u);
    return b;
}
__device__ __forceinline__ void xcd_barrier_complete(unsigned* bar, unsigned x, unsigned& nloc, unsigned& nx) {
    const unsigned G = gridDim.x * gridDim.y * gridDim.z;
    unsigned sum, cnt, mine, sp = 0u;
    for (;;) {
        sum = 0u; cnt = 0u; mine = 0u;
#pragma unroll
        for (unsigned j = 0; j < 16; ++j) { const unsigned c = xb_ld(&bar[XB_XCNT(j)]); sum += c; cnt += (c > 0u) ? 1u : 0u; mine = (j == x) ? c : mine; }
        if (sum == G) break;
        __builtin_amdgcn_s_sleep(1);
        if ((++sp & 255u) == 0u) { if (xb_ld(&bar[XB_TMO])) break; if (sp > XB_SPIN_CAP) { atomicAdd(&bar[XB_TMO], 1u); break; } }
    }
    nloc = mine > 0u ? mine : 1u; nx = cnt > 0u ? cnt : 1u;
}

__device__ __forceinline__ void xcd_barrier(const XcdBarrier& b) {
    asm volatile("s_waitcnt vmcnt(0)" ::: "memory");
    __syncthreads();
    if (threadIdx.x == 0) {
        unsigned* bar = b.bar;
        __builtin_amdgcn_s_waitcnt(0);
        unsigned nloc = b.st[0], nx = b.st[1];
        if (nloc == 0u) { xcd_barrier_complete(bar, b.x, nloc, nx); b.st[0] = nloc; b.st[1] = nx; }
        const unsigned old = xb_add(&bar[XB_XSUB(b.x)], 1u);
        const unsigned gen = old / nloc;
        if (old + 1u == (gen + 1u) * nloc) {
            __builtin_amdgcn_fence(__ATOMIC_RELEASE, "agent");
            asm volatile("s_waitcnt vmcnt(0)" ::: "memory");
            const unsigned og = xb_add(&bar[XB_TOP], 1u);
            const unsigned tg = og / nx;
            if (og + 1u == (tg + 1u) * nx) xb_add(&bar[XB_TOPGEN], 1u);
            else XB_SPIN(xb_ld(&bar[XB_TOPGEN]) == tg, bar);
            __builtin_amdgcn_fence(__ATOMIC_ACQUIRE, "agent");
            xb_add(&bar[XB_XGEN(b.x)], 1u);
            asm volatile("s_waitcnt vmcnt(0)" ::: "memory");
        } else {
            XB_SPIN(xb_ld(&bar[XB_XGEN(b.x)]) == gen, bar);
            __builtin_amdgcn_fence(__ATOMIC_ACQUIRE, "agent");
            asm volatile("s_waitcnt vmcnt(0)" ::: "memory");
        }
    }
    __syncthreads();
}

__device__ __forceinline__ void transpose_item(const float* W, int K, int N, bf16* WT, int row_off, LAS float* scr, int item, int lane) {
    const int nblk = N / 32, kb = item / nblk, nb = item % nblk, k0 = 64 * kb, n0 = 32 * nb;
    float tv[32];
#pragma unroll
    for (int i = 0; i < 32; ++i) { const int kk = 2 * i + (lane >> 5); tv[i] = W[(size_t)(k0 + kk) * N + n0 + (lane & 31)]; }
#pragma unroll
    for (int i = 0; i < 32; ++i) { const int kk = 2 * i + (lane >> 5); scr[kk * 33 + (lane & 31)] = tv[i]; }
    asm volatile("s_waitcnt lgkmcnt(0)" ::: "memory");
    const int c = lane & 7;
#pragma unroll
    for (int j = 0; j < 4; ++j) { const int n = (lane >> 3) + 8 * j; const LAS float* s = scr + (8 * c) * 33 + n;
        u32x4 o; o.x = pk2(s[0 * 33], s[1 * 33]); o.y = pk2(s[2 * 33], s[3 * 33]); o.z = pk2(s[4 * 33], s[5 * 33]); o.w = pk2(s[6 * 33], s[7 * 33]);
        *(u32x4*)(WT + (size_t)(row_off + n0 + n) * K + k0 + 8 * c) = o; }
    asm volatile("s_waitcnt lgkmcnt(0)" ::: "memory");
}

__device__ __forceinline__ void mod_task(PPtr P, float* MOD, LAS float* sil, int tk, int tid) {
    const int layer = tk / 384, rem = tk % 384, ks = rem / 12, nb = rem % 12;
    const float* ada_w = P->in[layer ? 20 : 5]; const float* ada_b = P->in[layer ? 21 : 6];
    const float* c = P->in[1]; const float* cc = P->in[3];
    const int k0 = ks * 64, n = nb * 512 + tid;
    __syncthreads();
    for (int idx = tid; idx < 64 * 9; idx += NT) { const int k = idx / 9, j = idx % 9; const float v = (j < 8) ? c[j * 2048 + k0 + k] : cc[k0 + k]; sil[idx] = v * sigmoidf_(v); }
    __syncthreads();
    float acc[9];
#pragma unroll
    for (int j = 0; j < 9; ++j) acc[j] = 0.f;
#pragma unroll 1
    for (int kb = 0; kb < 64; kb += 16) { float w[16];
#pragma unroll
        for (int k = 0; k < 16; ++k) w[k] = ada_w[(size_t)(k0 + kb + k) * 6144 + n];
#pragma unroll
        for (int k = 0; k < 16; ++k)
#pragma unroll
            for (int j = 0; j < 9; ++j) acc[j] += sil[(kb + k) * 9 + j] * w[k]; }
    const float bb = (ks == 0) ? ada_b[n] : 0.f;
#pragma unroll
    for (int j = 0; j < 9; ++j) atomicAdd(MOD + (size_t)(layer * 9 + j) * 6144 + n, acc[j] + bb);
}

__device__ __forceinline__ void normmod_row(const float* xrow, const float* g, const float* mod  , bf16* orow, int lane) {
    f32x4 v[8]; float s = 0.f;
#pragma unroll
    for (int j = 0; j < 8; ++j) { v[j] = ((const f32x4*)xrow)[lane + 64 * j]; s += (v[j].x * v[j].x + v[j].y * v[j].y) + (v[j].z * v[j].z + v[j].w * v[j].w); }
    const float rstd = 1.0f / sqrtf(wave_sum(s) * (1.0f / 2048.0f) + 1e-6f);
#pragma unroll
    for (int j = 0; j < 8; ++j) { const int c4 = lane + 64 * j; const f32x4 gg = ((const f32x4*)g)[c4], sh = ((const f32x4*)mod)[c4], sc = ((const f32x4*)(mod + 2048))[c4];
        const f32x4 y = v[j] * rstd * gg * (sc + 1.0f) + sh;
        u32x2 o; o.x = pk2(y.x, y.y); o.y = pk2(y.z, y.w); ((u32x2*)orow)[c4] = o; }
}

constexpr int S5_ROWB = 528;
constexpr int S5_WLDS = 32 * S5_ROWB;
__device__ __forceinline__ float gelu_tanh(float x) { const float u = 0.7978845608028654f * (x + 0.044715f * x * x * x); const float e = __expf(2.0f * u); return x * (1.0f - __builtin_amdgcn_rcpf(1.0f + e)); }

__device__ __forceinline__ void s5_phase(PPtr P, LAS unsigned char* lds, int wave, int lane) {
    const float* a_re = P->in[8]; const float* a_im = P->in[9]; const float* lstep = P->in[10];
    const float* b_re = P->in[11]; const float* b_im = P->in[12]; const float* c_re = P->in[13]; const float* c_im = P->in[14]; const float* dskip = P->in[15];
    const bf16* U = (const bf16*)(P->ws + WS_U); bf16* Y = (bf16*)(P->ws + WS_Y);
    LAS unsigned char* wl = lds + wave * S5_WLDS;
    const int d = wave >> 2;
    for (int round = blockIdx.x; round < 512; round += gridDim.x) {
        const int unit = round * 4 + (wave & 3), b = unit >> 8, g = unit & 255, dg = d * 256 + g;
        const float dt = expf(lstep[dg]);
        float abr, abi;
        { const float are = a_re[dg * 64 + lane], aim = a_im[dg * 64 + lane]; const float mag = expf(dt * are); abr = mag * cosf(dt * aim); abi = mag * sinf(dt * aim); }
        bf16x8 Bf[4];
#pragma unroll
        for (int nn = 0; nn < 2; ++nn) {
            const int n = (lane & 31) + 32 * nn; const float are = a_re[dg * 64 + n], aim = a_im[dg * 64 + n];
            const float mag = expf(dt * are), cr = mag * cosf(dt * aim), ci = mag * sinf(dt * aim), den = are * are + aim * aim, nr = cr - 1.0f, ni = ci;
            const float fre = (nr * are + ni * aim) / den, fim = (ni * are - nr * aim) / den;
            const float* br = b_re + ((size_t)dg * 64 + n) * 16 + 8 * (lane >> 5); const float* bi = b_im + ((size_t)dg * 64 + n) * 16 + 8 * (lane >> 5);
#pragma unroll
            for (int j = 0; j < 8; ++j) { const float xr = br[j], xi = bi[j]; Bf[nn][j] = (short)f2bf(fre * xr - fim * xi); Bf[2 + nn][j] = (short)f2bf(fre * xi + fim * xr); }
        }
        bf16x8 Cf[4];
#pragma unroll
        for (int ks = 0; ks < 4; ++ks) { const int k = 32 * ks + 8 * (lane >> 4); const int o = lane & 15;
            const float* cr = c_re + ((size_t)dg * 16 + o) * 64 + (k >> 1); const float* cim = c_im + ((size_t)dg * 16 + o) * 64 + (k >> 1);
#pragma unroll
            for (int j = 0; j < 8; ++j) Cf[ks][j] = (short)f2bf((j & 1) ? -cim[j >> 1] : cr[j >> 1]); }
        const f32x4 dska = *(const f32x4*)(dskip + g * 16 + (lane & 1) * 8), dskb = *(const f32x4*)(dskip + g * 16 + (lane & 1) * 8 + 4);
        float hr = 0.f, hi = 0.f;
#define S5CH(cs_) const bool isctx = (cs_) < 8; const int ci = isctx ? (cs_) : (cs_) - 8, nch = isctx ? 8 : 64; const int tc = d ? (nch - 1 - ci) : ci; \
        const size_t rowbase = isctx ? (size_t)b * 256 : (size_t)2048 + (size_t)b * 2048;
#define S5AF(dst, cs_) { S5CH(cs_) (void)ci; const int i_ = lane & 31; const int t_ = 32 * tc + (d ? 31 - i_ : i_); dst = *(const bf16x8*)(U + (rowbase + t_) * 4096 + g * 16 + 8 * (lane >> 5)); }
        bf16x8 Anext; { const int c0 = 0; S5AF(Anext, c0) }
        for (int cs = 0; cs < 72; ++cs) {
            S5CH(cs) const bool first = ci < (nch >> 1);
            const bf16x8 Af = Anext;
            if (cs + 1 < 72) { const int c1 = cs + 1; S5AF(Anext, c1) }
            const int oi = lane >> 1, oh = lane & 1; const int ot = 32 * tc + (d ? 31 - oi : oi);
            const size_t opos = (rowbase + ot) * 4096 + g * 16 + oh * 8;
            u32x4 pyv = {0u, 0u, 0u, 0u}, puv = {0u, 0u, 0u, 0u};
            if (!first) { pyv = *(const u32x4*)(Y + opos); puv = *(const u32x4*)(U + opos); }
            { f32x16 z16; for (int q = 0; q < 16; ++q) z16[q] = 0.f;
#pragma unroll
              for (int nh = 0; nh < 2; ++nh) {
                  const f32x16 rr = __builtin_amdgcn_mfma_f32_32x32x16_bf16(Af, Bf[nh], z16, 0, 0, 0), ri = __builtin_amdgcn_mfma_f32_32x32x16_bf16(Af, Bf[2 + nh], z16, 0, 0, 0);
#pragma unroll
                  for (int reg = 0; reg < 16; ++reg) { const int ii = (reg & 3) + 8 * (reg >> 2) + 4 * (lane >> 5);
                      *(LAS f32x2c*)(wl + ii * S5_ROWB + ((lane & 31) + 32 * nh) * 8) = (f32x2c){rr[reg], ri[reg]}; } } }
#pragma unroll 16
            for (int i = 0; i < 32; ++i) { const f32x2c bu = *(LAS f32x2c*)(wl + i * S5_ROWB + lane * 8);
                const float nhr = abr * hr - abi * hi + bu.x, nhi = abr * hi + abi * hr + bu.y; hr = nhr; hi = nhi;
                *(LAS unsigned*)(wl + i * S5_ROWB + lane * 4) = pk2(hr, hi); }
#pragma unroll
            for (int mt = 0; mt < 2; ++mt) { f32x4 yv = {0.f, 0.f, 0.f, 0.f};
#pragma unroll
                for (int ks = 0; ks < 4; ++ks) { const bf16x8 Hf = *(const LAS bf16x8*)(wl + (16 * mt + (lane & 15)) * S5_ROWB + (32 * ks + 8 * (lane >> 4)) * 2);
                    yv = __builtin_amdgcn_mfma_f32_16x16x32_bf16(Hf, Cf[ks], yv, 0, 0, 0); }
#pragma unroll
                for (int reg = 0; reg < 4; ++reg) *(LAS float*)(wl + (16 * mt + 4 * (lane >> 4) + reg) * S5_ROWB + 256 + (lane & 15) * 4) = yv[reg]; }
            asm volatile("" ::: "memory");
            { const f32x4 ya = *(LAS f32x4*)(wl + oi * S5_ROWB + 256 + oh * 32), yb = *(LAS f32x4*)(wl + oi * S5_ROWB + 256 + oh * 32 + 16);
              u32x4 o;
              if (first) { o = (u32x4){pk2(ya.x, ya.y), pk2(ya.z, ya.w), pk2(yb.x, yb.y), pk2(yb.z, yb.w)}; }
              else {
#define S5G(yv_, pw_, uw_, dk_, hi_) gelu_tanh((yv_) + ((hi_) ? bhi(pw_) : blo(pw_)) + (dk_) * ((hi_) ? bhi(uw_) : blo(uw_)))
                  o.x = pk2(S5G(ya.x, pyv.x, puv.x, dska.x, 0), S5G(ya.y, pyv.x, puv.x, dska.y, 1)); o.y = pk2(S5G(ya.z, pyv.y, puv.y, dska.z, 0), S5G(ya.w, pyv.y, puv.y, dska.w, 1));
                  o.z = pk2(S5G(yb.x, pyv.z, puv.z, dskb.x, 0), S5G(yb.y, pyv.z, puv.z, dskb.y, 1)); o.w = pk2(S5G(yb.z, pyv.w, puv.w, dskb.z, 0), S5G(yb.w, pyv.w, puv.w, dskb.w, 1));
#undef S5G
              }
              *(u32x4*)(Y + opos) = o; }
            asm volatile("" ::: "memory");
            if (ci == (nch >> 1) - 1) __syncthreads();
        }
        __syncthreads();
#undef S5CH
#undef S5AF
    }
}

typedef float f32x2 __attribute__((ext_vector_type(2)));
constexpr int RW_ARR = 16 * 64 * 4;
constexpr int RO_TT = 0, RO_WD = 8704, RO_PA = 21760, RO_Q = 62720, RO_AR = 63232, RO_BK = 77056, RO_BKT = 86272, RO_WL = 103168, RO_VB = 103936, RO_G = 112640, RO_ZT = 117248, RO_MM = 120064, RO_PW = 122880, RO_Y = 133120, RO_CST = 141824, RW_END = 143104;
constexpr int T_ROW = 88, BKT_SLOT = 64 * T_ROW, ZT_SLOT = 16 * T_ROW;
constexpr int W_ROW = 68, W_SLOT = 16 * W_ROW * 4;
constexpr int VB_ROW = 136, VB_SLOT = 16 * VB_ROW, Y_ROW = 68, Y_SLOT = 16 * Y_ROW * 4;
static_assert(RW_END <= LDS_BYTES - 64, "rwkv LDS map");
__device__ __forceinline__ void rwkv_phase(PPtr P, LAS unsigned char* lds, int hb, int tid) {
    const float* w0 = P->in[24]; const float* a0 = P->in[27]; const float* k_k = P->in[30]; const float* k_a = P->in[31]; const float* r_k = P->in[32];
    const float* ln_w = P->in[33]; const float* ln_b = P->in[34];
    const bf16* RB = (const bf16*)(P->ws + WS_RKV); const bf16* KB = RB + (size_t)9216 * 4096; const bf16* VB = KB + (size_t)9216 * 4096;
    bf16* ZB = (bf16*)(P->ws + WS_ZB); const bf16* LW = (const bf16*)(P->ws + WS_ZB + ZB_LW); const bf16* LA = (const bf16*)(P->ws + WS_ZB + ZB_LA);
    const bf16* W2T = (const bf16*)(P->ws + WS_W2T); const bf16* A2T = (const bf16*)(P->ws + WS_A2T);
    bf16* YP = (bf16*)(P->ws + WS_YP); float* QP = (float*)(P->ws + WS_QP);
    const int wid = __builtin_amdgcn_readfirstlane(tid >> 6), lane0 = tid & 63;
#define LANEVARS int lnv = lane0; asm volatile("" : "+v"(lnv)); const int lane = lnv, fr = lane & 15, fq = lane >> 4; (void)fr; (void)fq;
#define BAR_LDS() do { asm volatile("s_waitcnt lgkmcnt(0)" ::: "memory"); __builtin_amdgcn_s_barrier(); asm volatile("" ::: "memory"); } while (0)
#define STH(p, v) (*(LAS unsigned short*)(p) = (unsigned short)f2bf_lo16(v))
#define CHUNK(c_, tc_, rb_) const bool ic_##c_ = (c_) < 16; const int ci_##c_ = ic_##c_ ? (c_) : (c_) - 16, nch_##c_ = ic_##c_ ? 16 : 128; \
        const int tc_ = d ? (nch_##c_ - 1 - ci_##c_) : ci_##c_; const size_t rb_ = ic_##c_ ? (size_t)bl * 256 : (size_t)1024 + (size_t)bl * 2048;
#define CST(a_, nq_) (*(LAS f32x4*)((LAS float*)(lds + RO_CST) + (a_) * 64 + 4 * (nq_)))
    for (int pr = blockIdx.x; pr < 256; pr += gridDim.x) {
        const int bl = pr >> 6, h = pr & 63;
        __syncthreads();
        if (tid < 320) { const int a_ = tid >> 6, c_ = tid & 63; const float* src = a_ == 0 ? k_k : (a_ == 1 ? k_a : (a_ == 2 ? r_k : (a_ == 3 ? ln_w : ln_b))); ((LAS float*)(lds + RO_CST))[tid] = src[h * 64 + c_]; }
        for (int d = 0; d < 2; ++d) {
            __syncthreads();
            f32x4 St[4];
#pragma unroll
            for (int nt = 0; nt < 4; ++nt) St[nt] = (f32x4){0.f, 0.f, 0.f, 0.f};
            bf16x8 Bw[3], Ba[3]; float w0v = 0.f, a0v = 0.f;
            u32x4 PF[6];
#pragma unroll
            for (int j = 0; j < 6; ++j) PF[j] = (u32x4){0u, 0u, 0u, 0u};
#pragma unroll
            for (int ks = 0; ks < 3; ++ks) { Bw[ks] = (bf16x8){0, 0, 0, 0, 0, 0, 0, 0}; Ba[ks] = Bw[ks]; }
#define PFLO(v, j) ((j) & 1 ? (u32x2){(v).z, (v).w} : (u32x2){(v).x, (v).y})
#define PFSET(v, j, val) { const u32x2 t_ = (val); if ((j) & 1) { (v).z = t_.x; (v).w = t_.y; } else { (v).x = t_.x; (v).y = t_.y; } }
#define LPREF(c_) { CHUNK(c_, tc_, rb_) const size_t row_ = rb_ + 16 * tc_ + (d ? 15 - fr : fr); const bf16* lwr = LW + row_ * 192 + d * 96 + 8 * fq; const bf16* lar = LA + row_ * 192 + d * 96 + 8 * fq; \
                _Pragma("unroll") for (int ks = 0; ks < 3; ++ks) { PF[ks] = *(const u32x4*)(lwr + 32 * ks); PF[3 + ks] = *(const u32x4*)(lar + 32 * ks); } }
            if (wid < 4) { LANEVARS
                const size_t rowo = ((size_t)d * 4096 + h * 64 + 16 * wid + fr) * 96 + 8 * fq;
#pragma unroll
                for (int ks = 0; ks < 3; ++ks) { Bw[ks] = *(const bf16x8*)(W2T + rowo + 32 * ks); Ba[ks] = *(const bf16x8*)(A2T + rowo + 32 * ks); }
                const int hn1 = h * 64 + 16 * wid + fr; w0v = w0[d * 4096 + hn1]; a0v = a0[d * 4096 + hn1];
                { const int c0 = 0; LPREF(c0) } }
            f32x4 cKK = {0.f, 0.f, 0.f, 0.f}, cKA = cKK, cRK = cKK;
            if (wid == 5 || wid == 6) { LANEVARS cKK = CST(0, fr); cKA = CST(1, fr); cRK = CST(2, fr); }
            if (wid == 4) { LANEVARS cKK = CST(3, fr); cKA = CST(4, fr); }
            for (int it = -4; it <= 144; ++it) {
                LANEVARS
                if (wid < 4) {
                    if (it >= 0 && it <= 143) { const int c = it;
                        LAS unsigned char* oAR = lds + RO_AR + (c % 3) * 4608; LAS unsigned char* oBKT = lds + RO_BKT + (c % 3) * BKT_SLOT; LAS float* aWL = (LAS float*)(lds + RO_WL + (c % 3) * 256);
                        LAS unsigned char* oVB = lds + RO_VB + (c & 3) * VB_SLOT; LAS unsigned char* oZT = lds + RO_ZT + (c & 1) * ZT_SLOT; LAS unsigned char* oMM = lds + RO_MM + (c & 1) * ZT_SLOT;
                        LAS float* aY = (LAS float*)(lds + RO_Y + (c & 1) * Y_SLOT);
#define PERMK(base_, rowbytes_) ({ const u32x2 lo_ = *(const LAS u32x2*)((base_) + (rowbytes_) + 8 * fq), hi_ = *(const LAS u32x2*)((base_) + (rowbytes_) + 32 + 8 * fq); __builtin_bit_cast(bf16x8, (u32x4){lo_.x, lo_.y, hi_.x, hi_.y}); })
                        f32x4 XuT = {0.f, 0.f, 0.f, 0.f}, XrT = {0.f, 0.f, 0.f, 0.f};
#pragma unroll
                        for (int ks = 0; ks < 2; ++ks) {
                            const u32x4 bs = {pk2(St[2 * ks][0], St[2 * ks][1]), pk2(St[2 * ks][2], St[2 * ks][3]), pk2(St[2 * ks + 1][0], St[2 * ks + 1][1]), pk2(St[2 * ks + 1][2], St[2 * ks + 1][3])};
                            const bf16x8 A0 = PERMK(oAR, fr * 144 + 64 * ks), A1 = PERMK(oAR, (16 + fr) * 144 + 64 * ks);
                            XuT = __builtin_amdgcn_mfma_f32_16x16x32_bf16(A0, __builtin_bit_cast(bf16x8, bs), XuT, 0, 0, 0); XrT = __builtin_amdgcn_mfma_f32_16x16x32_bf16(A1, __builtin_bit_cast(bf16x8, bs), XrT, 0, 0, 0); }
                        unsigned vlo, vhi;
                        { const unsigned v0 = *(LAS unsigned short*)(oVB + (4 * fq + 0) * VB_ROW + (16 * wid + fr) * 2), v1 = *(LAS unsigned short*)(oVB + (4 * fq + 1) * VB_ROW + (16 * wid + fr) * 2);
                          const unsigned v2 = *(LAS unsigned short*)(oVB + (4 * fq + 2) * VB_ROW + (16 * wid + fr) * 2), v3 = *(LAS unsigned short*)(oVB + (4 * fq + 3) * VB_ROW + (16 * wid + fr) * 2);
                          vlo = v0 | (v1 << 16); vhi = v2 | (v3 << 16); }
                        f32x4 UT = {0.f, 0.f, 0.f, 0.f};
                        { const u32x4 bu = {pk2(XuT[0], XuT[1]), pk2(XuT[2], XuT[3]), vlo, vhi};
                          UT = __builtin_amdgcn_mfma_f32_16x16x32_bf16(PERMK(oZT, fr * T_ROW), __builtin_bit_cast(bf16x8, bu), UT, 0, 0, 0); }
                        const u32x4 buv = {pk2(UT[0], UT[1]), pk2(UT[2], UT[3]), vlo, vhi};
                        if (c >= 16) {
                            const f32x4 y = __builtin_amdgcn_mfma_f32_16x16x32_bf16(PERMK(oMM, fr * T_ROW), __builtin_bit_cast(bf16x8, buv), XrT, 0, 0, 0);
#pragma unroll
                            for (int reg = 0; reg < 4; ++reg) aY[(4 * fq + reg) * Y_ROW + 16 * wid + fr] = y[reg]; }
#pragma unroll
                        for (int nt = 0; nt < 4; ++nt) { const f32x4 r = __builtin_amdgcn_mfma_f32_16x16x32_bf16(PERMK(oBKT, (16 * nt + fr) * T_ROW), __builtin_bit_cast(bf16x8, buv), St[nt], 0, 0, 0);
                            St[nt] = r * *(LAS f32x4*)(aWL + 16 * nt + 4 * fq); }
#undef PERMK
                    }
                    if (it + 4 <= 143) { const int c = it + 4;
                        LAS float* aWd = (LAS float*)(lds + RO_WD + (c % 3) * W_SLOT); LAS float* aTt = (LAS float*)(lds + RO_TT + (c & 1) * W_SLOT);
                        f32x4 cw = {0.f, 0.f, 0.f, 0.f}, ca = {0.f, 0.f, 0.f, 0.f};
#pragma unroll
                        for (int ks = 0; ks < 3; ++ks) { cw = __builtin_amdgcn_mfma_f32_16x16x32_bf16(__builtin_bit_cast(bf16x8, PF[ks]), Bw[ks], cw, 0, 0, 0); ca = __builtin_amdgcn_mfma_f32_16x16x32_bf16(__builtin_bit_cast(bf16x8, PF[3 + ks]), Ba[ks], ca, 0, 0, 0); }
#pragma unroll
                        for (int reg = 0; reg < 4; ++reg) { const int ii = 4 * fq + reg; const int n = 16 * wid + fr;
                            const float sg = sigmoidf_(w0v + cw[reg]);
                            aWd[ii * W_ROW + n] = __expf(-0.60653065971263342f * sg); aTt[ii * W_ROW + n] = sigmoidf_(a0v + ca[reg]); }
                    }
                    if (it + 5 >= 0 && it + 5 <= 143) { const int c5 = it + 5; LPREF(c5) }
                    if (wid == 0 && it + 2 >= 0 && it + 2 <= 143) { const int c = it + 2; const int k = lane;
                        LAS float* aWd = (LAS float*)(lds + RO_WD + (c % 3) * W_SLOT); LAS float* pa = (LAS float*)(lds + RO_PA + (c & 1) * 20480);
                        LAS unsigned char* oAR = lds + RO_AR + (c % 3) * 4608; LAS float* aWL = (LAS float*)(lds + RO_WL + (c % 3) * 256);
                        float Wc = 1.0f;
#pragma unroll
                        for (int t = 0; t < 16; ++t) { const float Wp = Wc; Wc *= aWd[t * W_ROW + k];
                            STH(oAR + t * 144 + k * 2, pa[0 * 1024 + t * 64 + k] * Wp); }
                        aWL[k] = Wc; }
                    if (wid == 1 && it + 2 >= 0 && it + 2 <= 143) { const int c = it + 2; const int k = lane;
                        LAS float* aWd = (LAS float*)(lds + RO_WD + (c % 3) * W_SLOT); LAS float* pa = (LAS float*)(lds + RO_PA + (c & 1) * 20480);
                        LAS unsigned char* oAR = lds + RO_AR + (c % 3) * 4608; LAS unsigned char* oVB = lds + RO_VB + (c & 3) * VB_SLOT;
                        float Wc = 1.0f;
#pragma unroll
                        for (int t = 0; t < 16; ++t) { Wc *= aWd[t * W_ROW + k]; STH(oAR + (16 + t) * 144 + k * 2, pa[3 * 1024 + t * 64 + k] * Wc); STH(oVB + t * VB_ROW + k * 2, pa[4 * 1024 + t * 64 + k]); } }
                } else if (wid == 4) {
                    if (it - 1 >= 16 && it - 1 <= 143) { const int c = it - 1; CHUNK(c, tc_, rb_) (void)rb_;
                        LAS float* aY = (LAS float*)(lds + RO_Y + (c & 1) * Y_SLOT); LAS float* aQ = (LAS float*)(lds + RO_Q + (c & 7) * 64); LAS unsigned char* oVB = lds + RO_VB + (c & 3) * VB_SLOT;
#pragma unroll
                        for (int j = 0; j < 4; ++j) { const int pi = fq + 4 * j, nq = fr, hn4 = h * 64 + 4 * nq;
                            const size_t rl = (size_t)bl * 2048 + 16 * tc_ + (d ? 15 - pi : pi);
                            const f32x4 y4 = *(LAS f32x4*)(aY + pi * Y_ROW + 4 * nq); const float qown = aQ[pi];
                            if (d == 0) {
                                u32x2 o; o.x = pk2(y4.x, y4.y); o.y = pk2(y4.z, y4.w); *(u32x2*)(YP + rl * 4096 + hn4) = o;
                                if (nq == 0) QP[rl * 64 + h] = qown;
                            } else {
                                const u32x2 py_ = PFLO(PF[j >> 1], j), pz_ = PFLO(PF[2 + (j >> 1)], j); const float pq_ = __builtin_bit_cast(float, j == 0 ? PF[4].x : (j == 1 ? PF[4].y : (j == 2 ? PF[4].z : PF[4].w)));
                                const f32x4 ys = {y4.x + blo(py_.x), y4.y + bhi(py_.x), y4.z + blo(py_.y), y4.w + bhi(py_.y)};
                                float sm = (ys.x + ys.y) + (ys.z + ys.w); sm = red16(sm); const float mean = sm * (1.0f / 64.0f);
                                const f32x4 dv = ys - mean; float vs = (dv.x * dv.x + dv.y * dv.y) + (dv.z * dv.z + dv.w * dv.w); vs = red16(vs);
                                const float rstd = __builtin_amdgcn_rsqf(vs * (1.0f / 64.0f) + 64e-5f);
                                const float q = qown + pq_;
                                const u32x2 vb = *(LAS u32x2*)(oVB + pi * VB_ROW + nq * 8);
                                const f32x4 v4 = {blo(vb.x), bhi(vb.x), blo(vb.y), bhi(vb.y)};
                                const f32x4 val = dv * rstd * cKK + cKA + v4 * q;
                                const float z0 = blo(pz_.x), z1 = bhi(pz_.x), z2 = blo(pz_.y), z3 = bhi(pz_.y);
                                u32x2 o; o.x = pk2(val.x * z0 * sigmoidf_(z0), val.y * z1 * sigmoidf_(z1)); o.y = pk2(val.z * z2 * sigmoidf_(z2), val.w * z3 * sigmoidf_(z3));
                                *(u32x2*)(ZB + (1024 + rl) * 4096 + hn4) = o;
                            } }
                    }
                    if (d == 1 && it >= 16 && it <= 143) { const int c = it; CHUNK(c, tc_, rb_) (void)rb_;
                        u32x2 ty[4], tz[4]; unsigned tq[4];
#pragma unroll
                        for (int j = 0; j < 4; ++j) { const int pi = fq + 4 * j, nq = fr, hn4 = h * 64 + 4 * nq; const size_t rl = (size_t)bl * 2048 + 16 * tc_ + (15 - pi);
                            ty[j] = *(const u32x2*)(YP + rl * 4096 + hn4); tq[j] = __builtin_bit_cast(unsigned, QP[rl * 64 + h]); tz[j] = *(const u32x2*)(ZB + (1024 + rl) * 4096 + hn4); }
                        PF[0] = (u32x4){ty[0].x, ty[0].y, ty[1].x, ty[1].y}; PF[1] = (u32x4){ty[2].x, ty[2].y, ty[3].x, ty[3].y};
                        PF[2] = (u32x4){tz[0].x, tz[0].y, tz[1].x, tz[1].y}; PF[3] = (u32x4){tz[2].x, tz[2].y, tz[3].x, tz[3].y};
                        PF[4] = (u32x4){tq[0], tq[1], tq[2], tq[3]}; }
                    if (it + 1 >= 0 && it + 1 <= 143) { const int c = it + 1;
                        LAS unsigned char* oAR = lds + RO_AR + (c % 3) * 4608; LAS unsigned char* oBK = lds + RO_BK + (c & 1) * 4608; LAS unsigned char* oMM = lds + RO_MM + (c & 1) * ZT_SLOT;
#pragma unroll
                        for (int mi = 0; mi < 2; ++mi) { f32x4 g = {0.f, 0.f, 0.f, 0.f};
#pragma unroll
                            for (int ks = 0; ks < 2; ++ks) { const bf16x8 Af = *(const LAS bf16x8*)(oBK + (16 * mi + fr) * 144 + (32 * ks + 8 * fq) * 2), Bf = *(const LAS bf16x8*)(oAR + (16 + fr) * 144 + (32 * ks + 8 * fq) * 2);
                                g = __builtin_amdgcn_mfma_f32_16x16x32_bf16(Af, Bf, g, 0, 0, 0); }
#pragma unroll
                            for (int reg = 0; reg < 4; ++reg) { const int s_ = 4 * fq + reg; STH(oMM + fr * T_ROW + (16 * mi + s_) * 2, (s_ <= fr) ? g[reg] : 0.f); } } }
                } else if (wid == 5) {
                    if (it + 3 >= 0 && it + 3 <= 143) { const int c = it + 3;
                        LAS float* aTt = (LAS float*)(lds + RO_TT + (c & 1) * W_SLOT); LAS float* pa = (LAS float*)(lds + RO_PA + (c & 1) * 20480); LAS float* aQ = (LAS float*)(lds + RO_Q + (c & 7) * 64);
#pragma unroll
                        for (int j = 0; j < 3; ++j) { const int pi = fq + 4 * j, nq = fr;
                            const u32x2 pk_ = PFLO(PF[j >> 1], j), pr_ = PFLO(PF[2 + (j >> 1)], j), pv_ = PFLO(PF[4 + (j >> 1)], j);
                            const f32x4 k4 = {blo(pk_.x), bhi(pk_.x), blo(pk_.y), bhi(pk_.y)}, r4 = {blo(pr_.x), bhi(pr_.x), blo(pr_.y), bhi(pr_.y)}, v4 = {blo(pv_.x), bhi(pv_.x), blo(pv_.y), bhi(pv_.y)};
                            f32x4 kk = k4 * cKK; float ss = (kk.x * kk.x + kk.y * kk.y) + (kk.z * kk.z + kk.w * kk.w); ss = red16(ss);
                            const float inv = __builtin_amdgcn_rsqf(fmaxf(ss, 1e-24f)); kk = kk * inv;
                            const f32x4 ar = *(LAS f32x4*)(aTt + pi * W_ROW + 4 * nq);
                            const f32x4 kd = k4 * ((ar - 1.0f) * cKA + 1.0f);
                            *(LAS f32x4*)(pa + 0 * 1024 + pi * 64 + 4 * nq) = -kk; *(LAS f32x4*)(pa + 1 * 1024 + pi * 64 + 4 * nq) = kk * ar; *(LAS f32x4*)(pa + 2 * 1024 + pi * 64 + 4 * nq) = kd;
                            *(LAS f32x4*)(pa + 3 * 1024 + pi * 64 + 4 * nq) = r4; *(LAS f32x4*)(pa + 4 * 1024 + pi * 64 + 4 * nq) = v4;
                            const f32x4 q3 = kd * r4 * cRK; float qq = (q3.x + q3.y) + (q3.z + q3.w); qq = red16(qq);
                            if (nq == 0) aQ[pi] = qq; }
                    }
                    if (it + 4 >= 0 && it + 4 <= 143) { const int c4 = it + 4; CHUNK(c4, tc_, rb_)
#pragma unroll
                        for (int j = 0; j < 3; ++j) { const int pi = fq + 4 * j; const size_t off_ = (rb_ + 16 * tc_ + (d ? 15 - pi : pi)) * 4096 + h * 64 + 4 * fr;
                            PFSET(PF[j >> 1], j, *(const u32x2*)(KB + off_)) PFSET(PF[2 + (j >> 1)], j, *(const u32x2*)(RB + off_)) PFSET(PF[4 + (j >> 1)], j, *(const u32x2*)(VB + off_)) } }
                } else if (wid == 6) {
                    if (it + 3 >= 0 && it + 3 <= 143) { const int c = it + 3;
                        LAS float* aTt = (LAS float*)(lds + RO_TT + (c & 1) * W_SLOT); LAS float* pa = (LAS float*)(lds + RO_PA + (c & 1) * 20480); LAS float* aQ = (LAS float*)(lds + RO_Q + (c & 7) * 64);
#pragma unroll
                        for (int j = 3; j < 4; ++j) { const int pi = fq + 4 * j, nq = fr;
                            const u32x2 pk_ = PFLO(PF[j >> 1], j), pr_ = PFLO(PF[2 + (j >> 1)], j), pv_ = PFLO(PF[4 + (j >> 1)], j);
                            const f32x4 k4 = {blo(pk_.x), bhi(pk_.x), blo(pk_.y), bhi(pk_.y)}, r4 = {blo(pr_.x), bhi(pr_.x), blo(pr_.y), bhi(pr_.y)}, v4 = {blo(pv_.x), bhi(pv_.x), blo(pv_.y), bhi(pv_.y)};
                            f32x4 kk = k4 * cKK; float ss = (kk.x * kk.x + kk.y * kk.y) + (kk.z * kk.z + kk.w * kk.w); ss = red16(ss);
                            const float inv = __builtin_amdgcn_rsqf(fmaxf(ss, 1e-24f)); kk = kk * inv;
                            const f32x4 ar = *(LAS f32x4*)(aTt + pi * W_ROW + 4 * nq);
                            const f32x4 kd = k4 * ((ar - 1.0f) * cKA + 1.0f);
                            *(LAS f32x4*)(pa + 0 * 1024 + pi * 64 + 4 * nq) = -kk; *(LAS f32x4*)(pa + 1 * 1024 + pi * 64 + 4 * nq) = kk * ar; *(LAS f32x4*)(pa + 2 * 1024 + pi * 64 + 4 * nq) = kd;
                            *(LAS f32x4*)(pa + 3 * 1024 + pi * 64 + 4 * nq) = r4; *(LAS f32x4*)(pa + 4 * 1024 + pi * 64 + 4 * nq) = v4;
                            const f32x4 q3 = kd * r4 * cRK; float qq = (q3.x + q3.y) + (q3.z + q3.w); qq = red16(qq);
                            if (nq == 0) aQ[pi] = qq; }
                    }
                    if (it + 4 >= 0 && it + 4 <= 143) { const int c4 = it + 4; CHUNK(c4, tc_, rb_)
#pragma unroll
                        for (int j = 3; j < 4; ++j) { const int pi = fq + 4 * j; const size_t off_ = (rb_ + 16 * tc_ + (d ? 15 - pi : pi)) * 4096 + h * 64 + 4 * fr;
                            PFSET(PF[j >> 1], j, *(const u32x2*)(KB + off_)) PFSET(PF[2 + (j >> 1)], j, *(const u32x2*)(RB + off_)) PFSET(PF[4 + (j >> 1)], j, *(const u32x2*)(VB + off_)) } }
                    if (it + 2 >= 0 && it + 2 <= 143) { const int c = it + 2; const int k = lane;
                        LAS float* aWd = (LAS float*)(lds + RO_WD + (c % 3) * W_SLOT); LAS float* pa = (LAS float*)(lds + RO_PA + (c & 1) * 20480);
                        LAS unsigned char* oBK = lds + RO_BK + (c & 1) * 4608; LAS unsigned char* oBKT = lds + RO_BKT + (c % 3) * BKT_SLOT; LAS unsigned char* oAR = lds + RO_AR + (c % 3) * 4608; LAS unsigned char* oVB = lds + RO_VB + (c & 3) * VB_SLOT;
                        float Wc = 1.0f, pxb = 0.f, pxk = 0.f;
#pragma unroll
                        for (int t = 0; t < 16; ++t) { Wc *= aWd[t * W_ROW + k]; const float rW = __builtin_amdgcn_rcpf(Wc);
                            const float xb = pa[1 * 1024 + t * 64 + k] * rW, xk = pa[2 * 1024 + t * 64 + k] * rW;
                            STH(oBK + t * 144 + k * 2, xb); STH(oBK + (16 + t) * 144 + k * 2, xk);
                            if (t & 1) { *(LAS unsigned*)(oBKT + k * T_ROW + (t - 1) * 2) = pk2(pxb, xb); *(LAS unsigned*)(oBKT + k * T_ROW + (16 + t - 1) * 2) = pk2(pxk, xk); } pxb = xb; pxk = xk;
                            } }
                } else {
                    if (it + 1 >= 0 && it + 1 <= 143) { const int c = it + 1;
                        LAS unsigned char* oAR = lds + RO_AR + (c % 3) * 4608; LAS unsigned char* oBK = lds + RO_BK + (c & 1) * 4608; LAS float* aG = (LAS float*)(lds + RO_G);
                        LAS unsigned char* oZT = lds + RO_ZT + (c & 1) * ZT_SLOT;
#pragma unroll
                        for (int mi = 0; mi < 2; ++mi) { const int ni = 0; f32x4 g = {0.f, 0.f, 0.f, 0.f};
#pragma unroll
                            for (int ks = 0; ks < 2; ++ks) { const bf16x8 Af = *(const LAS bf16x8*)(oBK + (16 * mi + fr) * 144 + (32 * ks + 8 * fq) * 2), Bf = *(const LAS bf16x8*)(oAR + (16 * ni + fr) * 144 + (32 * ks + 8 * fq) * 2);
                                g = __builtin_amdgcn_mfma_f32_16x16x32_bf16(Af, Bf, g, 0, 0, 0); }
#pragma unroll
                            for (int reg = 0; reg < 4; ++reg) aG[(16 * mi + 4 * fq + reg) * 36 + 16 * ni + fr] = g[reg]; }
                        asm volatile("" ::: "memory");
                        { const int rp = lane & 31; float z[16], grow[16];
#pragma unroll
                          for (int t4 = 0; t4 < 4; ++t4) { const f32x4 gr = *(LAS f32x4*)(aG + rp * 36 + 4 * t4); grow[4 * t4] = gr.x; grow[4 * t4 + 1] = gr.y; grow[4 * t4 + 2] = gr.z; grow[4 * t4 + 3] = gr.w; }
#pragma unroll
                          for (int t = 0; t < 16; ++t) z[t] = (rp < 16) ? ((t == rp) ? 1.0f : 0.0f) : ((rp - 16 < t) ? grow[t] : 0.0f);
#pragma unroll
                          for (int s = 0; s < 15; ++s) {
#pragma unroll
                              for (int t = s + 1; t < 16; ++t) { const float gst = __builtin_bit_cast(float, __builtin_amdgcn_readlane(__builtin_bit_cast(int, grow[t]), s)); z[t] += z[s] * gst; } }
                          if (lane < 32) {
#pragma unroll
                              for (int t = 0; t < 16; ++t) STH(oZT + t * T_ROW + rp * 2, z[t]); } }
                    }
                }
                BAR_LDS();
            }
        }
    }
    __syncthreads();
#undef LANEVARS
#undef BAR_LDS
#undef STH
#undef CHUNK
#undef CST
#undef LPREF
#undef PFLO
#undef PFSET
}

__device__ __forceinline__ void mix_phase(PPtr P, int i0, int i1, int i2, int gtid, int gthreads) {
    const bf16* H = (const bf16*)(P->ws + WS_H1); const float* mu = P->in[22];
    bf16* A0 = (bf16*)(P->ws + WS_A); bf16* A1 = (bf16*)(P->ws + WS_A + A_STRIDE); bf16* A2 = (bf16*)(P->ws + WS_A + 2 * A_STRIDE);
    for (int idx = gtid; idx < 9216 * 256; idx += gthreads) {
        const int row = idx >> 8, c0 = (idx & 255) * 8;
        int nrow = -1;
        if (row < 1024) { const int t = row & 255; if (c0 < 1024) { if (t > 0) nrow = row - 1; } else { if (t < 255) nrow = row + 1; } }
        else { const int t = (row - 1024) & 2047, gx = t & 63, gy = t >> 6, qd = c0 >> 9;
            if (qd == 0) { if (gx > 0) nrow = row - 1; } else if (qd == 1) { if (gx < 63) nrow = row + 1; } else if (qd == 2) { if (gy > 0) nrow = row - 64; } else { if (gy < 31) nrow = row + 64; } }
        const u32x4 hv = *(const u32x4*)(H + (size_t)row * 2048 + c0);
        u32x4 sv = {0u, 0u, 0u, 0u}; if (nrow >= 0) sv = *(const u32x4*)(H + (size_t)nrow * 2048 + c0);
        const float hf[8] = {blo(hv.x), bhi(hv.x), blo(hv.y), bhi(hv.y), blo(hv.z), bhi(hv.z), blo(hv.w), bhi(hv.w)};
        const float sf[8] = {blo(sv.x), bhi(sv.x), blo(sv.y), bhi(sv.y), blo(sv.z), bhi(sv.z), blo(sv.w), bhi(sv.w)};
#pragma unroll
        for (int q = 0; q < 3; ++q) { const int mi = q == 0 ? i0 : (q == 1 ? i1 : i2); bf16* dst = q == 0 ? A0 : (q == 1 ? A1 : A2);
            const f32x4 m0 = *(const f32x4*)(mu + mi * 2048 + c0), m1 = *(const f32x4*)(mu + mi * 2048 + c0 + 4);
            const float mm[8] = {m0.x, m0.y, m0.z, m0.w, m1.x, m1.y, m1.z, m1.w};
            float o[8];
#pragma unroll
            for (int e = 0; e < 8; ++e) o[e] = hf[e] + (sf[e] - hf[e]) * mm[e];
            u32x4 w; w.x = pk2(o[0], o[1]); w.y = pk2(o[2], o[3]); w.z = pk2(o[4], o[5]); w.w = pk2(o[6], o[7]);
            *(u32x4*)(dst + (size_t)row * 2048 + c0) = w; }
    }
}

__global__ void __launch_bounds__(NT, 2) fwd_megakernel(Params Pk) {
    extern __shared__ __attribute__((aligned(16))) unsigned char lds_raw[];
    LAS unsigned char* lds = (LAS unsigned char*)lds_raw;
    cg::grid_group grid = cg::this_grid();
    const int G = gridDim.x, NGW = G * 8, gthreads = G * NT;
#ifdef PROBE_CAT
    unsigned long long pb_acc = 0, pb_t0 = 0;
#define PB_BEGIN(cat) if (PROBE_CAT == (cat)) pb_t0 = __builtin_amdgcn_s_memrealtime();
#define PB_END(cat) if (PROBE_CAT == (cat)) pb_acc += __builtin_amdgcn_s_memrealtime() - pb_t0;
#else
#define PB_BEGIN(cat)
#define PB_END(cat)
#endif
    { int t_ = threadIdx.x; if (t_ < 16) ((LAS unsigned*)(lds + LDS_BARST))[t_] = 0u; }
    __syncthreads();
    XcdBarrier xbar;
    { GETP xbar = xcd_barrier_post((unsigned*)(P->ws + WS_BAR), (volatile LAS unsigned*)(lds + LDS_BARST)); }
#define GSYNC_CG() do { PB_BEGIN(4) grid.sync(); PB_END(4) } while (0)
#define GSYNC() do { PB_BEGIN(4) xcd_barrier(xbar); PB_END(4) } while (0)
#define TID_VARS GETP unsigned char* ws = P->ws; float* MOD = (float*)(ws + WS_MOD); (void)MOD; int tid = threadIdx.x; asm volatile("" : "+v"(tid)); const int lane = tid & 63, wave = __builtin_amdgcn_readfirstlane(tid >> 6); const int gw = blockIdx.x * 8 + wave, gtid = blockIdx.x * NT + tid; LAS float* scr = (LAS float*)(lds + wave * 16384); (void)lane; (void)gw; (void)gtid; (void)scr;

    { TID_VARS
      for (int tk = blockIdx.x; tk < 768; tk += G) mod_task(P, MOD, (LAS float*)(lds + 8 * 16384), tk, tid);
      constexpr int I_IN = 32 * 256, I_GLU = 64 * 128, I_OUT = 64 * 64;
      for (int it = gw; it < I_IN + I_GLU + I_OUT; it += NGW) { int r = it;
          if (r < I_IN) { transpose_item(P->in[7], 2048, 8192, (bf16*)(ws + WB_L0_IN), 0, scr, r, lane); continue; } r -= I_IN;
          if (r < I_GLU) { transpose_item(P->in[16], 4096, 4096, (bf16*)(ws + WB_L0_GLU), 0, scr, r, lane); continue; } r -= I_GLU;
          transpose_item(P->in[18], 4096, 2048, (bf16*)(ws + WB_L0_OUT), 0, scr, r, lane); } }
    GSYNC(); if (gridDim.x == 0u) GSYNC_CG();
    { TID_VARS bf16* H0 = (bf16*)P->out;
      for (int m = gw; m < 18432; m += NGW) {
          if (m < 2048) normmod_row(P->in[2] + (size_t)m * 2048, P->in[4], MOD + 8 * 6144, H0 + (size_t)m * 2048, lane);
          else { const int r = m - 2048; normmod_row(P->in[0] + (size_t)r * 2048, P->in[4], MOD + (r >> 11) * 6144, H0 + (size_t)m * 2048, lane); } } }
    GSYNC();
    { GETP unsigned char* ws = P->ws; float* MOD = (float*)(ws + WS_MOD); (void)MOD; pg8::Gemm g{(const bf16*)P->out, (const bf16*)(ws + WB_L0_IN), 18432, 8192, 2048, 0, 1, 1 << 30}; pg8::StaticOrder S; S.init(18432, 8192, G, (int)blockIdx.x);
      pg8::EpiSplitBf16 E{(bf16*)(ws + WS_U), 4096, 4096, (size_t)18432 * 4096};
      PB_BEGIN(1) pg8::gemm_phase<pg8::EpiSplitBf16, pg8::StaticOrder, true, true>(lds, g, S, E); PB_END(1) }
    GSYNC();
    { PB_BEGIN(2) TID_VARS s5_phase(P, lds, wave, lane); PB_END(2) }
    GSYNC();
    { GETP unsigned char* ws = P->ws; float* MOD = (float*)(ws + WS_MOD); (void)MOD; pg8::Gemm g{(const bf16*)(ws + WS_Y), (const bf16*)(ws + WB_L0_GLU), 18432, 4096, 4096, 0, 1, 1 << 30}; pg8::StaticOrder S; S.init(18432, 4096, G, (int)blockIdx.x);
      pg8::EpiGlu E{(const bf16*)(ws + WS_Y), (bf16*)(ws + WS_Z), 4096, P->in[17]};
      PB_BEGIN(1) pg8::gemm_phase<pg8::EpiGlu, pg8::StaticOrder, true, true>(lds, g, S, E); PB_END(1) }
    GSYNC();
    { GETP unsigned char* ws = P->ws; float* MOD = (float*)(ws + WS_MOD); (void)MOD; pg8::Gemm g{(const bf16*)(ws + WS_Z), (const bf16*)(ws + WB_L0_OUT), 18432, 2048, 4096, 0, 1, 1 << 30}; pg8::StaticOrder S; S.init(18432, 2048, G, (int)blockIdx.x);
      pg8::EpiResid E{P->in[0], P->out, P->in[2], (float*)(ws + WS_XC), MOD, 2048, 0};
      PB_BEGIN(1) pg8::gemm_phase<pg8::EpiResid, pg8::StaticOrder, true, true>(lds, g, S, E); PB_END(1) }
    GSYNC();
    { TID_VARS constexpr int I_IN = 32 * 128, I_LO = 32 * 3, I_OUT = 64 * 64; bf16* WIN = (bf16*)(ws + WB_L1_IN);
      for (int it = gw; it < 4 * I_IN + 4 * I_LO + I_OUT; it += NGW) { int r = it;
          if (r < 4 * I_IN) { const int q = r / I_IN; transpose_item(P->in[23] + (size_t)q * 2048 * 4096, 2048, 4096, WIN, q * 4096, scr, r % I_IN, lane); continue; } r -= 4 * I_IN;
          if (r < 2 * I_LO) { const int q = r / I_LO; transpose_item(P->in[25] + (size_t)q * 2048 * 96, 2048, 96, WIN, 16384 + q * 96, scr, r % I_LO, lane); continue; } r -= 2 * I_LO;
          if (r < 2 * I_LO) { const int q = r / I_LO; transpose_item(P->in[28] + (size_t)q * 2048 * 96, 2048, 96, WIN, 16640 + q * 96, scr, r % I_LO, lane); continue; } r -= 2 * I_LO;
          transpose_item(P->in[35], 4096, 2048, (bf16*)(ws + WB_L1_OUT), 0, scr, r, lane); }
      for (int idx = gtid; idx < 2 * 64 * 2048 / 8; idx += gthreads) { const int e = idx * 8, pr = e / 2048, c = e % 2048; const int row = (pr < 64) ? 16576 + pr : 16832 + (pr - 64);
          *(u32x4*)(WIN + (size_t)row * 2048 + c) = (u32x4){0u, 0u, 0u, 0u}; }
      bf16* W2T = (bf16*)(ws + WS_W2T); bf16* A2T = (bf16*)(ws + WS_A2T);
      for (int idx = gtid; idx < 2 * 96 * 4096; idx += gthreads) { const int n = idx & 4095, m = (idx >> 12) % 96, dd = idx / (96 * 4096);
          W2T[((size_t)dd * 4096 + n) * 96 + m] = (bf16)f2bf(P->in[26][idx]); A2T[((size_t)dd * 4096 + n) * 96 + m] = (bf16)f2bf(P->in[29][idx]); } }
    for (int hb = 0; hb < 2; ++hb) {
        { TID_VARS bf16* H1 = (bf16*)(ws + WS_H1); const float* MOD1 = MOD + 9 * 6144;
          for (int m = gw; m < 9216; m += NGW) {
              if (m < 1024) normmod_row((const float*)(ws + WS_XC) + (size_t)(hb * 1024 + m) * 2048, P->in[19], MOD1 + 8 * 6144, H1 + (size_t)m * 2048, lane);
              else { const int r = hb * 8192 + (m - 1024); normmod_row(P->out + (size_t)r * 2048, P->in[19], MOD1 + (r >> 11) * 6144, H1 + (size_t)m * 2048, lane); } } }
        GSYNC();
        { TID_VARS mix_phase(P, 0, 1, 2, gtid, gthreads); }
        GSYNC();
        { GETP unsigned char* ws = P->ws; float* MOD = (float*)(ws + WS_MOD); (void)MOD; pg8::Gemm g{(const bf16*)(ws + WS_A), (const bf16*)(ws + WB_L1_IN), 9216, 12288, 2048, A_STRIDE, 16, 48}; pg8::StaticOrder S; S.init(9216, 12288, G, (int)blockIdx.x);
          pg8::EpiSplitBf16 E{(bf16*)(ws + WS_RKV), 4096, 4096, (size_t)9216 * 4096};
          PB_BEGIN(1) pg8::gemm_phase<pg8::EpiSplitBf16, pg8::StaticOrder, true, true>(lds, g, S, E); PB_END(1) }
        GSYNC();
        { TID_VARS mix_phase(P, 3, 4, 5, gtid, gthreads); }
        GSYNC();
        { GETP unsigned char* ws = P->ws; float* MOD = (float*)(ws + WS_MOD); (void)MOD; pg8::Gemm g{(const bf16*)(ws + WS_A), (const bf16*)(ws + WB_L1_IN) + (size_t)12288 * 2048, 9216, 4608, 2048, A_STRIDE, 16, 16}; pg8::StaticOrder S; S.init(9216, 4608, G, (int)blockIdx.x);
          pg8::EpiZLora E{(bf16*)(ws + WS_ZB), (bf16*)(ws + WS_ZB + ZB_LW), (bf16*)(ws + WS_ZB + ZB_LA)};
          PB_BEGIN(1) pg8::gemm_phase<pg8::EpiZLora, pg8::StaticOrder, true, true>(lds, g, S, E); PB_END(1) }
        GSYNC();
        { PB_BEGIN(3) TID_VARS rwkv_phase(P, lds, hb, tid); PB_END(3) }
        GSYNC();
        { GETP unsigned char* ws = P->ws; float* MOD = (float*)(ws + WS_MOD); (void)MOD; pg8::Gemm g{(const bf16*)(ws + WS_ZB) + (size_t)1024 * 4096, (const bf16*)(ws + WB_L1_OUT), 8192, 2048, 4096, 0, 1, 1 << 30}; pg8::StaticOrder S; S.init(8192, 2048, G, (int)blockIdx.x);
          pg8::EpiResid E{P->out, P->out, nullptr, nullptr, MOD + 9 * 6144, 0, hb * 8192};
          PB_BEGIN(1) pg8::gemm_phase<pg8::EpiResid, pg8::StaticOrder, true, true>(lds, g, S, E); PB_END(1) }
        GSYNC();
    }
    { TID_VARS const float* fg = P->in[36];
      for (int m = gw; m < 16384; m += NGW) { float* xr = P->out + (size_t)m * 2048;
          f32x4 v[8]; float s = 0.f;
#pragma unroll
          for (int j = 0; j < 8; ++j) { v[j] = ((const f32x4*)xr)[lane + 64 * j]; s += (v[j].x * v[j].x + v[j].y * v[j].y) + (v[j].z * v[j].z + v[j].w * v[j].w); }
          const float rstd = 1.0f / sqrtf(wave_sum(s) * (1.0f / 2048.0f) + 1e-6f);
#pragma unroll
          for (int j = 0; j < 8; ++j) ((f32x4*)xr)[lane + 64 * j] = v[j] * rstd * ((const f32x4*)fg)[lane + 64 * j]; } }
#ifdef PROBE_CAT
    { const unsigned long long t1 = __builtin_amdgcn_s_memrealtime(); while (__builtin_amdgcn_s_memrealtime() - t1 < pb_acc) __builtin_amdgcn_s_sleep(8); }
#endif
}

extern "C" void kernel_launch(void* const* d_in, const int* in_sizes, int n_in, void* d_out, int out_size, void* d_ws, size_t ws_size, hipStream_t stream) {
    static int grid = 0;
    if (grid == 0) {
        if (n_in != 37 || ws_size < WS_END) { fprintf(stderr, "kernel_launch: need 37 inputs and >= %zu bytes of workspace; got n_in %d, ws %zu; nothing launched\n", (size_t)WS_END, n_in, ws_size); grid = -1; return; }
        int dev = 0, cus = 0, per_cu = 0;
        if (hipGetDevice(&dev) != hipSuccess || hipDeviceGetAttribute(&cus, hipDeviceAttributeMultiprocessorCount, dev) != hipSuccess) { grid = -1; return; }
        if (hipFuncSetAttribute((const void*)fwd_megakernel, hipFuncAttributeMaxDynamicSharedMemorySize, LDS_BYTES) != hipSuccess) { fprintf(stderr, "kernel_launch: hipFuncSetAttribute failed\n"); grid = -1; return; }
        if (hipOccupancyMaxActiveBlocksPerMultiprocessor(&per_cu, (const void*)fwd_megakernel, NT, LDS_BYTES) != hipSuccess || per_cu < 1) { fprintf(stderr, "kernel_launch: occupancy query says %d\n", per_cu); per_cu = 1; }
        (void)hipGetLastError();
        grid = cus * 1;
    }
    if (grid < 0) return;
    (void)hipMemsetAsync((char*)d_ws + WS_MOD, 0, ZERO_BYTES, stream);
    Params p{};
    for (int i = 0; i < 37; ++i) p.in[i] = (const float*)d_in[i];
    p.out = (float*)d_out; p.ws = (unsigned char*)d_ws;
    void* args[] = {&p};
    hipError_t e = hipLaunchCooperativeKernel((const void*)fwd_megakernel, dim3(grid), dim3(NT), args, LDS_BYTES, stream);
    if (e != hipSuccess) fprintf(stderr, "cooperative launch failed: %s (grid %d)\n", hipGetErrorString(e), grid);
}
```
